# Optimizing an MI355X kernel written in HIP

```python
import math
import jax
import jax.numpy as jnp
from jax import lax
import numpy as np


D_MODEL = 1024
BATCH = 1
SEQ = 16384
DEPTH = 1
DEC_BATCH = 8
DEC_SEQ = 8192
PAST_LEN = 128

N_MEM = 256
GRID_W = 64
EPS = 1e-6
SSM_HEADS = 16
SSM_HEAD_DIM = 64
SSM_INNER = SSM_HEADS * SSM_HEAD_DIM
SSM_GROUPS = 2
SSM_STATE = 128
D_CONV = 5
CHUNK = 128
CONV_DIM = SSM_INNER + 2 * SSM_GROUPS * SSM_STATE
DT_MIN = 1e-3
DT_MAX = 1e-1
ATTN_HEADS = 8
ATTN_KV_HEADS = 2
ATTN_HEAD_DIM = 64
ATTN_INNER = ATTN_HEADS * ATTN_HEAD_DIM
ROPE_THETA = 10000.0
Q_BLOCK = 128
MIX_WIDTH = SSM_INNER + ATTN_INNER
IN_SPLITS = (SSM_INNER, CONV_DIM, 2 * SSM_HEADS, ATTN_INNER,
             ATTN_KV_HEADS * ATTN_HEAD_DIM, ATTN_KV_HEADS * ATTN_HEAD_DIM)
D_IN_PROJ = sum(IN_SPLITS)
IN_SPLIT_IDX = [int(v) for v in np.cumsum(IN_SPLITS)[:-1]]
X_HEADS = 4
X_HEAD_DIM = 128
X_INNER = X_HEADS * X_HEAD_DIM
D_FF = -(-8 * D_MODEL // (3 * 256)) * 256

kernel_name = 'hymba_ssd_axial_gqa_sandwich_encoder'


def rmsnorm(x, g):
    xf = x.astype(jnp.float32)
    y = xf * lax.rsqrt(jnp.mean(xf * xf, axis=-1, keepdims=True) + EPS)
    return (y * g.astype(jnp.float32)).astype(x.dtype)


def segsum(a):
    cs = jnp.cumsum(a, axis=-1)
    t = a.shape[-1]
    diff = cs[..., :, None] - cs[..., None, :]
    mask = jnp.tril(jnp.ones((t, t), dtype=bool))
    return jnp.where(mask, diff, -jnp.inf)


def ssd_scan(xh, dt, a, bmat, cmat):
    b, L, H, P = xh.shape
    c = L // CHUNK
    e = H // SSM_GROUPS
    f32 = jnp.float32
    X = (xh.astype(f32) * dt[..., None]).reshape(b, c, CHUNK, SSM_GROUPS, e, P)
    A = (dt * a).reshape(b, c, CHUNK, SSM_GROUPS, e).transpose(0, 3, 4, 1, 2)
    Bc = bmat.astype(f32).reshape(b, c, CHUNK, SSM_GROUPS, SSM_STATE)
    Cc = cmat.astype(f32).reshape(b, c, CHUNK, SSM_GROUPS, SSM_STATE)
    A_cs = jnp.cumsum(A, axis=-1)
    Lmat = jnp.exp(segsum(A))
    CB = jnp.einsum('bclgn,bcsgn->bcgls', Cc, Bc)
    y_diag = jnp.einsum('bcgls,bgecls,bcsgep->bclgep', CB, Lmat, X)
    decay_states = jnp.exp(A_cs[..., -1:] - A_cs)
    states = jnp.einsum('bcsgn,bgecs,bcsgep->bcgepn', Bc, decay_states, X)
    states = jnp.concatenate([jnp.zeros_like(states[:, :1]), states], axis=1)
    chunk_decay = jnp.exp(segsum(jnp.pad(A_cs[..., -1], ((0, 0), (0, 0), (0, 0), (1, 0)))))
    states = jnp.einsum('bgezc,bcgepn->bzgepn', chunk_decay, states)[:, :-1]
    y_off = jnp.einsum('bclgn,bcgepn,bgecl->bclgep', Cc, states, jnp.exp(A_cs))
    return (y_diag + y_off).reshape(b, L, H, P)


def dwconv_centred(x, w, bias):
    out = lax.conv_general_dilated(
        x, w[:, None, :].astype(x.dtype), window_strides=(1,),
        padding=[(D_CONV // 2, D_CONV // 2)],
        dimension_numbers=('NWC', 'WIO', 'NWC'),
        feature_group_count=x.shape[-1])
    return out + bias.astype(x.dtype)


def ssd_mixer(xbc_raw, z, dt_raw, conv_w, conv_b, dt_bias, a_log, d_skip, ssm_norm):
    b, L, _ = xbc_raw.shape
    f32 = jnp.float32
    xbc = jax.nn.silu(dwconv_centred(xbc_raw, conv_w, conv_b))
    xs, bm, cm = jnp.split(xbc, [SSM_INNER, SSM_INNER + SSM_GROUPS * SSM_STATE], axis=-1)
    xh = xs.reshape(b, L, SSM_HEADS, SSM_HEAD_DIM)
    bm = bm.reshape(b, L, SSM_GROUPS, SSM_STATE)
    cm = cm.reshape(b, L, SSM_GROUPS, SSM_STATE)
    dt = jax.nn.softplus(dt_raw.astype(f32).reshape(b, L, 2, SSM_HEADS) + dt_bias.astype(f32))
    a = -jnp.exp(a_log.astype(f32))
    flip = lambda t: jnp.flip(t, axis=1)
    y_f = ssd_scan(xh, dt[:, :, 0], a[0], bm, cm)
    y_b = flip(ssd_scan(flip(xh), flip(dt[:, :, 1]), a[1], flip(bm), flip(cm)))
    y = y_f + y_b + xh.astype(f32) * d_skip.astype(f32)[:, None]
    y = y.reshape(b, L, SSM_INNER) * jax.nn.silu(z.astype(f32))
    yg = y.reshape(b, L, SSM_GROUPS, SSM_INNER // SSM_GROUPS)
    yg = yg * lax.rsqrt(jnp.mean(yg * yg, axis=-1, keepdims=True) + EPS)
    y = yg.reshape(b, L, SSM_INNER) * ssm_norm.astype(f32)
    return y.astype(xbc_raw.dtype)


def axial_angles(L):
    rows = L // GRID_W
    r = jnp.repeat(jnp.arange(rows, dtype=jnp.float32), GRID_W)
    c = jnp.tile(jnp.arange(GRID_W, dtype=jnp.float32), rows)
    half = ATTN_HEAD_DIM // 2
    inv = 1.0 / (ROPE_THETA ** (jnp.arange(0, half, 2, dtype=jnp.float32) / half))
    return r[:, None] * inv, c[:, None] * inv


def rope1d(x, ang):
    cos = jnp.cos(ang)[None, :, None, :]
    sin = jnp.sin(ang)[None, :, None, :]
    x1, x2 = jnp.split(x, 2, axis=-1)
    return jnp.concatenate([x1 * cos - x2 * sin, x2 * cos + x1 * sin], axis=-1)


def axial_rope(x, ang_r, ang_c):
    xf = x.astype(jnp.float32)
    half = ATTN_HEAD_DIM // 2
    out = jnp.concatenate([rope1d(xf[..., :half], ang_r), rope1d(xf[..., half:], ang_c)], axis=-1)
    return out.astype(x.dtype)


def self_attention(q, k, v, q_norm, k_norm):
    b, L, _ = q.shape
    g = ATTN_HEADS // ATTN_KV_HEADS
    q = rmsnorm(q.reshape(b, L, ATTN_HEADS, ATTN_HEAD_DIM), q_norm)
    k = rmsnorm(k.reshape(b, L, ATTN_KV_HEADS, ATTN_HEAD_DIM), k_norm)
    v = v.reshape(b, L, ATTN_KV_HEADS, ATTN_HEAD_DIM)
    ang_r, ang_c = axial_angles(L)
    q = axial_rope(q, ang_r, ang_c)
    k = axial_rope(k, ang_r, ang_c)
    nblk = L // Q_BLOCK
    qb = q.reshape(b, nblk, Q_BLOCK, ATTN_KV_HEADS, g, ATTN_HEAD_DIM).transpose(1, 0, 2, 3, 4, 5)
    scale = ATTN_HEAD_DIM ** -0.5

    def block(qi):
        s = jnp.einsum('bqkgd,bskd->bkgqs', qi, k).astype(jnp.float32) * scale
        p = jax.nn.softmax(s, axis=-1).astype(v.dtype)
        return jnp.einsum('bkgqs,bskd->bqkgd', p, v)

    o = lax.map(block, qb)
    return o.transpose(1, 0, 2, 3, 4, 5).reshape(b, L, ATTN_INNER)


def cross_attention(h, mem_n, wq, wk, wv, wo):
    b, L, _ = h.shape
    m = mem_n.shape[1]
    q = (h @ wq).reshape(b, L, X_HEADS, X_HEAD_DIM)
    k = (mem_n @ wk).reshape(b, m, X_HEADS, X_HEAD_DIM)
    v = (mem_n @ wv).reshape(b, m, X_HEADS, X_HEAD_DIM)
    s = jnp.einsum('blhd,bmhd->bhlm', q, k).astype(jnp.float32) * (X_HEAD_DIM ** -0.5)
    p = jax.nn.softmax(s, axis=-1).astype(v.dtype)
    o = jnp.einsum('bhlm,bmhd->blhd', p, v).reshape(b, L, X_INNER)
    return o @ wo


def encoder_layer(x, mem, p, i):
    h = rmsnorm(x, p['norm_mix_pre'][i])
    proj = h @ p['w_in'][i]
    z, xbc, dtr, q, k, v = jnp.split(proj, IN_SPLIT_IDX, axis=-1)
    y_ssm = ssd_mixer(xbc, z, dtr, p['conv_w'][i], p['conv_b'][i], p['dt_bias'][i],
                      p['a_log'][i], p['d_skip'][i], p['ssm_norm'][i])
    y_att = rmsnorm(self_attention(q, k, v, p['q_norm'][i], p['k_norm'][i]), p['attn_norm'][i])
    mix = jnp.concatenate([y_ssm, y_att], axis=-1) @ p['w_out'][i]
    x = x + rmsnorm(mix, p['norm_mix_post'][i])
    h = rmsnorm(x, p['norm_x_pre'][i])
    m = rmsnorm(mem, p['norm_mem'][i])
    ca = cross_attention(h, m, p['w_xq'][i], p['w_xk'][i], p['w_xv'][i], p['w_xo'][i])
    x = x + rmsnorm(ca, p['norm_x_post'][i])
    h = rmsnorm(x, p['norm_ffn_pre'][i])
    f = (jax.nn.silu(h @ p['w_gate'][i]) * (h @ p['w_up'][i])) @ p['w_down'][i]
    x = x + rmsnorm(f, p['norm_ffn_post'][i])
    return x


def setup_inputs(seed: int = 0) -> dict:
    key = jax.random.key(seed)
    ks = jax.random.split(key, 32)
    f32 = jnp.float32

    def nrm(k, shape, fan_in):
        return jax.random.normal(k, shape, f32) * (fan_in ** -0.5)

    def gain(k, shape):
        return 1.0 + 0.02 * jax.random.normal(k, shape, f32)

    u = jax.random.uniform(ks[8], (DEPTH, 2, SSM_HEADS), f32)
    dt0 = jnp.exp(u * (math.log(DT_MAX) - math.log(DT_MIN)) + math.log(DT_MIN))
    dt_bias = dt0 + jnp.log(-jnp.expm1(-dt0))
    a_log = jnp.log(jax.random.uniform(ks[9], (DEPTH, 2, SSM_HEADS), f32, 1.0, 16.0))
    return {
        'x_prompt': jax.random.normal(ks[0], (BATCH, SEQ, D_MODEL), f32),
        'x_sample': jax.random.normal(ks[1], (DEC_BATCH, DEC_SEQ, D_MODEL), f32),
        'mem_prompt': jax.random.normal(ks[2], (BATCH, N_MEM, D_MODEL), f32),
        'mem_sample': jax.random.normal(ks[3], (DEC_BATCH, N_MEM, D_MODEL), f32),
        'norm_mix_pre': gain(ks[4], (DEPTH, D_MODEL)),
        'w_in': nrm(ks[5], (DEPTH, D_MODEL, D_IN_PROJ), D_MODEL),
        'conv_w': nrm(ks[6], (DEPTH, D_CONV, CONV_DIM), D_CONV),
        'conv_b': 0.01 * jax.random.normal(ks[7], (DEPTH, CONV_DIM), f32),
        'dt_bias': dt_bias,
        'a_log': a_log,
        'd_skip': gain(ks[10], (DEPTH, SSM_HEADS)),
        'ssm_norm': gain(ks[11], (DEPTH, SSM_INNER)),
        'q_norm': gain(ks[12], (DEPTH, ATTN_HEAD_DIM)),
        'k_norm': gain(ks[13], (DEPTH, ATTN_HEAD_DIM)),
        'attn_norm': gain(ks[14], (DEPTH, ATTN_INNER)),
        'w_out': nrm(ks[15], (DEPTH, MIX_WIDTH, D_MODEL), MIX_WIDTH),
        'norm_mix_post': gain(ks[16], (DEPTH, D_MODEL)),
        'norm_x_pre': gain(ks[17], (DEPTH, D_MODEL)),
        'norm_mem': gain(ks[18], (DEPTH, D_MODEL)),
        'w_xq': nrm(ks[19], (DEPTH, D_MODEL, X_INNER), D_MODEL),
        'w_xk': nrm(ks[20], (DEPTH, D_MODEL, X_INNER), D_MODEL),
        'w_xv': nrm(ks[21], (DEPTH, D_MODEL, X_INNER), D_MODEL),
        'w_xo': nrm(ks[22], (DEPTH, X_INNER, D_MODEL), X_INNER),
        'norm_x_post': gain(ks[23], (DEPTH, D_MODEL)),
        'norm_ffn_pre': gain(ks[24], (DEPTH, D_MODEL)),
        'w_gate': nrm(ks[25], (DEPTH, D_MODEL, D_FF), D_MODEL),
        'w_up': nrm(ks[26], (DEPTH, D_MODEL, D_FF), D_MODEL),
        'w_down': nrm(ks[27], (DEPTH, D_FF, D_MODEL), D_FF),
        'norm_ffn_post': gain(ks[28], (DEPTH, D_MODEL)),
    }


def reference(x_prompt, x_sample, mem_prompt, mem_sample, norm_mix_pre, w_in, conv_w, conv_b,
              dt_bias, a_log, d_skip, ssm_norm, q_norm, k_norm, attn_norm, w_out, norm_mix_post,
              norm_x_pre, norm_mem, w_xq, w_xk, w_xv, w_xo, norm_x_post, norm_ffn_pre,
              w_gate, w_up, w_down, norm_ffn_post):
    p = {
        'norm_mix_pre': norm_mix_pre, 'w_in': w_in, 'conv_w': conv_w, 'conv_b': conv_b,
        'dt_bias': dt_bias, 'a_log': a_log, 'd_skip': d_skip, 'ssm_norm': ssm_norm,
        'q_norm': q_norm, 'k_norm': k_norm, 'attn_norm': attn_norm, 'w_out': w_out,
        'norm_mix_post': norm_mix_post, 'norm_x_pre': norm_x_pre, 'norm_mem': norm_mem,
        'w_xq': w_xq, 'w_xk': w_xk, 'w_xv': w_xv, 'w_xo': w_xo, 'norm_x_post': norm_x_post,
        'norm_ffn_pre': norm_ffn_pre, 'w_gate': w_gate, 'w_up': w_up, 'w_down': w_down,
        'norm_ffn_post': norm_ffn_post,
    }
    y_prompt = x_prompt
    y_sample = x_sample
    for i in range(DEPTH):
        y_prompt = encoder_layer(y_prompt, mem_prompt, p, i)
        y_sample = encoder_layer(y_sample, mem_sample, p, i)
    return (y_prompt, y_sample)
```

```cpp
#include <hip/hip_runtime.h>
#include <hip/hip_cooperative_groups.h>
#include <cstdio>
#include <cstdint>
namespace pg8 {
#define PG8_LAS __attribute__((address_space(3)))
typedef unsigned short bf16_t;
typedef short bf16x8 __attribute__((ext_vector_type(8)));
typedef float f32x4 __attribute__((ext_vector_type(4)));
typedef unsigned u32x4 __attribute__((ext_vector_type(4)));
constexpr int BM = 256, BK = 64, HALF = 128, HTB = HALF * BK * 2  , STAGE_BYTES = 8 * HTB, NXCD = 8, WGM = 8;

__host__ __device__ __forceinline__ int lds_byte(int r, int c) { const int st = (r >> 4) * 2 + (c >> 5), rr = r & 15, cc = c & 31, ob = rr * 64 + cc * 2; return st * 1024 + (ob ^ (((ob >> 9) & 1) << 5)); }
__host__ __device__ __forceinline__ void stage_rc(int b, int& R, int& C) { const int st = b / 1024, sb = b % 1024, swz = sb ^ (((sb >> 9) & 1) << 5); R = (st >> 1) * 16 + swz / 64; C = (st & 1) * 32 + (swz % 64) / 2; }
__host__ __device__ __forceinline__ int perm32(int rho) { const int n = rho >> 4, i = rho & 15; return 8 * (i >> 2) + 4 * n + (i & 3); }

struct Unit { int pm, pn; };
struct Gemm { const bf16_t* A; const bf16_t* Bt; int M, N, K, lda; long a2off; int pm2; };

struct StaticOrder {
    int nM, nN, nwg, G, c;
    __host__ __device__ __forceinline__ void init(int M, int N, int G_, int c_) { nM = M / BM; nN = N / BM; nwg = nM * nN; G = G_; c = c_; }
    __host__ __device__ __forceinline__ bool next(int i, Unit& u) const {
        const long L = (long)i * G + c; if (L >= nwg) return false;
        int wgid = (int)L; { const int q = nwg / NXCD, r = nwg % NXCD, xcd = wgid % NXCD, off = wgid / NXCD; wgid = (xcd < r ? xcd * (q + 1) : r * (q + 1) + (xcd - r) * q) + off; }
        const int nig = WGM * nN, gid = wgid / nig, fm = gid * WGM, gsz = (nM - fm) < WGM ? (nM - fm) : WGM;
        u.pm = fm + ((wgid % nig) % gsz); u.pn = (wgid % nig) / gsz; return true;
    }
    __device__ __forceinline__ void a_ready(const Unit&) const {}
    __device__ __forceinline__ void done(const Unit&) const {}
};

template <class Epi, class Sched, bool ALIGN_EPI = false, bool SP2 = false>
__device__ __forceinline__ void gemm_phase(PG8_LAS unsigned char* lds, const Gemm g, const Sched& S, const Epi& E) {
    int tid_l = threadIdx.x; asm volatile("" : "+v"(tid_l));
    const int tid = tid_l, wid = __builtin_amdgcn_readfirstlane(tid >> 6), lane = tid & 63, wr = wid >> 2, wc = wid & 3, fr = lane & 15, fq = lane >> 4;
    const int K = g.K, nt = K / BK, lda = g.lda;
    unsigned voffA[2], voffB[2];
#pragma unroll
    for (int i = 0; i < 2; ++i) { int R, C; stage_rc(tid * 16 + i * 8192, R, C); const int Rb = Epi::PERM ? ((R & ~31) + perm32(R & 31)) : R;
        voffA[i] = (unsigned)(R * lda + C) * 2u; voffB[i] = (unsigned)(Rb * K + C) * 2u; }
    const size_t kstep = (size_t)(BK * 2);
    const size_t hstepB = (size_t)HALF * K * 2, hstepA = (size_t)HALF * lda * 2;
    const size_t tstepB = 2 * hstepB, tstepA = 2 * hstepA;
    const unsigned ldsw = (unsigned)wid * 1024u;
    const int aoff = lds_byte(wr * 64 + fr, fq * 8), boff = lds_byte(wc * 32 + fr, fq * 8);
#define PG8_SA(b, h) (((b) * 2 + (h)) * HTB)
#define PG8_SB(b, h) ((4 + (b) * 2 + (h)) * HTB)
#define PG8_STAGE(bufoff, gbase, voff) do { _Pragma("unroll") for (int _i = 0; _i < 2; ++_i) \
        __builtin_amdgcn_global_load_lds((const unsigned*)((const char*)(gbase) + (voff)[_i]), (PG8_LAS unsigned*)(lds + (bufoff) + ldsw + _i * 8192), 16, 0, 0); } while (0)
#define PG8_LDA(dst, b, h) do { _Pragma("unroll") for (int m = 0; m < 4; ++m) _Pragma("unroll") for (int k = 0; k < 2; ++k) dst[m][k] = *(const PG8_LAS bf16x8*)(lds + PG8_SA(b, h) + aoff + m * 2048 + k * 1024); } while (0)
#define PG8_LDB(dst, b, h) do { _Pragma("unroll") for (int n = 0; n < 2; ++n) _Pragma("unroll") for (int k = 0; k < 2; ++k) dst[n][k] = *(const PG8_LAS bf16x8*)(lds + PG8_SB(b, h) + boff + n * 2048 + k * 1024); } while (0)
#define PG8_MMA(ai, bj, At, Bt) do { __builtin_amdgcn_s_setprio(1); _Pragma("unroll") for (int m = 0; m < 4; ++m) _Pragma("unroll") for (int n = 0; n < 2; ++n) _Pragma("unroll") for (int k = 0; k < 2; ++k) \
        acc[ai][bj][m][n] = __builtin_amdgcn_mfma_f32_16x16x32_bf16(Bt[n][k], At[m][k], acc[ai][bj][m][n], 0, 0, 0); __builtin_amdgcn_s_setprio(0); } while (0)
#define PG8_WAIT_V(n) asm volatile("s_waitcnt vmcnt(" #n ")" ::: "memory")
#define PG8_WAIT_L(n) asm volatile("s_waitcnt lgkmcnt(" #n ")" ::: "memory")
#define PG8_BAR __builtin_amdgcn_s_barrier()
#define PG8_SCHED __builtin_amdgcn_sched_barrier(0)
    Unit cur, nxt; int ui = 0;
    if (!S.next(0, cur)) return;
    f32x4 acc[2][2][4][2];
#pragma unroll
    for (int a = 0; a < 2; ++a)
#pragma unroll
        for (int b = 0; b < 2; ++b)
#pragma unroll
            for (int m = 0; m < 4; ++m)
#pragma unroll
                for (int n = 0; n < 2; ++n) acc[a][b][m][n] = (f32x4){0.f, 0.f, 0.f, 0.f};
    bf16x8 At[4][2], B0[2][2], B1[2][2];
    const char* cA = (const char*)g.A + (cur.pm < g.pm2 ? (long)cur.pm * (long)tstepA : g.a2off + (long)(cur.pm - g.pm2) * (long)tstepA); const char* cB = (const char*)g.Bt + (size_t)cur.pn * tstepB;
    S.a_ready(cur);
    if constexpr (SP2) {
        PG8_STAGE(PG8_SB(0, 0), cB, voffB); PG8_STAGE(PG8_SB(0, 1), cB + hstepB, voffB); PG8_STAGE(PG8_SA(0, 0), cA, voffA); PG8_STAGE(PG8_SA(0, 1), cA + hstepA, voffA);
        if (wr == 1) PG8_BAR;
        PG8_WAIT_V(2); PG8_BAR;
        PG8_STAGE(PG8_SB(1, 0), cB + kstep, voffB); PG8_STAGE(PG8_SA(1, 0), cA + kstep, voffA); PG8_STAGE(PG8_SB(1, 1), cB + hstepB + kstep, voffB);
        PG8_WAIT_V(6); PG8_BAR;
    } else {
        PG8_STAGE(PG8_SB(0, 0), cB, voffB); PG8_STAGE(PG8_SA(0, 0), cA, voffA); PG8_STAGE(PG8_SB(0, 1), cB + hstepB, voffB); PG8_STAGE(PG8_SA(0, 1), cA + hstepA, voffA);
        if (wr == 1) PG8_BAR;
        PG8_WAIT_V(4); PG8_BAR;
        PG8_STAGE(PG8_SB(1, 0), cB + kstep, voffB); PG8_STAGE(PG8_SA(1, 0), cA + kstep, voffA); PG8_STAGE(PG8_SB(1, 1), cB + hstepB + kstep, voffB);
        PG8_WAIT_V(6); PG8_BAR;
    }
    for (;;) {
        const bool has_next = S.next(ui + 1, nxt);
        const char* nA = has_next ? (const char*)g.A + (nxt.pm < g.pm2 ? (long)nxt.pm * (long)tstepA : g.a2off + (long)(nxt.pm - g.pm2) * (long)tstepA) : cA; const char* nB = has_next ? (const char*)g.Bt + (size_t)nxt.pn * tstepB : cB;
        for (int t = 0; t < nt; t += 2) {
            if constexpr (Epi::RESCALE) { if (t == 8 || t == 16) E.rescale(acc, ui, t, wr, fr); }
            const bool last = (t == nt - 2);
            const char* a1 = cA + (size_t)(t + 1) * kstep;
            const char* a2 = last ? nA : cA + (size_t)(t + 2) * kstep; const char* b2 = last ? nB : cB + (size_t)(t + 2) * kstep;
            const char* a3 = a2 + kstep; const char* b3 = b2 + kstep;
            if (last && has_next) S.a_ready(nxt);
            if constexpr (SP2) {
            PG8_LDB(B0, 0, 0); PG8_LDB(B1, 0, 1); PG8_SCHED; PG8_LDA(At, 0, 0); PG8_STAGE(PG8_SA(1, 1), a1 + hstepA, voffA);
            PG8_WAIT_V(8); PG8_WAIT_L(0); PG8_BAR; PG8_MMA(0, 0, At, B0); PG8_MMA(0, 1, At, B1); PG8_BAR; PG8_SCHED;
            PG8_LDA(At, 0, 1); PG8_STAGE(PG8_SB(0, 0), b2, voffB); PG8_STAGE(PG8_SB(0, 1), b2 + hstepB, voffB); PG8_STAGE(PG8_SA(0, 0), a2, voffA);
            PG8_WAIT_V(8); PG8_WAIT_L(0); PG8_BAR; PG8_MMA(1, 0, At, B0); PG8_MMA(1, 1, At, B1); PG8_BAR; PG8_SCHED;
            PG8_LDB(B0, 1, 0); PG8_LDB(B1, 1, 1); PG8_SCHED; PG8_LDA(At, 1, 0); PG8_STAGE(PG8_SA(0, 1), a2 + hstepA, voffA);
            PG8_WAIT_V(8); PG8_WAIT_L(0); PG8_BAR; PG8_MMA(0, 0, At, B0); PG8_MMA(0, 1, At, B1); PG8_BAR; PG8_SCHED;
            PG8_LDA(At, 1, 1); PG8_STAGE(PG8_SB(1, 0), b3, voffB); PG8_STAGE(PG8_SB(1, 1), b3 + hstepB, voffB); PG8_STAGE(PG8_SA(1, 0), a3, voffA);
            PG8_WAIT_V(8); PG8_WAIT_L(0); PG8_BAR; PG8_MMA(1, 0, At, B0); PG8_MMA(1, 1, At, B1); PG8_BAR; PG8_SCHED;
            } else {
            PG8_LDB(B0, 0, 0); PG8_SCHED; PG8_LDA(At, 0, 0); PG8_STAGE(PG8_SA(1, 1), a1 + hstepA, voffA);
            PG8_WAIT_L(8); PG8_BAR; PG8_WAIT_L(0); PG8_MMA(0, 0, At, B0); PG8_BAR; PG8_SCHED;
            PG8_LDB(B1, 0, 1); PG8_STAGE(PG8_SB(0, 0), b2, voffB);
            PG8_BAR; PG8_WAIT_L(0); PG8_MMA(0, 1, At, B1); PG8_BAR;
            PG8_LDA(At, 0, 1); PG8_STAGE(PG8_SA(0, 0), a2, voffA);
            PG8_BAR; PG8_WAIT_L(0); PG8_MMA(1, 0, At, B0); PG8_BAR; PG8_SCHED;
            PG8_STAGE(PG8_SB(0, 1), b2 + hstepB, voffB);
            PG8_WAIT_V(6); PG8_BAR; PG8_MMA(1, 1, At, B1); PG8_BAR;
            PG8_LDB(B0, 1, 0); PG8_SCHED; PG8_LDA(At, 1, 0); PG8_STAGE(PG8_SA(0, 1), a2 + hstepA, voffA);
            PG8_WAIT_L(8); PG8_BAR; PG8_WAIT_L(0); PG8_MMA(0, 0, At, B0); PG8_BAR; PG8_SCHED;
            PG8_LDB(B1, 1, 1); PG8_STAGE(PG8_SB(1, 0), b3, voffB);
            PG8_BAR; PG8_WAIT_L(0); PG8_MMA(0, 1, At, B1); PG8_BAR;
            PG8_LDA(At, 1, 1); PG8_STAGE(PG8_SA(1, 0), a3, voffA);
            PG8_BAR; PG8_WAIT_L(0); PG8_MMA(1, 0, At, B0); PG8_BAR; PG8_SCHED;
            PG8_STAGE(PG8_SB(1, 1), b3 + hstepB, voffB);
            PG8_WAIT_V(6); PG8_BAR; PG8_MMA(1, 1, At, B1); PG8_BAR;
            }
        }
        if constexpr (ALIGN_EPI) { if (wr == 0) PG8_BAR; }
        if constexpr (Epi::RESCALE) { E.fin(acc, cur, ui, wr, wc, fr, fq); } else if constexpr (!Epi::AFTER_DRAIN) { E(acc, cur, wr, wc, fr, fq); S.done(cur); }
        if (!has_next) break;
#pragma unroll
        for (int a = 0; a < 2; ++a)
#pragma unroll
            for (int b = 0; b < 2; ++b)
#pragma unroll
                for (int m = 0; m < 4; ++m)
#pragma unroll
                    for (int n = 0; n < 2; ++n) acc[a][b][m][n] = (f32x4){0.f, 0.f, 0.f, 0.f};
        cur = nxt; cA = nA; cB = nB; ++ui;
        if constexpr (ALIGN_EPI) { if (wr == 1) PG8_BAR; }
    }
    PG8_WAIT_V(0);
    if constexpr (!ALIGN_EPI) { if (wr == 0) PG8_BAR; }
    PG8_BAR;
    if constexpr (Epi::AFTER_DRAIN) { E.fused(acc, cur, wr, wc, fr, fq, lds, wid, lane); S.done(cur); }
#undef PG8_SA
#undef PG8_SB
#undef PG8_STAGE
#undef PG8_LDA
#undef PG8_LDB
#undef PG8_MMA
#undef PG8_WAIT_V
#undef PG8_WAIT_L
#undef PG8_BAR
#undef PG8_SCHED
}
}

#include <hip/hip_bf16.h>
#include <cmath>
namespace attn_body {
using bf16=__hip_bfloat16;
using bf16x8=__attribute__((ext_vector_type(8)))short;
using s16x4=__attribute__((ext_vector_type(4)))short;
using f32x16=__attribute__((ext_vector_type(16)))float;
using u32x4=__attribute__((ext_vector_type(4)))unsigned;
constexpr int D=64,DM=3584;
constexpr int NW=8,QBLK=32,QB=QBLK*NW,KVBLK=64;
constexpr int ATTN_PITCH=DM, ATTN_UNIT_ROWS=QB;
__device__ __forceinline__ int crow(int r,int hi){return (r&3)+8*(r>>2)+4*hi;}
#define SBAR() __builtin_amdgcn_sched_barrier(0)
constexpr int NSLOT=3, SLOTB=8192;
constexpr int LDS_K=0, LDS_V=NSLOT*SLOTB, LDS_WS=2*NSLOT*SLOTB, LDS_OST=LDS_WS+NW*64*4, LDS_BYTES=LDS_OST+NW*4096;
constexpr float C2=0.125f*1.4426950408889634f;
__device__ __forceinline__ void glds16(const void*gsrc,unsigned lds_dst){unsigned keep;
  asm volatile("s_mov_b32 %0, m0\n\ts_mov_b32 m0, %2\n\ts_nop 0\n\tglobal_load_lds_dwordx4 %1, off\n\ts_mov_b32 m0, %0":"=&s"(keep):"v"(gsrc),"s"(lds_dst):"memory");}
__device__ __forceinline__ float max3f(float a,float b,float c){float r;asm("v_max3_f32 %0, %1, %2, %3":"=v"(r):"v"(a),"v"(b),"v"(c));return r;}
__device__ __forceinline__ float max2f(float a,float b){float r;asm("v_max_f32_e32 %0, %1, %2":"=v"(r):"v"(a),"v"(b));return r;}
__device__ __forceinline__ float fadd_s(float a,float b){float r;asm("v_add_f32_e32 %0, %1, %2":"=v"(r):"v"(a),"v"(b));return r;}
__device__ __forceinline__ float fsub_s(float a,float b){float r;asm("v_sub_f32_e32 %0, %1, %2":"=v"(r):"v"(a),"v"(b));return r;}
typedef float f32x2_t __attribute__((ext_vector_type(2))); typedef __bf16 bf16x2_t __attribute__((ext_vector_type(2)));
__device__ __forceinline__ unsigned cvtpk_s(float lo,float hi){f32x2_t v={lo,hi};bf16x2_t b=__builtin_convertvector(v,bf16x2_t);return __builtin_bit_cast(unsigned,b);}
#define WAIT_BAR(N) asm volatile("s_waitcnt vmcnt(" #N ") lgkmcnt(0)\n\ts_barrier":::"memory")

__device__ __forceinline__ void qkt(f32x16&p0,f32x16&p1,const char*Kslot,const bf16x8*qr,const f32x16&negm,int r32,int hi){
  const char*kb=Kslot+hi*1024+r32*16;
  #pragma unroll
  for(int d0=0;d0<4;++d0){
    const bf16x8 b0=*reinterpret_cast<const bf16x8*>(kb+d0*2048);
    const bf16x8 b1=*reinterpret_cast<const bf16x8*>(kb+d0*2048+512);
    if(d0==0){p0=__builtin_amdgcn_mfma_f32_32x32x16_bf16(b0,qr[0],negm,0,0,0);p1=__builtin_amdgcn_mfma_f32_32x32x16_bf16(b1,qr[0],negm,0,0,0);}
    else{p0=__builtin_amdgcn_mfma_f32_32x32x16_bf16(b0,qr[d0],p0,0,0,0);p1=__builtin_amdgcn_mfma_f32_32x32x16_bf16(b1,qr[d0],p1,0,0,0);}}
}
typedef __attribute__((address_space(3))) const char* lds_cptr;
typedef short v4i16_t __attribute__((ext_vector_type(4)));
__device__ __forceinline__ void kload8(bf16x8*kf,lds_cptr kp){
  kf[0]=*(const __attribute__((address_space(3))) bf16x8*)(kp);      kf[1]=*(const __attribute__((address_space(3))) bf16x8*)(kp+512);
  kf[2]=*(const __attribute__((address_space(3))) bf16x8*)(kp+2048); kf[3]=*(const __attribute__((address_space(3))) bf16x8*)(kp+2560);
  kf[4]=*(const __attribute__((address_space(3))) bf16x8*)(kp+4096); kf[5]=*(const __attribute__((address_space(3))) bf16x8*)(kp+4608);
  kf[6]=*(const __attribute__((address_space(3))) bf16x8*)(kp+6144); kf[7]=*(const __attribute__((address_space(3))) bf16x8*)(kp+6656);
}
__device__ __forceinline__ void kload2(bf16x8*kf,lds_cptr kp,int j){ kf[2*j]=*(const __attribute__((address_space(3))) bf16x8*)(kp+j*2048); kf[2*j+1]=*(const __attribute__((address_space(3))) bf16x8*)(kp+j*2048+512); }
__device__ __forceinline__ s16x4 vtr(lds_cptr p){ return __builtin_bit_cast(s16x4,__builtin_amdgcn_ds_read_tr16_b64_v4i16((__attribute__((address_space(3))) v4i16_t*)p)); }
__device__ __forceinline__ float rowmax(const f32x16&p0,const f32x16&p1){
  float a=max3f(p0[0],p0[1],p1[0]),b=max3f(p0[2],p0[3],p1[1]);a=max3f(a,p1[2],p1[3]);
  #pragma unroll
  for(int r=4;r<16;r+=4){a=max3f(a,p0[r],p0[r+1]);b=max3f(b,p0[r+2],p0[r+3]);a=max3f(a,p1[r],p1[r+1]);b=max3f(b,p1[r+2],p1[r+3]);}
  const float m=max2f(a,b);
  auto rr=__builtin_amdgcn_permlane32_swap(__float_as_uint(m),__float_as_uint(m),false,false);
  return max2f(__uint_as_float(rr[0]),__uint_as_float(rr[1]));
}
__device__ __forceinline__ void pv(f32x16*o,int vb,bf16x8 pa0,bf16x8 pa1,bf16x8 pa2,bf16x8 pa3){
  #pragma unroll
  for(int d0=0;d0<2;++d0){s16x4 lo[4],hi[4];
    #pragma unroll
    for(int ks=0;ks<4;++ks){
      asm volatile("ds_read_b64_tr_b16 %0,%1 offset:%c2":"=&v"(lo[ks]):"v"(vb),"i"(d0*4096+ks*1024):"memory");
      asm volatile("ds_read_b64_tr_b16 %0,%1 offset:%c2":"=&v"(hi[ks]):"v"(vb),"i"(d0*4096+ks*1024+512):"memory");}
    asm volatile("s_waitcnt lgkmcnt(0)":::"memory");SBAR();
    #define PK(k) (bf16x8){lo[k][0],lo[k][1],lo[k][2],lo[k][3],hi[k][0],hi[k][1],hi[k][2],hi[k][3]}
    o[d0]=__builtin_amdgcn_mfma_f32_32x32x16_bf16(pa0,PK(0),o[d0],0,0,0);
    o[d0]=__builtin_amdgcn_mfma_f32_32x32x16_bf16(pa1,PK(1),o[d0],0,0,0);
    o[d0]=__builtin_amdgcn_mfma_f32_32x32x16_bf16(pa2,PK(2),o[d0],0,0,0);
    o[d0]=__builtin_amdgcn_mfma_f32_32x32x16_bf16(pa3,PK(3),o[d0],0,0,0);
    #undef PK
  }
}

#ifndef ATTN_STORE16
#define ATTN_STORE16(p,v) (*(u32x4*)(p)=(v))
#endif
template<int THRL,bool FAST> __device__ __forceinline__ void attn_unit(float bref,long rowbase,int seqlen,int h,int qb,const bf16*Q,const bf16*__restrict__ K,const bf16*__restrict__ V,bf16*O,float*SSQ,char*shm){
  int tid_l=threadIdx.x; asm volatile("":"+v"(tid_l)); const int tid=tid_l,lane=tid&63,r32=lane&31,hi=lane>>5; const int wid=__builtin_amdgcn_readfirstlane(tid>>6);
  const int q0=qb*QB; const int kvh=h>>2;
  const bf16*Qw=Q+(rowbase+q0+wid*QBLK)*DM+h*D;
  constexpr int KDM=64; constexpr long KVTOK=81920;
  const bf16*Kh=K+((long)kvh*KVTOK+rowbase)*KDM,*Vh=V+((long)kvh*KVTOK+rowbase)*KDM;
  const unsigned lds0=(unsigned)(uintptr_t)shm;
  float*wsf=(float*)(shm+LDS_WS)+wid*64;
  const bf16*ksrc=Kh+(long)lane*KDM+wid*8;
  const bf16*vsrc=Vh+(long)(16*(wid&3)+(lane>>2))*KDM+(wid>>2)*32+(lane&3)*8;
  const unsigned kdst=lds0+LDS_K+wid*1024, vdst=lds0+LDS_V+wid*1024;
  #define DMA_K(t,slot) glds16(ksrc+(long)(t)*KVBLK*KDM,(unsigned)__builtin_amdgcn_readfirstlane(kdst+(slot)))
  #define DMA_V(t,slot) glds16(vsrc+(long)(t)*KVBLK*KDM,(unsigned)__builtin_amdgcn_readfirstlane(vdst+(slot)))
  const int vb0=(int)(lds0+LDS_V)+((lane>>4)&1)*32+(lane&3)*8+(4*hi+((lane&15)>>2))*64;
  const char*Kbase=shm+LDS_K; bf16x8 kf[8];
  const lds_cptr shm3=(lds_cptr)shm; const lds_cptr kp0=shm3+LDS_K+hi*1024+r32*16; const lds_cptr vp0=shm3+LDS_V+((lane>>4)&1)*32+(lane&3)*8+(4*hi+((lane&15)>>2))*64;
  const int NT=seqlen/KVBLK;
  DMA_K(0,0);DMA_V(0,0);DMA_K(1,SLOTB);
  bf16x8 qr[4];
  #pragma unroll
  for(int d0=0;d0<4;++d0)qr[d0]=*reinterpret_cast<const bf16x8*>(&Qw[(long)r32*DM+d0*16+hi*8]);
  float mhat=FAST?bref:0.f,l_reg=0.f;f32x16 o[2];o[0]=f32x16{};o[1]=f32x16{};f32x16 negm=f32x16{};
  if constexpr(FAST){
    #pragma unroll
    for(int r=0;r<16;++r)negm[r]=-bref;}
  asm volatile("":"+v"(negm));
  #define CMASK(P0,P1,t) do{}while(0)
  bool resc=false;
  #define START(P0,P1) do{ resc=false; \
    if constexpr(!FAST){ const float rm=rowmax(P0,P1); const float dl=rm; mhat=fadd_s(mhat,dl); \
      _Pragma("unroll") for(int r=0;r<16;++r){P0[r]=fsub_s(P0[r],dl);P1[r]=fsub_s(P1[r],dl);} \
      _Pragma("unroll") for(int r=0;r<16;++r)negm[r]=-mhat; asm volatile("":"+v"(negm)); } \
    _Pragma("unroll") for(int r=0;r<16;++r)P0[r]=__builtin_amdgcn_exp2f(P0[r]); }while(0)
  #define RESC() do{ if(resc){ asm volatile("s_waitcnt lgkmcnt(0)":::"memory"); \
      _Pragma("unroll") for(int d_=0;d_<2;++d_) _Pragma("unroll") for(int r=0;r<16;++r)o[d_][r]*=wsf[crow(r,hi)]; } }while(0)
  f32x16 pA0,pA1,pB0,pB1;
  int sl_prev=0,sl_cur=0,sl_next=SLOTB;
  #define ROT() do{sl_prev=sl_cur;sl_cur=sl_next;sl_next=(sl_next==(NSLOT-1)*SLOTB)?0:sl_next+SLOTB;}while(0)
  DMA_K(2,2*SLOTB);
  WAIT_BAR(3);
  qkt(pA0,pA1,Kbase,qr,negm,r32,hi);asm volatile("s_nop 15\n\ts_nop 7":"+v"(pA0),"+v"(pA1));
  START(pA0,pA1);
  _Pragma("unroll") for(int r=0;r<16;++r)pA1[r]=__builtin_amdgcn_exp2f(pA1[r]);
  WAIT_BAR(0);
  DMA_K(3,0);DMA_V(1,SLOTB);
  ROT();
  kload8(kf,kp0+sl_cur);
  WAIT_BAR(2);
  s16x4 vlo[8],vhi[8]; u32x4 pw0,pw1,pw2,pw3;
  #define PKW(P,B) cvtpk_s(P[B],P[B+1])
  #define PAF(k) __builtin_bit_cast(bf16x8,pw##k)
  #define VFR(i) (bf16x8){vlo[i][0],vlo[i][1],vlo[i][2],vlo[i][3],vhi[i][0],vhi[i][1],vhi[i][2],vhi[i][3]}
  #define PIN(x) asm volatile("":"+v"(x))
  #define MX3(a,b,c) __builtin_fmaxf(__builtin_fmaxf((a),(b)),(c))
  #define GAPA(MF,A0,A1,A2,A3,W0,W1,PW) do{ MF; sacc+=A0; sacc+=A1; sacc+=A2; sacc+=A3; PIN(sacc); W0; W1; PIN(PW); SBAR(); }while(0)
  #define EX(v) __builtin_amdgcn_exp2f(v)
  #define GAPB(MF,X,B) do{ MF; X[B]=EX(X[B]); X[B+1]=EX(X[B+1]); X[B+2]=EX(X[B+2]); X[B+3]=EX(X[B+3]); PIN(X); SBAR(); }while(0)
  #define VRD(i) do{ vlo[i]=vtr(vp_+(((i)>>2)*4096+((i)&3)*1024)); vhi[i]=vtr(vp_+(((i)>>2)*4096+((i)&3)*1024+512)); }while(0)
  #define KRD(G,j) do{ if(G){ kload2(kf,kp0+sl_next,j); SBAR(); } }while(0)
  #define STEP(C0,C1,P0,P1,t,GK,GV,GL) do{ SBAR(); \
    const lds_cptr vp_=vp0+sl_prev; \
    VRD(0); SBAR(); float sacc=(P0[0]+P0[1]); \
    GAPA(C0=__builtin_amdgcn_mfma_f32_32x32x16_bf16(kf[0],qr[0],negm,0,0,0), P0[2],P0[3],P0[4],P0[5],     pw0[0]=PKW(P0,0), pw0[1]=PKW(P0,2), pw0); \
    VRD(4); SBAR(); GAPA(C1=__builtin_amdgcn_mfma_f32_32x32x16_bf16(kf[1],qr[0],negm,0,0,0), P0[6],P0[7],P0[8],P0[9],     pw0[2]=PKW(P0,4), pw0[3]=PKW(P0,6), pw0); \
    VRD(1); SBAR(); GAPA(C0=__builtin_amdgcn_mfma_f32_32x32x16_bf16(kf[2],qr[1],C0,0,0,0),   P0[10],P0[11],P0[12],P0[13], pw1[0]=PKW(P0,8), pw1[1]=PKW(P0,10), pw1); \
    VRD(5); SBAR(); GAPA(C1=__builtin_amdgcn_mfma_f32_32x32x16_bf16(kf[3],qr[1],C1,0,0,0),   P0[14],P0[15],P1[0],P1[1],   pw1[2]=PKW(P0,12),pw1[3]=PKW(P0,14), pw1); \
    VRD(2); SBAR(); GAPA(C0=__builtin_amdgcn_mfma_f32_32x32x16_bf16(kf[4],qr[2],C0,0,0,0),   P1[2],P1[3],P1[4],P1[5],     pw2[0]=PKW(P1,0), pw2[1]=PKW(P1,2), pw2); \
    VRD(6); SBAR(); GAPA(C1=__builtin_amdgcn_mfma_f32_32x32x16_bf16(kf[5],qr[2],C1,0,0,0),   P1[6],P1[7],P1[8],P1[9],     pw2[2]=PKW(P1,4), pw2[3]=PKW(P1,6), pw2); \
    VRD(3); SBAR(); GAPA(C0=__builtin_amdgcn_mfma_f32_32x32x16_bf16(kf[6],qr[3],C0,0,0,0),   P1[10],P1[11],P1[12],P1[13], pw3[0]=PKW(P1,8), pw3[1]=PKW(P1,10), pw3); \
    VRD(7); SBAR(); GAPA(C1=__builtin_amdgcn_mfma_f32_32x32x16_bf16(kf[7],qr[3],C1,0,0,0),   P1[14],P1[15],0.f,0.f,       pw3[2]=PKW(P1,12),pw3[3]=PKW(P1,14), pw3); \
    l_reg+=sacc; \
    if(GK){DMA_K((t)+3,sl_cur);} if(GV){DMA_V((t)+1,sl_next);} \
    CMASK(C0,C1,t); \
    if constexpr(!FAST){ float a=MX3(C0[0],C0[1],C1[0]),b=MX3(C0[2],C0[3],C1[1]); a=MX3(a,C1[2],C1[3]); \
      _Pragma("unroll") for(int r=4;r<16;r+=4){a=MX3(a,C0[r],C0[r+1]);b=MX3(b,C0[r+2],C0[r+3]);a=MX3(a,C1[r],C1[r+1]);b=MX3(b,C1[r+2],C1[r+3]);} \
      float rm=__builtin_fmaxf(a,b); { auto rr=__builtin_amdgcn_permlane32_swap(__float_as_uint(rm),__float_as_uint(rm),false,false); rm=__builtin_fmaxf(__uint_as_float(rr[0]),__uint_as_float(rr[1])); } \
      resc=false; \
      if(__builtin_expect(__any(rm>(float)THRL),0)){ const float dl=__builtin_fmaxf(rm,0.f); mhat+=dl; \
        _Pragma("unroll") for(int r=0;r<16;++r){C0[r]-=dl;C1[r]-=dl;} \
        _Pragma("unroll") for(int r=0;r<16;++r)negm[r]=-mhat; asm volatile("":"+v"(negm)); \
        const float f=__builtin_amdgcn_exp2f(-dl); l_reg*=f; if(hi==0)wsf[r32]=f; resc=true; } } \
    SBAR(); \
    GAPB(o[0]=__builtin_amdgcn_mfma_f32_32x32x16_bf16(PAF(0),VFR(0),o[0],0,0,0), C0,0); \
    GAPB(o[1]=__builtin_amdgcn_mfma_f32_32x32x16_bf16(PAF(0),VFR(4),o[1],0,0,0), C0,4); \
    KRD(GL,0); GAPB(o[0]=__builtin_amdgcn_mfma_f32_32x32x16_bf16(PAF(1),VFR(1),o[0],0,0,0), C0,8); \
    KRD(GL,1); GAPB(o[1]=__builtin_amdgcn_mfma_f32_32x32x16_bf16(PAF(1),VFR(5),o[1],0,0,0), C0,12); \
    KRD(GL,2); GAPB(o[0]=__builtin_amdgcn_mfma_f32_32x32x16_bf16(PAF(2),VFR(2),o[0],0,0,0), C1,0); \
    KRD(GL,3); GAPB(o[1]=__builtin_amdgcn_mfma_f32_32x32x16_bf16(PAF(2),VFR(6),o[1],0,0,0), C1,4); \
    GAPB(o[0]=__builtin_amdgcn_mfma_f32_32x32x16_bf16(PAF(3),VFR(3),o[0],0,0,0), C1,8); \
    GAPB(o[1]=__builtin_amdgcn_mfma_f32_32x32x16_bf16(PAF(3),VFR(7),o[1],0,0,0), C1,12); \
    }while(0)
  int t=1;
  for(;t+5<NT;t+=2){
    STEP(pB0,pB1,pA0,pA1,t,true,true,true);     WAIT_BAR(2); RESC(); ROT();
    STEP(pA0,pA1,pB0,pB1,t+1,true,true,true);   WAIT_BAR(2); RESC(); ROT();
  }
  #define ENDW(tt) do{ if((tt)+3<NT){WAIT_BAR(2);} else if((tt)+2<NT){WAIT_BAR(1);} else {WAIT_BAR(0);} }while(0)
  for(;t+1<NT;t+=2){
    STEP(pB0,pB1,pA0,pA1,t,(t+3<NT),(t+1<NT),(t+1<NT));       ENDW(t);   RESC(); ROT();
    STEP(pA0,pA1,pB0,pB1,t+1,(t+4<NT),(t+2<NT),(t+2<NT));     ENDW(t+1); RESC(); ROT();
  }
  STEP(pB0,pB1,pA0,pA1,NT-1,false,false,false); RESC();
  { float sacc=pB0[0]+pB0[1]; _Pragma("unroll") for(int r=2;r<16;++r)sacc+=pB0[r]; _Pragma("unroll") for(int r=0;r<16;++r)sacc+=pB1[r]; l_reg+=sacc;
    pw0=(u32x4){PKW(pB0,0),PKW(pB0,2),PKW(pB0,4),PKW(pB0,6)};pw1=(u32x4){PKW(pB0,8),PKW(pB0,10),PKW(pB0,12),PKW(pB0,14)};pw2=(u32x4){PKW(pB1,0),PKW(pB1,2),PKW(pB1,4),PKW(pB1,6)};pw3=(u32x4){PKW(pB1,8),PKW(pB1,10),PKW(pB1,12),PKW(pB1,14)};
    SBAR(); pv(o,vb0+sl_cur,PAF(0),PAF(1),PAF(2),PAF(3)); }
  #undef PKW
  #undef PAF
  #undef VFR
  #undef PIN
  #undef MX3
  #undef GAPA
  #undef GAPB
  #undef EX
  #undef VRD
  #undef KRD
  #undef STEP
  #undef ENDW
  {auto rr=__builtin_amdgcn_permlane32_swap(__float_as_uint(l_reg),__float_as_uint(l_reg),false,false);l_reg=__uint_as_float(rr[0])+__uint_as_float(rr[1]);}
  if(hi==0)wsf[32+r32]=l_reg;asm volatile("s_waitcnt lgkmcnt(0)":::"memory");
  float rli[16];
  #pragma unroll
  for(int r=0;r<16;++r)rli[r]=__builtin_amdgcn_rcpf(wsf[32+crow(r,hi)]);
  bf16*Ow=O+(rowbase+q0+wid*QBLK)*DM+h*D;
  { bf16*stg=(bf16*)(shm+LDS_OST)+wid*2048;
    #pragma unroll
    for(int r=0;r<16;++r){const int orow=crow(r,hi);
      #pragma unroll
      for(int d0=0;d0<2;++d0)stg[orow*64+d0*32+r32]=__float2bfloat16(o[d0][r]*rli[r]);}
    asm volatile("s_waitcnt lgkmcnt(0)":::"memory");
    #pragma unroll
    for(int i=0;i<4;++i){const int row=i*8+(lane>>3),ch=lane&7; const u32x4 v=*(const u32x4*)(stg+row*64+ch*8); ATTN_STORE16(Ow+(long)row*DM+ch*8,v);
      float q=0.f;
      #pragma unroll
      for(int e=0;e<4;++e){const float a=__uint_as_float(v[e]<<16),b=__uint_as_float(v[e]&0xffff0000u);q+=a*a+b*b;}
      q+=__shfl_xor(q,1);q+=__shfl_xor(q,2);q+=__shfl_xor(q,4);
      if(ch==0)SSQ[(rowbase+q0+wid*QBLK+row)*8+h]=q;} }
  asm volatile("s_waitcnt lgkmcnt(0)\n\ts_barrier":::"memory");
  #undef DMA_K
  #undef DMA_V
  #undef CMASK
  #undef START
  #undef RESC
  #undef ROT
}
constexpr int ATTN_LDS_BYTES=LDS_BYTES;
struct AttnTensors { const bf16* Q; const bf16* K; const bf16* V; bf16* O; float* SSQ; };
template<int THRL,bool FAST> __device__ __forceinline__ void attn_phase(float bref,char*lds,const AttnTensors&T,int vcu,int G){
  for(int u=vcu;u<2560;u+=G){
    long rowbase;int seqlen,h,qb;
    if(u<512){rowbase=0;seqlen=16384;h=u>>6;qb=u&63;}
    else{const int u2=u-512;const int s=u2>>8;rowbase=16384+(long)s*8192;seqlen=8192;h=(u2>>5)&7;qb=u2&31;}
    attn_unit<THRL,FAST>(bref,rowbase,seqlen,h,qb,T.Q,T.K,T.V,T.O,T.SSQ,lds);
  }
}
#undef SBAR
#undef WAIT_BAR
}

namespace cg = cooperative_groups;
#ifndef PHMASK
#define PHMASK 0xffff
#endif

#define LAS __attribute__((address_space(3)))
typedef unsigned short bf16;
typedef unsigned v4u __attribute__((ext_vector_type(4)));
typedef unsigned v2u __attribute__((ext_vector_type(2)));
typedef float f32x4 __attribute__((ext_vector_type(4)));
typedef short bf16x8 __attribute__((ext_vector_type(8)));

constexpr int NTOK = 81920, PP = 3584;
constexpr int QC = 1024, XC = 1536, KC = 3072, VC = 3200, DTC = 3328;
constexpr int NCHUNK = 640;
constexpr float LOG2E = 1.4426950408889634f, EPSN = 1e-6f;
constexpr size_t MiB = 1u << 20;
constexpr size_t WS_TAB = 0, WS_WIN = 1 * MiB, WS_WOUT = 8 * MiB, WS_WXQ = 11 * MiB, WS_WXKV = 12 * MiB, WS_WXO = 14 * MiB, WS_WGU = 15 * MiB, WS_WD = 26 * MiB,
                 WS_MEMN = 32 * MiB, WS_MKV = 37 * MiB, WS_XN = 42 * MiB, WS_DT = 42 * MiB, WS_CS = 52 * MiB, WS_DEC = 62 * MiB, WS_SSQS = 64 * MiB, WS_SSQA = 66 * MiB, WS_KC = 122 * MiB, WS_VC = 143 * MiB,
                 WS_PROJ = 202 * MiB, WS_Q2 = 202 * MiB, WS_CA = 282 * MiB, WS_HID = 202 * MiB, WS_XBC = 762 * MiB, WS_RAW = 762 * MiB, WS_X2B0 = 642 * MiB, WS_X2B1 = 922 * MiB, WS_END = 962 * MiB, WS_BAR = 512 * 1024;
constexpr int LDS_BYTES = 152 * 1024;

__device__ __forceinline__ unsigned f2bf(float f) { unsigned u = __builtin_bit_cast(unsigned, f); return (u + 0x7fffu + ((u >> 16) & 1u)) >> 16; }
typedef float f32x2_t __attribute__((ext_vector_type(2))); typedef __bf16 bf16x2_t __attribute__((ext_vector_type(2)));
__device__ __forceinline__ unsigned pk2(float lo, float hi) { f32x2_t v = {lo, hi}; bf16x2_t b = __builtin_convertvector(v, bf16x2_t); return __builtin_bit_cast(unsigned, b); }
__device__ __forceinline__ float bflo(unsigned w) { return __builtin_bit_cast(float, w << 16); }
__device__ __forceinline__ float bfhi(unsigned w) { return __builtin_bit_cast(float, w & 0xffff0000u); }
__device__ __forceinline__ float bf1(bf16 h) { return __builtin_bit_cast(float, ((unsigned)h) << 16); }
__device__ __forceinline__ float wave_sum(float v) {
#pragma unroll
    for (int o = 1; o < 64; o <<= 1) v += __shfl_xor(v, o);
    return v;
}
__device__ __forceinline__ float ex2(float x) { return __builtin_amdgcn_exp2f(x); }
__device__ __forceinline__ f32x4 mfma16(bf16x8 a, bf16x8 b, f32x4 c) { return __builtin_amdgcn_mfma_f32_16x16x32_bf16(a, b, c, 0, 0, 0); }
__device__ __forceinline__ const float* xrow(const float* xp, const float* xs, int t) { return t < 16384 ? xp + (size_t)t * 1024 : xs + (size_t)(t - 16384) * 1024; }
#define LDS_WAIT() asm volatile("s_waitcnt lgkmcnt(0)" ::: "memory")
#define LBAR() asm volatile("s_waitcnt lgkmcnt(0)\n\ts_barrier" ::: "memory")

struct EpiStore {
    static constexpr bool PERM = true, AFTER_DRAIN = false, RESCALE = false;
    bf16* O; int ldc; float scale; const float* rs;
    __device__ __forceinline__ void operator()(const f32x4 (&acc)[2][2][4][2], const pg8::Unit& u, int wr, int wc, int fr, int fq) const {
        const int row0 = u.pm * 256 + wr * 64 + fr, col0 = u.pn * 256 + wc * 32 + 8 * fq;
#pragma unroll
        for (int ai = 0; ai < 2; ++ai)
#pragma unroll
            for (int m = 0; m < 4; ++m) { bf16* rowp = O + (size_t)(row0 + ai * 128 + m * 16) * ldc + col0; const float sc = rs ? scale * rs[row0 + ai * 128 + m * 16] : scale;
#pragma unroll
                for (int bj = 0; bj < 2; ++bj) { const f32x4 v0 = acc[ai][bj][m][0] * sc, v1 = acc[ai][bj][m][1] * sc;
                    v4u w; w.x = pk2(v0[0], v0[1]); w.y = pk2(v0[2], v0[3]); w.z = pk2(v1[0], v1[1]); w.w = pk2(v1[2], v1[3]);
                    *(v4u*)(rowp + bj * 128) = w; } }
    }
};
struct EpiRowScale {
    static constexpr bool PERM = true, AFTER_DRAIN = false, RESCALE = true;
    bf16* O; int ldc; const LAS float* Rl;
    __device__ __forceinline__ void rescale(f32x4 (&acc)[2][2][4][2], int ui, int t, int wr, int fr) const {
        const LAS float* rp = Rl + (size_t)ui * 1024 + (wr * 64 + fr) * 4 + (t == 8 ? 0 : 1);
#pragma unroll
        for (int ai = 0; ai < 2; ++ai)
#pragma unroll
            for (int m = 0; m < 4; ++m) { const float f = rp[(ai * 128 + m * 16) * 4];
#pragma unroll
                for (int bj = 0; bj < 2; ++bj)
#pragma unroll
                    for (int n = 0; n < 2; ++n) acc[ai][bj][m][n] = acc[ai][bj][m][n] * f; }
    }
    __device__ __forceinline__ void fin(const f32x4 (&acc)[2][2][4][2], const pg8::Unit& u, int ui, int wr, int wc, int fr, int fq) const {
        const int row0 = u.pm * 256 + wr * 64 + fr, col0 = u.pn * 256 + wc * 32 + 8 * fq; const LAS float* rp = Rl + (size_t)ui * 1024 + (wr * 64 + fr) * 4 + 2;
#pragma unroll
        for (int ai = 0; ai < 2; ++ai)
#pragma unroll
            for (int m = 0; m < 4; ++m) { bf16* rowp = O + (size_t)(row0 + ai * 128 + m * 16) * ldc + col0; const float scale = rp[(ai * 128 + m * 16) * 4];
#pragma unroll
                for (int bj = 0; bj < 2; ++bj) { const f32x4 v0 = acc[ai][bj][m][0] * scale, v1 = acc[ai][bj][m][1] * scale;
                    v4u w; w.x = pk2(v0[0], v0[1]); w.y = pk2(v0[2], v0[3]); w.z = pk2(v1[0], v1[1]); w.w = pk2(v1[2], v1[3]);
                    *(v4u*)(rowp + bj * 128) = w; } }
    }
    __device__ __forceinline__ void operator()(const f32x4 (&acc)[2][2][4][2], const pg8::Unit& u, int wr, int wc, int fr, int fq) const {}
};
struct EpiSwiglu {
    static constexpr bool PERM = true, AFTER_DRAIN = false, RESCALE = false;
    bf16* O; int ldc; const float* rs;
    __device__ __forceinline__ void operator()(const f32x4 (&acc)[2][2][4][2], const pg8::Unit& u, int wr, int wc, int fr, int fq) const {
        const int row0 = u.pm * 256 + wr * 64 + fr, col0 = u.pn * 128 + wc * 32 + 8 * fq;
#pragma unroll
        for (int ai = 0; ai < 2; ++ai)
#pragma unroll
            for (int m = 0; m < 4; ++m) { bf16* rowp = O + (size_t)(row0 + ai * 128 + m * 16) * ldc + col0; float h[8]; const float sc = rs[row0 + ai * 128 + m * 16];
#pragma unroll
                for (int n = 0; n < 2; ++n)
#pragma unroll
                    for (int i = 0; i < 4; ++i) { const float g = acc[ai][0][m][n][i] * sc, up = acc[ai][1][m][n][i] * sc; h[4 * n + i] = g * __builtin_amdgcn_rcpf(1.f + ex2(-g * LOG2E)) * up; }
                v4u w; w.x = pk2(h[0], h[1]); w.y = pk2(h[2], h[3]); w.z = pk2(h[4], h[5]); w.w = pk2(h[6], h[7]);
                *(v4u*)rowp = w; }
    }
};

__device__ __forceinline__ void tr_item(const float* W, int pitch, int k0, int ncol0, bf16* WT, int dstK, int drow0, LAS float* scr, int lane, const float* gk = nullptr) {
    float tv[32];
#pragma unroll
    for (int i = 0; i < 32; ++i) { const int kk = 2 * i + (lane >> 5); tv[i] = W[(size_t)(k0 + kk) * pitch + ncol0 + (lane & 31)]; if (gk) tv[i] *= gk[kk]; }
#pragma unroll
    for (int i = 0; i < 32; ++i) { const int kk = 2 * i + (lane >> 5); scr[kk * 33 + (lane & 31)] = tv[i]; }
    LDS_WAIT(); asm volatile("" ::: "memory");
    const int c = lane & 7;
#pragma unroll
    for (int j = 0; j < 4; ++j) { const int n = (lane >> 3) + 8 * j; const LAS float* s = scr + (8 * c) * 33 + n;
        v4u o; o.x = pk2(s[0 * 33], s[1 * 33]); o.y = pk2(s[2 * 33], s[3 * 33]); o.z = pk2(s[4 * 33], s[5 * 33]); o.w = pk2(s[6 * 33], s[7 * 33]);
        *(v4u*)(WT + (size_t)(drow0 + n) * dstK + k0 + 8 * c) = o; }
    LDS_WAIT(); asm volatile("" ::: "memory");
}

constexpr int XSPLIT = 61440;
template <int RB> __device__ __forceinline__ void norm_rows(const float* xp, const float* xs, const bf16* xb_in0, const bf16* xb_in1, const bf16* RAW, const float* gpost, float* out, bf16* xb_out0, bf16* xb_out1,
                                                            const float* gpre, bf16* XN, float* rs_out, int gw, int NGW, int lane) {
    for (int tb = gw; tb < NTOK; tb += NGW * RB) {
        f32x4 v[RB][4]; v2u rw[RB][4];
#pragma unroll
        for (int k = 0; k < RB; ++k) { const int t = tb + k * NGW; if (t < NTOK) {
            if (xp) { const float* base = xrow(xp, xs, t);
#pragma unroll
                for (int j = 0; j < 4; ++j) v[k][j] = ((const f32x4*)base)[lane + 64 * j]; }
            else { const bf16* base = t < XSPLIT ? xb_in0 + (size_t)t * 1024 : xb_in1 + (size_t)(t - XSPLIT) * 1024;
#pragma unroll
                for (int j = 0; j < 4; ++j) { const v2u w = *(const v2u*)(base + 4 * (lane + 64 * j)); v[k][j] = (f32x4){bflo(w.x), bfhi(w.x), bflo(w.y), bfhi(w.y)}; } }
            if (RAW) {
#pragma unroll
                for (int j = 0; j < 4; ++j) rw[k][j] = *(const v2u*)(RAW + (size_t)t * 1024 + 4 * (lane + 64 * j)); } } }
#pragma unroll
        for (int k = 0; k < RB; ++k) { const int t = tb + k * NGW; if (t < NTOK) {
            if (RAW) {
                f32x4 r[4]; float ss = 0.f;
#pragma unroll
                for (int j = 0; j < 4; ++j) { const v2u w = rw[k][j]; r[j] = (f32x4){bflo(w.x), bfhi(w.x), bflo(w.y), bfhi(w.y)};
                    ss += (r[j].x * r[j].x + r[j].y * r[j].y) + (r[j].z * r[j].z + r[j].w * r[j].w); }
                const float rstd = 1.0f / sqrtf(wave_sum(ss) * (1.f / 1024.f) + EPSN);
#pragma unroll
                for (int j = 0; j < 4; ++j) { const f32x4 g = ((const f32x4*)gpost)[lane + 64 * j]; v[k][j] = v[k][j] + r[j] * rstd * g; }
            }
            if (out) {
#pragma unroll
                for (int j = 0; j < 4; ++j) ((f32x4*)(out + (size_t)t * 1024))[lane + 64 * j] = v[k][j]; }
            if (xb_out0) { bf16* ob = t < XSPLIT ? xb_out0 + (size_t)t * 1024 : xb_out1 + (size_t)(t - XSPLIT) * 1024;
#pragma unroll
                for (int j = 0; j < 4; ++j) { v2u w; w.x = pk2(v[k][j].x, v[k][j].y); w.y = pk2(v[k][j].z, v[k][j].w); *(v2u*)(ob + 4 * (lane + 64 * j)) = w; } }
            if (XN || rs_out) {
                float s2 = 0.f;
#pragma unroll
                for (int j = 0; j < 4; ++j) s2 += (v[k][j].x * v[k][j].x + v[k][j].y * v[k][j].y) + (v[k][j].z * v[k][j].z + v[k][j].w * v[k][j].w);
                const float rstd2 = 1.0f / sqrtf(wave_sum(s2) * (1.f / 1024.f) + EPSN);
                if (rs_out && lane == 0) rs_out[t] = rstd2;
                if (XN) {
#pragma unroll
                for (int j = 0; j < 4; ++j) { const f32x4 g = ((const f32x4*)gpre)[lane + 64 * j]; const f32x4 o = v[k][j] * rstd2 * g;
                    v2u w; w.x = pk2(o.x, o.y); w.y = pk2(o.z, o.w); *(v2u*)(XN + (size_t)t * 1024 + 4 * (lane + 64 * j)) = w; } }
            } } }
    }
}

template <int NCH  > __device__ __forceinline__ void lds_transpose128(const bf16* src, int pitch, LAS unsigned char* dst, int tid) {
#pragma unroll
    for (int rep = 0; rep < NCH / 8; ++rep) { const int it = tid + 512 * rep, i = it & 63, ch = it >> 6;
        const bf16* p = src + (size_t)(2 * i) * pitch + ch * 8; const v4u r0 = *(const v4u*)p, r1 = *(const v4u*)(p + pitch);
#pragma unroll
        for (int j = 0; j < 8; ++j) { const unsigned a = r0[j >> 1], b = r1[j >> 1]; const unsigned lo = (j & 1) ? (a >> 16) : (a & 0xffffu), hi = (j & 1) ? (b & 0xffff0000u) : (b << 16);
            *(LAS unsigned*)(dst + (ch * 8 + j) * 272 + 4 * i) = lo | hi; } }
}
__device__ __forceinline__ void lds_copy128(const bf16* src, int pitch, LAS unsigned char* dst, int tid) {
#pragma unroll
    for (int rep = 0; rep < 4; ++rep) { const int it = tid + 512 * rep, r = it >> 4, ch = it & 15; *(LAS v4u*)(dst + r * 272 + ch * 16) = *(const v4u*)(src + (size_t)r * pitch + ch * 8); }
}
__device__ __forceinline__ bf16x8 scale8(v4u x, f32x4 w0, f32x4 w1) {
    v4u o; o.x = pk2(bflo(x.x) * w0.x, bfhi(x.x) * w0.y); o.y = pk2(bflo(x.y) * w0.z, bfhi(x.y) * w0.w); o.z = pk2(bflo(x.z) * w1.x, bfhi(x.z) * w1.y); o.w = pk2(bflo(x.w) * w1.z, bfhi(x.w) * w1.w);
    return __builtin_bit_cast(bf16x8, o);
}
__device__ __forceinline__ bf16x8 scale8s(v4u x, float w) {
    v4u o; o.x = pk2(bflo(x.x) * w, bfhi(x.x) * w); o.y = pk2(bflo(x.y) * w, bfhi(x.y) * w); o.z = pk2(bflo(x.z) * w, bfhi(x.z) * w); o.w = pk2(bflo(x.w) * w, bfhi(x.w) * w);
    return __builtin_bit_cast(bf16x8, o);
}

__device__ __forceinline__ void ssdA_load(const bf16* XBC, const float* DT, const float* CS, int u, int tid, v4u (&pb)[2][2], v4u (&px)[4][2], float (&pw)[2][3]) {
    const int c = u >> 2, g = (u >> 1) & 1, hh = u & 1, h0 = 8 * g + 4 * hh; const size_t tok0 = (size_t)c * 128;
#pragma unroll
    for (int rep = 0; rep < 2; ++rep) { const int it = tid + 512 * rep, i = it & 63, ch = it >> 6; const bf16* p = XBC + (tok0 + 2 * i) * 1536 + 1024 + g * 128 + ch * 8; pb[rep][0] = *(const v4u*)p; pb[rep][1] = *(const v4u*)(p + 1536); }
#pragma unroll
    for (int rep = 0; rep < 4; ++rep) { const int it = tid + 512 * rep, i = it & 63, ch = it >> 6; const bf16* p = XBC + (tok0 + 2 * i) * 1536 + h0 * 64 + ch * 8; px[rep][0] = *(const v4u*)p; px[rep][1] = *(const v4u*)(p + 1536); }
#pragma unroll
    for (int rep = 0; rep < 2; ++rep) { const int idx = tid + 512 * rep, hd = idx >> 8, dir = (idx >> 7) & 1, s = idx & 127, j = dir * 16 + h0 + hd;
        pw[rep][0] = CS[(tok0 + s) * 32 + j]; pw[rep][1] = CS[(tok0 + (dir ? 0 : 127)) * 32 + j]; pw[rep][2] = DT[(tok0 + s) * 32 + j]; }
}
__device__ __forceinline__ void tr_write(LAS unsigned char* dst, int ch, int i, v4u r0, v4u r1) {
#pragma unroll
    for (int j = 0; j < 8; ++j) { const unsigned a = r0[j >> 1], b = r1[j >> 1]; const unsigned lo = (j & 1) ? (a >> 16) : (a & 0xffffu), hi = (j & 1) ? (b & 0xffff0000u) : (b << 16);
        *(LAS unsigned*)(dst + (ch * 8 + j) * 272 + 4 * i) = lo | hi; }
}
__device__ __forceinline__ void ssd_states(LAS unsigned char* lds, const bf16* XBC, const float* DT, const float* CS, bf16* ST, int vcu, int G, int tid0) {
    const int wave = __builtin_amdgcn_readfirstlane(tid0 >> 6);
    LAS unsigned char* BT = lds; LAS unsigned char* XT = lds + 34816; LAS float* Wv = (LAS float*)(lds + 34816 + 69632);
    v4u pb[2][2], px[4][2]; float pw[2][3];
    if (vcu < 4 * NCHUNK) ssdA_load(XBC, DT, CS, vcu, tid0, pb, px, pw);
    for (int u = vcu; u < 4 * NCHUNK; u += G) {
        int tid = tid0; asm volatile("" : "+v"(tid));
        const int lane = tid & 63, fr = lane & 15, fq = lane >> 4;
        const int c = u >> 2, g = (u >> 1) & 1, hh = u & 1, h0 = 8 * g + 4 * hh;
#pragma unroll
        for (int rep = 0; rep < 2; ++rep) { const int it = tid + 512 * rep; tr_write(BT, it >> 6, it & 63, pb[rep][0], pb[rep][1]); }
#pragma unroll
        for (int rep = 0; rep < 4; ++rep) { const int it = tid + 512 * rep; tr_write(XT, it >> 6, it & 63, px[rep][0], px[rep][1]); }
#pragma unroll
        for (int rep = 0; rep < 2; ++rep) Wv[tid + 512 * rep] = ex2(pw[rep][1] - pw[rep][0]) * pw[rep][2];
        LBAR();
        if (u + G < 4 * NCHUNK) ssdA_load(XBC, DT, CS, u + G, tid, pb, px, pw);
        const int hd = wave >> 1, dir = wave & 1;
        f32x4 acc[8][4];
#pragma unroll
        for (int a = 0; a < 8; ++a)
#pragma unroll
            for (int b = 0; b < 4; ++b) acc[a][b] = (f32x4){0.f, 0.f, 0.f, 0.f};
#pragma unroll 1
        for (int ks = 0; ks < 4; ++ks) {
            const LAS float* wp = Wv + (hd * 2 + dir) * 128 + ks * 32 + fq * 8; const f32x4 w0 = *(const LAS f32x4*)wp, w1 = *(const LAS f32x4*)(wp + 4);
            bf16x8 bfr[4];
#pragma unroll
            for (int pt = 0; pt < 4; ++pt) bfr[pt] = scale8(*(const LAS v4u*)(XT + (hd * 64 + pt * 16 + fr) * 272 + (ks * 32 + fq * 8) * 2), w0, w1);
#pragma unroll
            for (int nt = 0; nt < 8; ++nt) { const bf16x8 a = *(const LAS bf16x8*)(BT + (nt * 16 + fr) * 272 + (ks * 32 + fq * 8) * 2);
#pragma unroll
                for (int pt = 0; pt < 4; ++pt) acc[nt][pt] = mfma16(a, bfr[pt], acc[nt][pt]); }
        }
        bf16* dst = ST + ((size_t)(c * 2 + dir) * 16 + (h0 + hd)) * 8192;
#pragma unroll
        for (int nt = 0; nt < 8; ++nt)
#pragma unroll
            for (int pt = 0; pt < 4; ++pt) { v2u w; w.x = pk2(acc[nt][pt][0], acc[nt][pt][1]); w.y = pk2(acc[nt][pt][2], acc[nt][pt][3]); *(v2u*)(dst + (pt * 16 + fr) * 128 + nt * 16 + fq * 4) = w; }
        LBAR();
    }
}

__device__ __forceinline__ void ssd_pass(bf16* ST, const float* DEC, int gtid, int NT_) {
    for (int it = gtid; it < 18 * 16384; it += NT_) {
        const int sd = it >> 14, v = it & 16383, s = sd >> 1, dir = sd & 1, head = v >> 10;
        const int c0 = s == 0 ? 0 : 128 + (s - 1) * 64, nc = s == 0 ? 128 : 64;
        float h[8];
#pragma unroll
        for (int k = 0; k < 8; ++k) h[k] = 0.f;
        for (int i = 0; i < nc; i += 8) {
            v4u sv[8]; float d[8]; bf16* pp[8];
#pragma unroll
            for (int q = 0; q < 8; ++q) { const int c = dir ? (c0 + nc - 1 - (i + q)) : (c0 + i + q); pp[q] = ST + ((size_t)(c * 2 + dir) * 16) * 8192 + (size_t)v * 8; sv[q] = *(const v4u*)pp[q]; d[q] = DEC[c * 32 + dir * 16 + head]; }
#pragma unroll
            for (int q = 0; q < 8; ++q) { v4u o; o.x = pk2(h[0], h[1]); o.y = pk2(h[2], h[3]); o.z = pk2(h[4], h[5]); o.w = pk2(h[6], h[7]); *(v4u*)pp[q] = o;
                h[0] = d[q] * h[0] + bflo(sv[q].x); h[1] = d[q] * h[1] + bfhi(sv[q].x); h[2] = d[q] * h[2] + bflo(sv[q].y); h[3] = d[q] * h[3] + bfhi(sv[q].y);
                h[4] = d[q] * h[4] + bflo(sv[q].z); h[5] = d[q] * h[5] + bfhi(sv[q].z); h[6] = d[q] * h[6] + bflo(sv[q].w); h[7] = d[q] * h[7] + bfhi(sv[q].w); }
        }
    }
}

__device__ __forceinline__ void ssd_out(LAS unsigned char* lds, const bf16* XBC, const float* DT, const float* CS, const bf16* ST, bf16* PROJ, const float* dskip, float* SSQS, int vcu, int G, int tid0) {
    const int wave = __builtin_amdgcn_readfirstlane(tid0 >> 6);
    LAS unsigned char* Cm = lds; LAS unsigned char* CBm = lds + 34816; LAS unsigned char* XT = lds + 69632; LAS float* Vv = (LAS float*)(lds + 69632 + 69632);
    for (int u = vcu; u < 4 * NCHUNK; u += G) {
        int tid = tid0; asm volatile("" : "+v"(tid));
        const int c = u >> 2, g = (u >> 1) & 1, hh = u & 1, h0 = 8 * g + 4 * hh; const size_t tok0 = (size_t)c * 128;
        v4u pc[4], pbn[4]; float pv[4];
#pragma unroll
        for (int rep = 0; rep < 4; ++rep) { const int it = tid + 512 * rep, r = it >> 4, ch = it & 15; const bf16* p = XBC + (tok0 + r) * 1536 + 1024 + g * 128 + ch * 8; pbn[rep] = *(const v4u*)p; pc[rep] = *(const v4u*)(p + 256); }
#pragma unroll
        for (int rep = 0; rep < 4; ++rep) { const int idx = tid + 512 * rep, hd = idx >> 9, kind = (idx >> 7) & 3, s = idx & 127, j = (kind & 1) * 16 + h0 + hd; pv[rep] = (kind < 2 ? CS : DT)[(tok0 + s) * 32 + j]; }
#pragma unroll
        for (int rep = 0; rep < 4; ++rep) { const int it = tid + 512 * rep, r = it >> 4, ch = it & 15; *(LAS v4u*)(Cm + r * 272 + ch * 16) = pc[rep]; *(LAS v4u*)(XT + r * 272 + ch * 16) = pbn[rep]; Vv[it] = pv[rep]; }
        LBAR();
        asm volatile("" : "+v"(tid));
        int lane = tid & 63, fr = lane & 15, fq = lane >> 4;
        {
            f32x4 cb[8];
#pragma unroll
            for (int st = 0; st < 8; ++st) cb[st] = (f32x4){0.f, 0.f, 0.f, 0.f};
#pragma unroll
            for (int ks = 0; ks < 4; ++ks) { const bf16x8 cf = *(const LAS bf16x8*)(Cm + (wave * 16 + fr) * 272 + (ks * 32 + fq * 8) * 2);
#pragma unroll
                for (int st = 0; st < 8; ++st) { const bf16x8 bfg = *(const LAS bf16x8*)(XT + (st * 16 + fr) * 272 + (ks * 32 + fq * 8) * 2); cb[st] = mfma16(bfg, cf, cb[st]); } }
#pragma unroll
            for (int st = 0; st < 8; ++st) { v2u w; w.x = pk2(cb[st][0], cb[st][1]); w.y = pk2(cb[st][2], cb[st][3]); *(LAS v2u*)(CBm + (wave * 16 + fr) * 272 + (st * 16 + fq * 4) * 2) = w; }
        }
        LBAR();
        asm volatile("" : "+v"(tid));
#pragma unroll
        for (int rep = 0; rep < 4; ++rep) { const int it = tid + 512 * rep, i = it & 63, ch = it >> 6; const bf16* p = XBC + (tok0 + 2 * i) * 1536 + h0 * 64 + ch * 8; tr_write(XT, ch, i, *(const v4u*)p, *(const v4u*)(p + 1536)); }
        LBAR();
        asm volatile("" : "+v"(tid)); lane = tid & 63; fr = lane & 15; fq = lane >> 4;
        const int hd = wave >> 1, lh = wave & 1, h = h0 + hd;
        const LAS float* csf = Vv + hd * 512, *csb = csf + 128, *dtf = csf + 256, *dtb = csf + 384;
        bf16x8 hf[4][4], hbk[4][4];
        f32x4 acc[4][4];
#pragma unroll
        for (int a = 0; a < 4; ++a)
#pragma unroll
            for (int b = 0; b < 4; ++b) acc[a][b] = (f32x4){0.f, 0.f, 0.f, 0.f};
        float csf_l[4], csb_l[4];
#pragma unroll
        for (int lt = 0; lt < 4; ++lt) { const int l = 16 * (4 * lh + lt) + fr; csf_l[lt] = csf[l]; csb_l[lt] = csb[l]; }
#pragma unroll 1
        for (int ks = 0; ks < 4; ++ks) {
            bf16x8 xb[4];
#pragma unroll
            for (int pt = 0; pt < 4; ++pt) xb[pt] = *(const LAS bf16x8*)(XT + (hd * 64 + pt * 16 + fr) * 272 + (ks * 32 + fq * 8) * 2);
            const int s0 = ks * 32 + fq * 8;
            const f32x4 sf0 = *(const LAS f32x4*)(csf + s0), sf1 = *(const LAS f32x4*)(csf + s0 + 4), sb0 = *(const LAS f32x4*)(csb + s0), sb1 = *(const LAS f32x4*)(csb + s0 + 4);
            const f32x4 df0 = *(const LAS f32x4*)(dtf + s0), df1 = *(const LAS f32x4*)(dtf + s0 + 4), db0 = *(const LAS f32x4*)(dtb + s0), db1 = *(const LAS f32x4*)(dtb + s0 + 4);
#pragma unroll
            for (int lt = 0; lt < 4; ++lt) { const int l = 16 * (4 * lh + lt) + fr;
                const v4u cbw = *(const LAS v4u*)(CBm + l * 272 + s0 * 2); float m[8];
                const int Lt = 4 * lh + lt; const bool allf = (32 * ks + 31 < 16 * Lt), allb = (32 * ks > 16 * Lt + 15);
                if (allf) {
#pragma unroll
                    for (int j = 0; j < 8; ++j) { const float sfj = j < 4 ? sf0[j & 3] : sf1[j & 3], dfj = j < 4 ? df0[j & 3] : df1[j & 3]; const unsigned cw = cbw[j >> 1]; m[j] = ((j & 1) ? bfhi(cw) : bflo(cw)) * (ex2(csf_l[lt] - sfj) * dfj); }
                } else if (allb) {
#pragma unroll
                    for (int j = 0; j < 8; ++j) { const float sbj = j < 4 ? sb0[j & 3] : sb1[j & 3], dbj = j < 4 ? db0[j & 3] : db1[j & 3]; const unsigned cw = cbw[j >> 1]; m[j] = ((j & 1) ? bfhi(cw) : bflo(cw)) * (ex2(csb_l[lt] - sbj) * dbj); }
                } else {
#pragma unroll
                    for (int j = 0; j < 8; ++j) { const int s = s0 + j; const float sfj = j < 4 ? sf0[j & 3] : sf1[j & 3], sbj = j < 4 ? sb0[j & 3] : sb1[j & 3], dfj = j < 4 ? df0[j & 3] : df1[j & 3], dbj = j < 4 ? db0[j & 3] : db1[j & 3];
                        const float mf = (s <= l) ? ex2(csf_l[lt] - sfj) * dfj : 0.f, mb = (s >= l) ? ex2(csb_l[lt] - sbj) * dbj : 0.f;
                        const unsigned cw = cbw[j >> 1]; m[j] = ((j & 1) ? bfhi(cw) : bflo(cw)) * (mf + mb); }
                }
                v4u mw; mw.x = pk2(m[0], m[1]); mw.y = pk2(m[2], m[3]); mw.z = pk2(m[4], m[5]); mw.w = pk2(m[6], m[7]); const bf16x8 a = __builtin_bit_cast(bf16x8, mw);
#pragma unroll
                for (int pt = 0; pt < 4; ++pt) acc[lt][pt] = mfma16(a, xb[pt], acc[lt][pt]); }
        }
        { const bf16* Hp = ST + ((size_t)(c * 2 + 0) * 16 + h) * 8192 + fr * 128 + fq * 8;
#pragma unroll
          for (int ks = 0; ks < 4; ++ks)
#pragma unroll
            for (int pt = 0; pt < 4; ++pt) hf[ks][pt] = *(const bf16x8*)(Hp + pt * 2048 + ks * 32); }
        { float e_l[4];
#pragma unroll
          for (int lt = 0; lt < 4; ++lt) e_l[lt] = ex2(csf_l[lt]);
#pragma unroll
          for (int ks = 0; ks < 4; ++ks) {
#pragma unroll
            for (int lt = 0; lt < 4; ++lt) { const int l = 16 * (4 * lh + lt) + fr; const bf16x8 a = scale8s(*(const LAS v4u*)(Cm + l * 272 + (ks * 32 + fq * 8) * 2), e_l[lt]);
#pragma unroll
                for (int pt = 0; pt < 4; ++pt) acc[lt][pt] = mfma16(a, hf[ks][pt], acc[lt][pt]); }
            __builtin_amdgcn_sched_barrier(0);
            if (ks >= 1 && ks <= 2) {
                const bf16* Hp = ST + ((size_t)(c * 2 + 1) * 16 + h) * 8192 + fr * 128 + fq * 8;
#pragma unroll
                for (int k2 = 2 * (ks - 1); k2 < 2 * (ks - 1) + 2; ++k2)
#pragma unroll
                    for (int pt = 0; pt < 4; ++pt) hbk[k2][pt] = *(const bf16x8*)(Hp + pt * 2048 + k2 * 32);
                __builtin_amdgcn_sched_barrier(0); } } }
        { float e_l[4];
#pragma unroll
          for (int lt = 0; lt < 4; ++lt) e_l[lt] = ex2(csb_l[lt]);
#pragma unroll
          for (int ks = 0; ks < 4; ++ks) {
#pragma unroll
            for (int lt = 0; lt < 4; ++lt) { const int l = 16 * (4 * lh + lt) + fr; const bf16x8 a = scale8s(*(const LAS v4u*)(Cm + l * 272 + (ks * 32 + fq * 8) * 2), e_l[lt]);
#pragma unroll
                for (int pt = 0; pt < 4; ++pt) acc[lt][pt] = mfma16(a, hbk[ks][pt], acc[lt][pt]); }
            __builtin_amdgcn_sched_barrier(0);
 } }
        LBAR();
        LAS unsigned char* ZT = lds;
#pragma unroll
        for (int rep = 0; rep < 8; ++rep) { const int it = tid + 512 * rep, r = it >> 5, ch = it & 31; *(LAS v4u*)(ZT + r * 528 + ch * 16) = *(const v4u*)(PROJ + (tok0 + r) * PP + h0 * 64 + ch * 8); }
        LBAR();
        asm volatile("" : "+v"(tid)); lane = tid & 63; fr = lane & 15; fq = lane >> 4;
        const float dsk = dskip[h];
#pragma unroll
        for (int lt = 0; lt < 4; ++lt) {
#pragma unroll
            for (int pt = 0; pt < 4; ++pt) { const int lb = 16 * (4 * lh + lt) + 4 * fq, p = pt * 16 + fr;
                const v2u xw = *(const LAS v2u*)(XT + (hd * 64 + p) * 272 + lb * 2); const float xv[4] = {bflo(xw.x), bfhi(xw.x), bflo(xw.y), bfhi(xw.y)};
#pragma unroll
                for (int r = 0; r < 4; ++r) { LAS bf16* zp = (LAS bf16*)(ZT + (lb + r) * 528 + (hd * 64 + p) * 2); const float z = bf1(*zp); const float y = (acc[lt][pt][r] + xv[r] * dsk) * z * __builtin_amdgcn_rcpf(1.f + ex2(-z * LOG2E)); *zp = (bf16)f2bf(y); } }
            __builtin_amdgcn_sched_barrier(0); }
        LBAR();
#pragma unroll
        for (int rep = 0; rep < 8; ++rep) { const int it = tid + 512 * rep, r = it >> 5, ch = it & 31; const v4u yv = *(const LAS v4u*)(ZT + r * 528 + ch * 16); *(v4u*)(PROJ + (tok0 + r) * PP + h0 * 64 + ch * 8) = yv;
            float q = (bflo(yv.x) * bflo(yv.x) + bfhi(yv.x) * bfhi(yv.x)) + (bflo(yv.y) * bflo(yv.y) + bfhi(yv.y) * bfhi(yv.y)) + (bflo(yv.z) * bflo(yv.z) + bfhi(yv.z) * bfhi(yv.z)) + (bflo(yv.w) * bflo(yv.w) + bfhi(yv.w) * bfhi(yv.w));
            q += __shfl_xor(q, 1); q += __shfl_xor(q, 2); q += __shfl_xor(q, 4); q += __shfl_xor(q, 8); q += __shfl_xor(q, 16);
            if (ch == 0) SSQS[(tok0 + r) * 4 + g * 2 + hh] = q; }
        LBAR();
    }
}

__device__ __forceinline__ void xa_scores(const LAS unsigned char* Kl, const bf16* qrow, int fr, int fq, v4u (&pa)[8], float& sum) {
    bf16x8 qf[4];
#pragma unroll
    for (int ks = 0; ks < 4; ++ks) qf[ks] = *(const bf16x8*)(qrow + 32 * ks);
    f32x4 s[16];
#pragma unroll
    for (int mt = 0; mt < 16; ++mt) { s[mt] = (f32x4){0.f, 0.f, 0.f, 0.f};
#pragma unroll
        for (int ks = 0; ks < 4; ++ks) s[mt] = mfma16(*(const LAS bf16x8*)(Kl + (mt * 16 + fr) * 272 + (ks * 32 + fq * 8) * 2), qf[ks], s[mt]);
        if (mt & 1) __builtin_amdgcn_sched_barrier(0); }
    float mx = -3.0e38f;
#pragma unroll
    for (int mt = 0; mt < 16; ++mt) mx = fmaxf(fmaxf(mx, fmaxf(s[mt][0], s[mt][1])), fmaxf(s[mt][2], s[mt][3]));
    mx = fmaxf(mx, __shfl_xor(mx, 16)); mx = fmaxf(mx, __shfl_xor(mx, 32));
    float sm = 0.f;
#pragma unroll
    for (int mt = 0; mt < 16; ++mt)
#pragma unroll
        for (int r = 0; r < 4; ++r) { const float e = ex2(s[mt][r] - mx); s[mt][r] = e; sm += e; }
    sm += __shfl_xor(sm, 16); sm += __shfl_xor(sm, 32); sum = sm;
#pragma unroll
    for (int kk = 0; kk < 8; ++kk) { v4u pw; pw.x = pk2(s[2 * kk][0], s[2 * kk][1]); pw.y = pk2(s[2 * kk][2], s[2 * kk][3]); pw.z = pk2(s[2 * kk + 1][0], s[2 * kk + 1][1]); pw.w = pk2(s[2 * kk + 1][2], s[2 * kk + 1][3]); pa[kk] = pw; }
    __builtin_amdgcn_sched_barrier(0);
}
__device__ __forceinline__ void xattn(LAS unsigned char* lds, const bf16* Q2, const bf16* MKV, bf16* CA, int vcu, int G, int tid0) {
    const int wave = __builtin_amdgcn_readfirstlane(tid0 >> 6);
    LAS unsigned char* Kl = lds; LAS unsigned char* VT = lds + 69632;
    const int per = (1280 + G - 1) / G; int loaded = -1;
    const int u1 = (vcu + 1) * per < 1280 ? (vcu + 1) * per : 1280;
    for (int u = vcu * per; u < u1; ++u) {
        int tid = tid0; asm volatile("" : "+v"(tid));
        const int lane = tid & 63, fr = lane & 15, fq = lane >> 4;
        int seq, head, tile;
        if (u < 256) { seq = 0; head = u >> 6; tile = u & 63; } else { const int u2 = u - 256, pr = u2 >> 5; seq = 1 + (pr >> 2); head = pr & 3; tile = u2 & 31; }
        const int key = seq * 4 + head;
        if (key != loaded) {
            __syncthreads();
            const bf16* Kg = MKV + (size_t)(seq * 256) * 1024 + head * 128; const bf16* Vg = Kg + 512;
#pragma unroll
            for (int rep = 0; rep < 8; ++rep) { const int it = tid + 512 * rep, m = it >> 4, ch = it & 15; *(LAS v4u*)(Kl + m * 272 + ch * 16) = *(const v4u*)(Kg + (size_t)m * 1024 + ch * 8); }
#pragma unroll
            for (int rep = 0; rep < 4; ++rep) { const int it = tid + 512 * rep, i = it & 127, ch = it >> 7;
                const bf16* p = Vg + (size_t)(2 * i) * 1024 + ch * 8; const v4u r0 = *(const v4u*)p, r1 = *(const v4u*)(p + 1024);
#pragma unroll
                for (int j = 0; j < 8; ++j) { const unsigned a = r0[j >> 1], b = r1[j >> 1]; const unsigned lo = (j & 1) ? (a >> 16) : (a & 0xffffu), hi = (j & 1) ? (b & 0xffff0000u) : (b << 16);
                    *(LAS unsigned*)(VT + (ch * 8 + j) * 528 + 4 * i) = lo | hi; } }
            __syncthreads(); loaded = key;
        }
        const int tokb = (seq == 0 ? 0 : 16384 + (seq - 1) * 8192) + tile * 256 + wave * 32;
        v4u pa[2][8]; float sum[2];
#pragma unroll
        for (int itr = 0; itr < 2; ++itr) xa_scores(Kl, Q2 + (size_t)(tokb + 16 * itr + fr) * 512 + head * 128 + fq * 8, fr, fq, pa[itr], sum[itr]);
        f32x4 o[2][8];
#pragma unroll
        for (int itr = 0; itr < 2; ++itr)
#pragma unroll
            for (int dt = 0; dt < 8; ++dt) o[itr][dt] = (f32x4){0.f, 0.f, 0.f, 0.f};
#pragma unroll
        for (int kk = 0; kk < 8; ++kk) {
#pragma unroll
            for (int dt = 0; dt < 8; ++dt) { const LAS unsigned char* vp = VT + (dt * 16 + fr) * 528 + (kk * 32 + fq * 4) * 2; const v2u lo = *(const LAS v2u*)vp, hi = *(const LAS v2u*)(vp + 32);
                v4u vw; vw.x = lo.x; vw.y = lo.y; vw.z = hi.x; vw.w = hi.y; const bf16x8 vb = __builtin_bit_cast(bf16x8, vw);
                o[0][dt] = mfma16(vb, __builtin_bit_cast(bf16x8, pa[0][kk]), o[0][dt]); o[1][dt] = mfma16(vb, __builtin_bit_cast(bf16x8, pa[1][kk]), o[1][dt]); }
            __builtin_amdgcn_sched_barrier(0);
        }
#pragma unroll
        for (int itr = 0; itr < 2; ++itr) { const int l0 = tokb + 16 * itr; const float inv = 1.0f / sum[itr]; bf16* cp = CA + (size_t)(l0 + fr) * 512 + head * 128 + fq * 4;
#pragma unroll
            for (int dt = 0; dt < 8; ++dt) { v2u w; w.x = pk2(o[itr][dt][0] * inv, o[itr][dt][1] * inv); w.y = pk2(o[itr][dt][2] * inv, o[itr][dt][3] * inv); *(v2u*)(cp + dt * 16) = w; } }
    }
}

typedef __attribute__((address_space(1))) unsigned gu32;
#define RLX_AGENT __ATOMIC_RELAXED, __HIP_MEMORY_SCOPE_AGENT
#define XB_TMO      128
#define XB_XCNT(j)  (256  + 64 * (j))
#define XB_XSUB(j)  (1280 + 64 * (j))
#define XB_XGEN(j)  (2304 + 64 * (j))
#define XB_TOP      3328
#define XB_TOPGEN   3392
#define XCD_BAR_WORDS 3456
#define XB_SPIN_CAP (1u << 18)

__device__ __forceinline__ unsigned xb_ld(unsigned* p)              { return __hip_atomic_load(p, __ATOMIC_RELAXED, __HIP_MEMORY_SCOPE_AGENT); }
__device__ __forceinline__ unsigned xb_add(unsigned* p, unsigned v) { return __hip_atomic_fetch_add(p, v, __ATOMIC_RELAXED, __HIP_MEMORY_SCOPE_AGENT); }
__device__ __forceinline__ unsigned xb_xcc_id() { return (unsigned)__builtin_amdgcn_s_getreg((3 << 11) | 20) & 0xFu; }
#define XB_SPIN(cond, bar) do { unsigned _sp = 0; while (cond) { __builtin_amdgcn_s_sleep(1); \
    if ((++_sp & 255u) == 0u) { if (xb_ld(&(bar)[XB_TMO])) break; if (_sp > XB_SPIN_CAP) { atomicAdd(&(bar)[XB_TMO], 1u); break; } } } } while (0)

struct XcdBarrier {
    unsigned* bar; unsigned x;
    volatile LAS unsigned* st;
};

__device__ __forceinline__ XcdBarrier xcd_barrier_post(unsigned* bar, volatile LAS unsigned* st) {
    XcdBarrier b; b.bar = bar; b.x = xb_xcc_id(); b.st = st;
    if (threadIdx.x == 0) (void)xb_add(&bar[XB_XCNT(b.x)], 1u);
    return b;
}
__device__ __forceinline__ void xcd_barrier_complete(unsigned* bar, unsigned x, unsigned& nloc, unsigned& nx) {
    const unsigned G = gridDim.x * gridDim.y * gridDim.z;
    unsigned sum, cnt, mine, sp = 0u;
    for (;;) {
        sum = 0u; cnt = 0u; mine = 0u;
#pragma unroll
        for (unsigned j = 0; j < 16; ++j) { const unsigned c = xb_ld(&bar[XB_XCNT(j)]); sum += c; cnt += (c > 0u) ? 1u : 0u; mine = (j == x) ? c : mine; }
        if (sum == G) break;
        __builtin_amdgcn_s_sleep(1);
        if ((++sp & 255u) == 0u) { if (xb_ld(&bar[XB_TMO])) break; if (sp > XB_SPIN_CAP) { atomicAdd(&bar[XB_TMO], 1u); break; } }
    }
    nloc = mine > 0u ? mine : 1u; nx = cnt > 0u ? cnt : 1u;
}

__device__ __forceinline__ void xcd_barrier(const XcdBarrier& b) {
    asm volatile("s_waitcnt vmcnt(0)" ::: "memory");
    __syncthreads();
    if (threadIdx.x == 0) {
        unsigned* bar = b.bar;
        __builtin_amdgcn_s_waitcnt(0);
        unsigned nloc = b.st[0], nx = b.st[1];
        if (nloc == 0u) { xcd_barrier_complete(bar, b.x, nloc, nx); b.st[0] = nloc; b.st[1] = nx; }
        const unsigned old = xb_add(&bar[XB_XSUB(b.x)], 1u);
        const unsigned gen = old / nloc;
        if (old + 1u == (gen + 1u) * nloc) {
            __builtin_amdgcn_fence(__ATOMIC_RELEASE, "agent");
            asm volatile("s_waitcnt vmcnt(0)" ::: "memory");
            const unsigned og = xb_add(&bar[XB_TOP], 1u);
            const unsigned tg = og / nx;
            if (og + 1u == (tg + 1u) * nx) xb_add(&bar[XB_TOPGEN], 1u);
            else XB_SPIN(xb_ld(&bar[XB_TOPGEN]) == tg, bar);
            __builtin_amdgcn_fence(__ATOMIC_ACQUIRE, "agent");
            xb_add(&bar[XB_XGEN(b.x)], 1u);
            asm volatile("s_waitcnt vmcnt(0)" ::: "memory");
        } else {
            XB_SPIN(xb_ld(&bar[XB_XGEN(b.x)]) == gen, bar);
            __builtin_amdgcn_fence(__ATOMIC_ACQUIRE, "agent");
            asm volatile("s_waitcnt vmcnt(0)" ::: "memory");
        }
    }
    __syncthreads();
}


struct Args { const float* in[29]; float* out; unsigned char* ws; };
__global__ void __launch_bounds__(512, 2) hymba_fwd(Args args) {
    extern __shared__ __attribute__((aligned(16))) unsigned char lds_raw[];
    cg::grid_group grid = cg::this_grid();
    LAS unsigned char* lds = (LAS unsigned char*)lds_raw;
    const int wave = __builtin_amdgcn_readfirstlane((int)threadIdx.x >> 6);
    const int G = gridDim.x; const int bx = blockIdx.x; const int vcu = (G % 8 == 0) ? (bx % 8) * (G / 8) + bx / 8 : bx;
    const int gw = vcu * 8 + wave, NGW = G * 8, NTH = G * 512;
#define PH_VARS int tid = threadIdx.x; asm volatile("" : "+v"(tid)); const int lane = tid & 63; const int gtid = vcu * 512 + tid; (void)lane; (void)gtid;
    unsigned char* ws = args.ws;
    const float* xp = args.in[0]; const float* xs = args.in[1];
    bf16* WIN = (bf16*)(ws + WS_WIN); bf16* WOUT = (bf16*)(ws + WS_WOUT); bf16* WXQ = (bf16*)(ws + WS_WXQ); bf16* WXKV = (bf16*)(ws + WS_WXKV); bf16* WXO = (bf16*)(ws + WS_WXO);
    bf16* WGU = (bf16*)(ws + WS_WGU); bf16* WD = (bf16*)(ws + WS_WD); bf16* MEMN = (bf16*)(ws + WS_MEMN); bf16* MKV = (bf16*)(ws + WS_MKV); bf16* XN = (bf16*)(ws + WS_XN);
    float* DT = (float*)(ws + WS_DT); float* CS = (float*)(ws + WS_CS); float* DEC = (float*)(ws + WS_DEC); float* TAB = (float*)(ws + WS_TAB); bf16* KC_ = (bf16*)(ws + WS_KC); bf16* VC_ = (bf16*)(ws + WS_VC); float* SSQS = (float*)(ws + WS_SSQS); float* RS1 = (float*)(ws + 64 * 1024); float* RS2 = (float*)(ws + 528 * 1024);   float* SSQA = (float*)(ws + WS_SSQA);
    bf16* PROJ = (bf16*)(ws + WS_PROJ); bf16* Q2 = (bf16*)(ws + WS_Q2); bf16* CA = (bf16*)(ws + WS_CA); bf16* HID = (bf16*)(ws + WS_HID); bf16* XBC = (bf16*)(ws + WS_XBC); bf16* RAW = (bf16*)(ws + WS_RAW);
    bf16* X1B = (bf16*)args.out; bf16* X2B0 = (bf16*)(ws + WS_X2B0); bf16* X2B1 = (bf16*)(ws + WS_X2B1);
    bf16* ST = (bf16*)args.out;
    volatile LAS unsigned* bst = (volatile LAS unsigned*)(lds + LDS_BYTES - 16);
    if (threadIdx.x < 4) bst[threadIdx.x] = 0u;
    __syncthreads();
    if (blockIdx.x == 0) for (int i = threadIdx.x; i < XCD_BAR_WORDS; i += 512) ((unsigned*)(ws + WS_BAR))[i] = 0u;
    XcdBarrier xbar; xbar.bar = (unsigned*)(ws + WS_BAR); xbar.x = 0; xbar.st = bst;
#define GRID_BAR() xcd_barrier(xbar)

#if (PHMASK >> 0) & 1
    { PH_VARS
    {
        LAS float* scr = (LAS float*)(lds + wave * 16384);
        for (int it = gw; it < 7696; it += NGW) {
            int r = it;
#define TRY(W_, pitch_, Krows_, col0_, ncols_, WT_, drow0_, mode_) { const int nb_ = (ncols_) / 32, cnt_ = ((Krows_) / 64) * nb_; if (r < cnt_) { const int kb = r / nb_, n0 = (r % nb_) * 32; \
                const int dr = (mode_) ? (drow0_) + 256 * (n0 / 128) + (n0 % 128) : (drow0_) + n0; tr_item(W_, pitch_, kb * 64, (col0_) + n0, WT_, Krows_, dr, scr, lane); continue; } r -= cnt_; }
            TRY(args.in[5], 3360, 1024, 0, 1024, WIN, 0, 0)
            TRY(args.in[5], 3360, 1024, 1024, 1536, WIN, XC, 0)
            TRY(args.in[5], 3360, 1024, 2560, 32, WIN, DTC, 0)
            TRY(args.in[5], 3360, 1024, 2592, 512, WIN, QC, 0)
            TRY(args.in[5], 3360, 1024, 3104, 128, WIN, KC, 0)
            TRY(args.in[5], 3360, 1024, 3232, 128, WIN, VC, 0)
            { const int nb_ = 32, cnt_ = 24 * nb_; if (r < cnt_) { const int kb = r / nb_, n0 = (r % nb_) * 32; const float* gk = kb < 16 ? args.in[11] + kb * 64 : args.in[14] + (kb - 16) * 64;
                tr_item(args.in[15], 1024, kb * 64, n0, WOUT, 1536, n0, scr, lane, gk); continue; } r -= cnt_; }
            { const int nb_ = 16, cnt_ = 16 * nb_; if (r < cnt_) { const int kb = r / nb_, n0 = (r % nb_) * 32; tr_item(args.in[19], 512, kb * 64, n0, WXQ, 1024, n0, scr, lane, args.in[17] + kb * 64); continue; } r -= cnt_; }
            TRY(args.in[20], 512, 1024, 0, 512, WXKV, 0, 0)
            TRY(args.in[21], 512, 1024, 0, 512, WXKV, 512, 0)
            TRY(args.in[22], 1024, 512, 0, 1024, WXO, 0, 0)
            { const int nb_ = 88, cnt_ = 16 * nb_; if (r < cnt_) { const int kb = r / nb_, n0 = (r % nb_) * 32; tr_item(args.in[25], 2816, kb * 64, n0, WGU, 1024, 256 * (n0 / 128) + (n0 % 128), scr, lane, args.in[24] + kb * 64); continue; } r -= cnt_; }
            { const int nb_ = 88, cnt_ = 16 * nb_; if (r < cnt_) { const int kb = r / nb_, n0 = (r % nb_) * 32; tr_item(args.in[26], 2816, kb * 64, n0, WGU, 1024, 128 + 256 * (n0 / 128) + (n0 % 128), scr, lane, args.in[24] + kb * 64); continue; } r -= cnt_; }
            TRY(args.in[27], 1024, 2816, 0, 1024, WD, 0, 0)
#undef TRY
        }
        for (int i = gtid; i < 224 * 1024 / 8; i += NTH) ((v4u*)(WIN + (size_t)3360 * 1024))[i] = (v4u){0u, 0u, 0u, 0u};
        for (int i = gtid; i < 320 * 16; i += NTH) { const int pos = i >> 4, f = i & 15; const double m4 = (f & 3) == 0 ? 1.0 : (f & 3) == 1 ? 0.56234132519034908 : (f & 3) == 2 ? 0.31622776601683794 : 0.17782794100389228;
            const double e4 = (f >> 2) == 0 ? 1.0 : (f >> 2) == 1 ? 0.1 : (f >> 2) == 2 ? 0.01 : 0.001; const double pv = (double)(pos < 256 ? pos : pos - 256);
            double rev = pv * (m4 * e4) * 0.15915494309189535; rev -= floor(rev); const float rf = (float)rev;
            TAB[2 * i] = __builtin_amdgcn_cosf(rf); TAB[2 * i + 1] = __builtin_amdgcn_sinf(rf); }
        norm_rows<4>(xp, xs, nullptr, nullptr, nullptr, nullptr, nullptr, nullptr, nullptr, args.in[4], XN, nullptr, gw, NGW, lane);
        for (int t = gw; t < 2304; t += NGW) {
            const float* base = t < 256 ? args.in[2] + (size_t)t * 1024 : args.in[3] + (size_t)(t - 256) * 1024; f32x4 v[4]; float s2 = 0.f;
#pragma unroll
            for (int j = 0; j < 4; ++j) { v[j] = ((const f32x4*)base)[lane + 64 * j]; s2 += (v[j].x * v[j].x + v[j].y * v[j].y) + (v[j].z * v[j].z + v[j].w * v[j].w); }
            const float rstd = 1.0f / sqrtf(wave_sum(s2) * (1.f / 1024.f) + EPSN);
#pragma unroll
            for (int j = 0; j < 4; ++j) { const f32x4 g = ((const f32x4*)args.in[18])[lane + 64 * j]; const f32x4 o = v[j] * rstd * g; v2u w; w.x = pk2(o.x, o.y); w.y = pk2(o.z, o.w); *(v2u*)(MEMN + (size_t)t * 1024 + 4 * (lane + 64 * j)) = w; }
        }
    }
    }
#endif
    grid.sync();
    xbar = xcd_barrier_post((unsigned*)(ws + WS_BAR), bst);
#if (PHMASK >> 1) & 1
    { PH_VARS
    {
        pg8::Gemm g{XN, WIN, NTOK, PP, 1024, 1024, 0, 1 << 30}; pg8::StaticOrder S; S.init(NTOK, PP, G, bx); EpiStore E{PROJ, PP, 1.0f, nullptr};
        pg8::gemm_phase<EpiStore, pg8::StaticOrder, true, true>(lds, g, S, E);
        pg8::Gemm g2{MEMN, WXKV, 2304, 1024, 1024, 1024, 0, 1 << 30}; pg8::StaticOrder S2; S2.init(2304, 1024, G, (bx + 128) % G); EpiStore E2{MKV, 1024, 1.0f, nullptr};
        pg8::gemm_phase<EpiStore, pg8::StaticOrder, true, true>(lds, g2, S2, E2);
    }
    }
#endif
    GRID_BAR();
#if (PHMASK >> 2) & 1
    { PH_VARS
    {
        const float* conv_w = args.in[6]; const float* conv_b = args.in[7];
        for (int item = gw; item < 30720; item += NGW) {
            const int run = item / 3, j = item - run * 3, t0 = run * 8, c0 = (lane + 64 * j) * 8;
            const int s0 = t0 < 16384 ? 0 : 16384 + ((t0 - 16384) >> 13) * 8192, len = t0 < 16384 ? 16384 : 8192, pos0 = t0 - s0;
            v4u rows[12];
#pragma unroll
            for (int i = 0; i < 12; ++i) { const int tt = pos0 + i - 2; rows[i] = (v4u){0u, 0u, 0u, 0u}; if (tt >= 0 && tt < len) rows[i] = *(const v4u*)(PROJ + (size_t)(t0 + i - 2) * PP + XC + c0); }
            f32x4 w[5][2];
#pragma unroll
            for (int dk = 0; dk < 5; ++dk) { w[dk][0] = *(const f32x4*)(conv_w + dk * 1536 + c0); w[dk][1] = *(const f32x4*)(conv_w + dk * 1536 + c0 + 4); }
            const f32x4 b0 = *(const f32x4*)(conv_b + c0), b1 = *(const f32x4*)(conv_b + c0 + 4);
#pragma unroll
            for (int o_ = 0; o_ < 8; ++o_) { float a[8] = {b0.x, b0.y, b0.z, b0.w, b1.x, b1.y, b1.z, b1.w};
#pragma unroll
                for (int dk = 0; dk < 5; ++dk) { const v4u r = rows[o_ + dk]; const f32x4 w0 = w[dk][0], w1 = w[dk][1];
                    a[0] += w0.x * bflo(r.x); a[1] += w0.y * bfhi(r.x); a[2] += w0.z * bflo(r.y); a[3] += w0.w * bfhi(r.y); a[4] += w1.x * bflo(r.z); a[5] += w1.y * bfhi(r.z); a[6] += w1.z * bflo(r.w); a[7] += w1.w * bfhi(r.w); }
#pragma unroll
                for (int k = 0; k < 8; ++k) a[k] = a[k] * __builtin_amdgcn_rcpf(1.f + ex2(-a[k] * LOG2E));
                v4u o; o.x = pk2(a[0], a[1]); o.y = pk2(a[2], a[3]); o.z = pk2(a[4], a[5]); o.w = pk2(a[6], a[7]); *(v4u*)(XBC + (size_t)(t0 + o_) * 1536 + c0) = o; }
        }
        for (int tb = gw * 4; tb < NTOK; tb += NGW * 4) {
            const int s0 = tb < 16384 ? 0 : 16384 + ((tb - 16384) >> 13) * 8192;
            v4u rin[5]; bf16* ptrs[5];
#pragma unroll
            for (int part = 0; part < 5; ++part) { const int t = part < 4 ? tb + part : tb + (lane >> 4); ptrs[part] = PROJ + (size_t)t * PP + (part < 4 ? QC + lane * 8 : KC + (lane & 15) * 8); rin[part] = *(const v4u*)ptrs[part]; }
#pragma unroll
            for (int part = 0; part < 5; ++part) {
                const int t = part < 4 ? tb + part : tb + (lane >> 4), pos = t - s0, prow = pos >> 6, pcol = pos & 63, i = lane & 7;
                const v4u r = rin[part]; float x[8] = {bflo(r.x), bfhi(r.x), bflo(r.y), bfhi(r.y), bflo(r.z), bfhi(r.z), bflo(r.w), bfhi(r.w)};
                float ss = 0.f;
#pragma unroll
                for (int k = 0; k < 8; ++k) ss += x[k] * x[k];
                ss += __shfl_xor(ss, 1); ss += __shfl_xor(ss, 2); ss += __shfl_xor(ss, 4);
                const float rstd = 1.0f / sqrtf(ss * (1.f / 64.f) + EPSN); const float* gn = args.in[part < 4 ? 12 : 13] + i * 8;
                const f32x4 g0 = *(const f32x4*)gn, g1 = *(const f32x4*)(gn + 4); const float gg[8] = {g0.x, g0.y, g0.z, g0.w, g1.x, g1.y, g1.z, g1.w};
                const float* tbp = TAB + ((size_t)((i < 4) ? prow : 256 + pcol) * 16 + 8 * (i & 1)) * 2; const f32x4 t0 = *(const f32x4*)tbp, t1 = *(const f32x4*)(tbp + 4), t2 = *(const f32x4*)(tbp + 8), t3 = *(const f32x4*)(tbp + 12);
                const float cs_[8] = {t0.x, t0.z, t1.x, t1.z, t2.x, t2.z, t3.x, t3.z}, sn_[8] = {t0.y, t0.w, t1.y, t1.w, t2.y, t2.w, t3.y, t3.w};
                const float sc = part < 4 ? 0.125f * LOG2E : 1.0f; float y[8];
#pragma unroll
                for (int k = 0; k < 8; ++k) { const float xv = x[k] * rstd * gg[k]; const float ov = __shfl_xor(xv, 2); y[k] = ((i & 2) ? (xv * cs_[k] + ov * sn_[k]) : (xv * cs_[k] - ov * sn_[k])) * sc; }
                v4u o; o.x = pk2(y[0], y[1]); o.y = pk2(y[2], y[3]); o.z = pk2(y[4], y[5]); o.w = pk2(y[6], y[7]);
                if (part < 4) *(v4u*)ptrs[part] = o;
                else *(v4u*)(KC_ + ((size_t)((lane >> 3) & 1) * NTOK + t) * 64 + i * 8) = o;
            }
            { const int t = tb + (lane >> 4), kvh = (lane >> 3) & 1, i = lane & 7;
              *(v4u*)(VC_ + ((size_t)kvh * NTOK + t) * 64 + i * 8) = *(const v4u*)(PROJ + (size_t)t * PP + VC + (lane & 15) * 8); }
        }
        for (int c = gw; c < NCHUNK; c += NGW) {
            const int j = lane & 31, hf = lane >> 5, dir = j >> 4; const float bias = args.in[8][j], al2 = -__expf(args.in[9][j]) * LOG2E; const size_t tok0 = (size_t)c * 128;
            float tot = 0.f;
#pragma unroll 1
            for (int i0 = 0; i0 < 64; i0 += 16) { float dtv[16];
#pragma unroll
                for (int i = 0; i < 16; ++i) { const int o = hf * 64 + i0 + i, tk = dir ? 127 - o : o; dtv[i] = bf1(PROJ[(tok0 + tk) * PP + DTC + j]); }
#pragma unroll
                for (int i = 0; i < 16; ++i) { const float xr = dtv[i] + bias; const float dt = xr > 15.f ? xr : log1pf(__expf(xr)); tot += dt * al2; } }
            const float other = __shfl_xor(tot, 32); float run = hf ? other : 0.f;
#pragma unroll 1
            for (int i0 = 0; i0 < 64; i0 += 16) { float dtv[16];
#pragma unroll
                for (int i = 0; i < 16; ++i) { const int o = hf * 64 + i0 + i, tk = dir ? 127 - o : o; dtv[i] = bf1(PROJ[(tok0 + tk) * PP + DTC + j]); }
#pragma unroll
                for (int i = 0; i < 16; ++i) { const int o = hf * 64 + i0 + i, tk = dir ? 127 - o : o; const float xr = dtv[i] + bias; const float dt = xr > 15.f ? xr : log1pf(__expf(xr)); run += dt * al2;
                    DT[(tok0 + tk) * 32 + j] = dt; CS[(tok0 + tk) * 32 + j] = run; } }
            if (hf == 0) DEC[c * 32 + j] = ex2(tot + other);
        }
    }
    }
#endif
    GRID_BAR();
#if (PHMASK >> 3) & 1
    { PH_VARS
    ssd_states(lds, XBC, DT, CS, ST, vcu, G, tid);
    }
#endif
    GRID_BAR();
#if (PHMASK >> 4) & 1
    { PH_VARS
    ssd_pass(ST, DEC, gtid, NTH);
    {
        const attn_body::AttnTensors AT{(const attn_body::bf16*)(PROJ + QC), (const attn_body::bf16*)KC_, (const attn_body::bf16*)VC_, (attn_body::bf16*)(PROJ + QC), SSQA};
        float mq = fabsf(args.in[12][lane]), mk = fabsf(args.in[13][lane]);
#pragma unroll
        for (int o_ = 1; o_ < 64; o_ <<= 1) { mq = fmaxf(mq, __shfl_xor(mq, o_)); mk = fmaxf(mk, __shfl_xor(mk, o_)); }
        const float bref = 0.125f * LOG2E * 64.f * mq * mk * 1.02f + 0.1f;
        if (bref <= 40.f) attn_body::attn_phase<8, true>(bref, (char*)lds_raw, AT, vcu, G);
        else attn_body::attn_phase<8, false>(0.f, (char*)lds_raw, AT, vcu, G);
    }
    }
#endif
    GRID_BAR();
#if (PHMASK >> 5) & 1
    { PH_VARS
    ssd_out(lds, XBC, DT, CS, ST, PROJ, args.in[10], SSQS, vcu, G, tid);
    }
#endif
    GRID_BAR();
#if (PHMASK >> 7) & 1
    { PH_VARS
    { pg8::Gemm g{PROJ, WOUT, NTOK, 1024, 1536, PP, 0, 1 << 30}; pg8::StaticOrder S; S.init(NTOK, 1024, G, bx);
      LAS float* Rl = (LAS float*)(lds + 131072);
      { pg8::Unit uu; for (int i = 0; i < 5 && S.next(i, uu); ++i) if (tid < 256) { const size_t row = (size_t)uu.pm * 256 + tid;
            const f32x4 sv = *(const f32x4*)(SSQS + row * 4), a0 = *(const f32x4*)(SSQA + row * 8), a1 = *(const f32x4*)(SSQA + row * 8 + 4);
            const float d0 = (sv.x + sv.y) * (1.f / 512.f) + EPSN, d1 = (sv.z + sv.w) * (1.f / 512.f) + EPSN, d2 = (((a0.x + a0.y) + (a0.z + a0.w)) + ((a1.x + a1.y) + (a1.z + a1.w))) * (1.f / 512.f) + EPSN;
            *(LAS f32x4*)(Rl + (size_t)i * 1024 + tid * 4) = (f32x4){sqrtf(d1 / d0), sqrtf(d2 / d1), 1.0f / sqrtf(d2), 0.f}; }
        __syncthreads(); }
      EpiRowScale E{RAW, 1024, Rl}; pg8::gemm_phase<EpiRowScale, pg8::StaticOrder, true, true>(lds, g, S, E); }
    }
#endif
    GRID_BAR();
#if (PHMASK >> 8) & 1
    { PH_VARS
    norm_rows<4>(xp, xs, nullptr, nullptr, RAW, args.in[16], nullptr, X1B, X1B + (size_t)XSPLIT * 1024, nullptr, nullptr, RS1, gw, NGW, lane);
    }
#endif
    GRID_BAR();
#if (PHMASK >> 9) & 1
    { PH_VARS
    { pg8::Gemm g{X1B, WXQ, NTOK, 512, 1024, 1024, 0, 1 << 30}; pg8::StaticOrder S; S.init(NTOK, 512, G, bx); EpiStore E{Q2, 512, 0.08838834764831845f * LOG2E, RS1}; pg8::gemm_phase<EpiStore, pg8::StaticOrder, true, true>(lds, g, S, E); }
    }
#endif
    GRID_BAR();
#if (PHMASK >> 10) & 1
    { PH_VARS
    xattn(lds, Q2, MKV, CA, vcu, G, tid);
    }
#endif
    GRID_BAR();
#if (PHMASK >> 11) & 1
    { PH_VARS
    { pg8::Gemm g{CA, WXO, NTOK, 1024, 512, 512, 0, 1 << 30}; pg8::StaticOrder S; S.init(NTOK, 1024, G, bx); EpiStore E{RAW, 1024, 1.0f, nullptr}; pg8::gemm_phase<EpiStore, pg8::StaticOrder, true, true>(lds, g, S, E); }
    }
#endif
    GRID_BAR();
#if (PHMASK >> 12) & 1
    { PH_VARS
    norm_rows<4>(nullptr, nullptr, X1B, X1B + (size_t)XSPLIT * 1024, RAW, args.in[23], nullptr, X2B0, X2B1, nullptr, nullptr, RS2, gw, NGW, lane);
    }
#endif
    GRID_BAR();
#if (PHMASK >> 13) & 1
    { PH_VARS
    { pg8::Gemm g{X2B0, WGU, NTOK, 5632, 1024, 1024, (long)((const char*)X2B1 - (const char*)X2B0), XSPLIT / 256}; pg8::StaticOrder S; S.init(NTOK, 5632, G, bx); EpiSwiglu E{HID, 2816, RS2}; pg8::gemm_phase<EpiSwiglu, pg8::StaticOrder, true, true>(lds, g, S, E); }
    }
#endif
    GRID_BAR();
#if (PHMASK >> 14) & 1
    { PH_VARS
    { pg8::Gemm g{HID, WD, NTOK, 1024, 2816, 2816, 0, 1 << 30}; pg8::StaticOrder S; S.init(NTOK, 1024, G, bx); EpiStore E{RAW, 1024, 1.0f, nullptr}; pg8::gemm_phase<EpiStore, pg8::StaticOrder, true, true>(lds, g, S, E); }
    }
#endif
    GRID_BAR();
#if (PHMASK >> 15) & 1
    { PH_VARS
    norm_rows<4>(nullptr, nullptr, X2B0, X2B1, RAW, args.in[28], args.out, nullptr, nullptr, nullptr, nullptr, nullptr, gw, NGW, lane);
    }
#endif
}

extern "C" void kernel_launch(void* const* d_in, const int* in_sizes, int n_in, void* d_out, int out_size, void* d_ws, size_t ws_size, hipStream_t stream) {
    static int grid = 0;
    if (grid == 0) {
        if (n_in != 29 || out_size != NTOK * 1024 || ws_size < WS_END) { fprintf(stderr, "kernel_launch: unexpected shapes (n_in %d, out %d, ws %zu)\n", n_in, out_size, ws_size); grid = -1; return; }
        int dev = 0, cus = 0, per_cu = 0;
        if (hipGetDevice(&dev) != hipSuccess || hipDeviceGetAttribute(&cus, hipDeviceAttributeMultiprocessorCount, dev) != hipSuccess) { grid = -1; return; }
        if (hipFuncSetAttribute((const void*)hymba_fwd, hipFuncAttributeMaxDynamicSharedMemorySize, LDS_BYTES) != hipSuccess) { fprintf(stderr, "kernel_launch: hipFuncSetAttribute failed\n"); grid = -1; return; }
        if (hipOccupancyMaxActiveBlocksPerMultiprocessor(&per_cu, (const void*)hymba_fwd, 512, LDS_BYTES) != hipSuccess || per_cu < 1) { fprintf(stderr, "kernel_launch: occupancy query says %d\n", per_cu); per_cu = 1; }
        (void)hipGetLastError();
        grid = cus * (per_cu > 1 ? 1 : per_cu);
    }
    if (grid < 0) return;
    Args a{};
    for (int i = 0; i < 29; ++i) a.in[i] = (const float*)d_in[i];
    a.out = (float*)d_out; a.ws = (unsigned char*)d_ws;
    void* kargs[] = {&a};
    const hipError_t e = hipLaunchCooperativeKernel((const void*)hymba_fwd, dim3(grid), dim3(512), kargs, LDS_BYTES, stream);
    if (e != hipSuccess) fprintf(stderr, "kernel_launch: cooperative launch failed: %s (grid %d)\n", hipGetErrorString(e), grid);
}
```

```cpp
#include <hip/hip_runtime.h>
#include <hip/hip_cooperative_groups.h>
#include <cstdio>
#include <cstdint>
namespace pg8 {
#define PG8_LAS __attribute__((address_space(3)))
typedef unsigned short bf16_t;
typedef short bf16x8 __attribute__((ext_vector_type(8)));
typedef float f32x4 __attribute__((ext_vector_type(4)));
typedef unsigned u32x4 __attribute__((ext_vector_type(4)));
constexpr int BM = 256, BK = 64, HALF = 128, HTB = HALF * BK * 2  , STAGE_BYTES = 8 * HTB, NXCD = 8, WGM = 8;

__host__ __device__ __forceinline__ int lds_byte(int r, int c) { const int st = (r >> 4) * 2 + (c >> 5), rr = r & 15, cc = c & 31, ob = rr * 64 + cc * 2; return st * 1024 + (ob ^ (((ob >> 9) & 1) << 5)); }
__host__ __device__ __forceinline__ void stage_rc(int b, int& R, int& C) { const int st = b / 1024, sb = b % 1024, swz = sb ^ (((sb >> 9) & 1) << 5); R = (st >> 1) * 16 + swz / 64; C = (st & 1) * 32 + (swz % 64) / 2; }
__host__ __device__ __forceinline__ int perm32(int rho) { const int n = rho >> 4, i = rho & 15; return 8 * (i >> 2) + 4 * n + (i & 3); }

struct Unit { int pm, pn; };
struct Gemm { const bf16_t* A; const bf16_t* Bt; int M, N, K, lda; long a2off; int pm2; };

struct StaticOrder {
    int nM, nN, nwg, G, c;
    __host__ __device__ __forceinline__ void init(int M, int N, int G_, int c_) { nM = M / BM; nN = N / BM; nwg = nM * nN; G = G_; c = c_; }
    __host__ __device__ __forceinline__ bool next(int i, Unit& u) const {
        const long L = (long)i * G + c; if (L >= nwg) return false;
        int wgid = (int)L; { const int q = nwg / NXCD, r = nwg % NXCD, xcd = wgid % NXCD, off = wgid / NXCD; wgid = (xcd < r ? xcd * (q + 1) : r * (q + 1) + (xcd - r) * q) + off; }
        const int nig = WGM * nN, gid = wgid / nig, fm = gid * WGM, gsz = (nM - fm) < WGM ? (nM - fm) : WGM;
        u.pm = fm + ((wgid % nig) % gsz); u.pn = (wgid % nig) / gsz; return true;
    }
    __device__ __forceinline__ void a_ready(const Unit&) const {}
    __device__ __forceinline__ void done(const Unit&) const {}
};

template <class Epi, class Sched, bool ALIGN_EPI = false, bool SP2 = false>
__device__ __forceinline__ void gemm_phase(PG8_LAS unsigned char* lds, const Gemm g, const Sched& S, const Epi& E) {
    int tid_l = threadIdx.x; asm volatile("" : "+v"(tid_l));
    const int tid = tid_l, wid = __builtin_amdgcn_readfirstlane(tid >> 6), lane = tid & 63, wr = wid >> 2, wc = wid & 3, fr = lane & 15, fq = lane >> 4;
    const int K = g.K, nt = K / BK, lda = g.lda;
    unsigned voffA[2], voffB[2];
#pragma unroll
    for (int i = 0; i < 2; ++i) { int R, C; stage_rc(tid * 16 + i * 8192, R, C); const int Rb = Epi::PERM ? ((R & ~31) + perm32(R & 31)) : R;
        voffA[i] = (unsigned)(R * lda + C) * 2u; voffB[i] = (unsigned)(Rb * K + C) * 2u; }
    const size_t kstep = (size_t)(BK * 2);
    const size_t hstepB = (size_t)HALF * K * 2, hstepA = (size_t)HALF * lda * 2;
    const size_t tstepB = 2 * hstepB, tstepA = 2 * hstepA;
    const unsigned ldsw = (unsigned)wid * 1024u;
    const int aoff = lds_byte(wr * 64 + fr, fq * 8), boff = lds_byte(wc * 32 + fr, fq * 8);
#define PG8_SA(b, h) (((b) * 2 + (h)) * HTB)
#define PG8_SB(b, h) ((4 + (b) * 2 + (h)) * HTB)
#define PG8_STAGE(bufoff, gbase, voff) do { _Pragma("unroll") for (int _i = 0; _i < 2; ++_i) \
        __builtin_amdgcn_global_load_lds((const unsigned*)((const char*)(gbase) + (voff)[_i]), (PG8_LAS unsigned*)(lds + (bufoff) + ldsw + _i * 8192), 16, 0, 0); } while (0)
#define PG8_LDA(dst, b, h) do { _Pragma("unroll") for (int m = 0; m < 4; ++m) _Pragma("unroll") for (int k = 0; k < 2; ++k) dst[m][k] = *(const PG8_LAS bf16x8*)(lds + PG8_SA(b, h) + aoff + m * 2048 + k * 1024); } while (0)
#define PG8_LDB(dst, b, h) do { _Pragma("unroll") for (int n = 0; n < 2; ++n) _Pragma("unroll") for (int k = 0; k < 2; ++k) dst[n][k] = *(const PG8_LAS bf16x8*)(lds + PG8_SB(b, h) + boff + n * 2048 + k * 1024); } while (0)
#define PG8_MMA(ai, bj, At, Bt) do { __builtin_amdgcn_s_setprio(1); _Pragma("unroll") for (int m = 0; m < 4; ++m) _Pragma("unroll") for (int n = 0; n < 2; ++n) _Pragma("unroll") for (int k = 0; k < 2; ++k) \
        acc[ai][bj][m][n] = __builtin_amdgcn_mfma_f32_16x16x32_bf16(Bt[n][k], At[m][k], acc[ai][bj][m][n], 0, 0, 0); __builtin_amdgcn_s_setprio(0); } while (0)
#define PG8_WAIT_V(n) asm volatile("s_waitcnt vmcnt(" #n ")" ::: "memory")
#define PG8_WAIT_L(n) asm volatile("s_waitcnt lgkmcnt(" #n ")" ::: "memory")
#define PG8_BAR __builtin_amdgcn_s_barrier()
#define PG8_SCHED __builtin_amdgcn_sched_barrier(0)
    Unit cur, nxt; int ui = 0;
    if (!S.next(0, cur)) return;
    f32x4 acc[2][2][4][2];
#pragma unroll
    for (int a = 0; a < 2; ++a)
#pragma unroll
        for (int b = 0; b < 2; ++b)
#pragma unroll
            for (int m = 0; m < 4; ++m)
#pragma unroll
                for (int n = 0; n < 2; ++n) acc[a][b][m][n] = (f32x4){0.f, 0.f, 0.f, 0.f};
    bf16x8 At[4][2], B0[2][2], B1[2][2];
    const char* cA = (const char*)g.A + (cur.pm < g.pm2 ? (long)cur.pm * (long)tstepA : g.a2off + (long)(cur.pm - g.pm2) * (long)tstepA); const char* cB = (const char*)g.Bt + (size_t)cur.pn * tstepB;
    S.a_ready(cur);
    if constexpr (SP2) {
        PG8_STAGE(PG8_SB(0, 0), cB, voffB); PG8_STAGE(PG8_SB(0, 1), cB + hstepB, voffB); PG8_STAGE(PG8_SA(0, 0), cA, voffA); PG8_STAGE(PG8_SA(0, 1), cA + hstepA, voffA);
        if (wr == 1) PG8_BAR;
        PG8_WAIT_V(2); PG8_BAR;
        PG8_STAGE(PG8_SB(1, 0), cB + kstep, voffB); PG8_STAGE(PG8_SA(1, 0), cA + kstep, voffA); PG8_STAGE(PG8_SB(1, 1), cB + hstepB + kstep, voffB);
        PG8_WAIT_V(6); PG8_BAR;
    } else {
        PG8_STAGE(PG8_SB(0, 0), cB, voffB); PG8_STAGE(PG8_SA(0, 0), cA, voffA); PG8_STAGE(PG8_SB(0, 1), cB + hstepB, voffB); PG8_STAGE(PG8_SA(0, 1), cA + hstepA, voffA);
        if (wr == 1) PG8_BAR;
        PG8_WAIT_V(4); PG8_BAR;
        PG8_STAGE(PG8_SB(1, 0), cB + kstep, voffB); PG8_STAGE(PG8_SA(1, 0), cA + kstep, voffA); PG8_STAGE(PG8_SB(1, 1), cB + hstepB + kstep, voffB);
        PG8_WAIT_V(6); PG8_BAR;
    }
    for (;;) {
        const bool has_next = S.next(ui + 1, nxt);
        const char* nA = has_next ? (const char*)g.A + (nxt.pm < g.pm2 ? (long)nxt.pm * (long)tstepA : g.a2off + (long)(nxt.pm - g.pm2) * (long)tstepA) : cA; const char* nB = has_next ? (const char*)g.Bt + (size_t)nxt.pn * tstepB : cB;
        for (int t = 0; t < nt; t += 2) {
            if constexpr (Epi::RESCALE) { if (t == 8 || t == 16) E.rescale(acc, ui, t, wr, fr); }
            const bool last = (t == nt - 2);
            const char* a1 = cA + (size_t)(t + 1) * kstep;
            const char* a2 = last ? nA : cA + (size_t)(t + 2) * kstep; const char* b2 = last ? nB : cB + (size_t)(t + 2) * kstep;
            const char* a3 = a2 + kstep; const char* b3 = b2 + kstep;
            if (last && has_next) S.a_ready(nxt);
            if constexpr (SP2) {
            PG8_LDB(B0, 0, 0); PG8_LDB(B1, 0, 1); PG8_SCHED; PG8_LDA(At, 0, 0); PG8_STAGE(PG8_SA(1, 1), a1 + hstepA, voffA);
            PG8_WAIT_V(8); PG8_WAIT_L(0); PG8_BAR; PG8_MMA(0, 0, At, B0); PG8_MMA(0, 1, At, B1); PG8_BAR; PG8_SCHED;
            PG8_LDA(At, 0, 1); PG8_STAGE(PG8_SB(0, 0), b2, voffB); PG8_STAGE(PG8_SB(0, 1), b2 + hstepB, voffB); PG8_STAGE(PG8_SA(0, 0), a2, voffA);
            PG8_WAIT_V(8); PG8_WAIT_L(0); PG8_BAR; PG8_MMA(1, 0, At, B0); PG8_MMA(1, 1, At, B1); PG8_BAR; PG8_SCHED;
            PG8_LDB(B0, 1, 0); PG8_LDB(B1, 1, 1); PG8_SCHED; PG8_LDA(At, 1, 0); PG8_STAGE(PG8_SA(0, 1), a2 + hstepA, voffA);
            PG8_WAIT_V(8); PG8_WAIT_L(0); PG8_BAR; PG8_MMA(0, 0, At, B0); PG8_MMA(0, 1, At, B1); PG8_BAR; PG8_SCHED;
            PG8_LDA(At, 1, 1); PG8_STAGE(PG8_SB(1, 0), b3, voffB); PG8_STAGE(PG8_SB(1, 1), b3 + hstepB, voffB); PG8_STAGE(PG8_SA(1, 0), a3, voffA);
            PG8_WAIT_V(8); PG8_WAIT_L(0); PG8_BAR; PG8_MMA(1, 0, At, B0); PG8_MMA(1, 1, At, B1); PG8_BAR; PG8_SCHED;
            } else {
            PG8_LDB(B0, 0, 0); PG8_SCHED; PG8_LDA(At, 0, 0); PG8_STAGE(PG8_SA(1, 1), a1 + hstepA, voffA);
            PG8_WAIT_L(8); PG8_BAR; PG8_WAIT_L(0); PG8_MMA(0, 0, At, B0); PG8_BAR; PG8_SCHED;
            PG8_LDB(B1, 0, 1); PG8_STAGE(PG8_SB(0, 0), b2, voffB);
            PG8_BAR; PG8_WAIT_L(0); PG8_MMA(0, 1, At, B1); PG8_BAR;
            PG8_LDA(At, 0, 1); PG8_STAGE(PG8_SA(0, 0), a2, voffA);
            PG8_BAR; PG8_WAIT_L(0); PG8_MMA(1, 0, At, B0); PG8_BAR; PG8_SCHED;
            PG8_STAGE(PG8_SB(0, 1), b2 + hstepB, voffB);
            PG8_WAIT_V(6); PG8_BAR; PG8_MMA(1, 1, At, B1); PG8_BAR;
            PG8_LDB(B0, 1, 0); PG8_SCHED; PG8_LDA(At, 1, 0); PG8_STAGE(PG8_SA(0, 1), a2 + hstepA, voffA);
            PG8_WAIT_L(8); PG8_BAR; PG8_WAIT_L(0); PG8_MMA(0, 0, At, B0); PG8_BAR; PG8_SCHED;
            PG8_LDB(B1, 1, 1); PG8_STAGE(PG8_SB(1, 0), b3, voffB);
            PG8_BAR; PG8_WAIT_L(0); PG8_MMA(0, 1, At, B1); PG8_BAR;
            PG8_LDA(At, 1, 1); PG8_STAGE(PG8_SA(1, 0), a3, voffA);
            PG8_BAR; PG8_WAIT_L(0); PG8_MMA(1, 0, At, B0); PG8_BAR; PG8_SCHED;
            PG8_STAGE(PG8_SB(1, 1), b3 + hstepB, voffB);
            PG8_WAIT_V(6); PG8_BAR; PG8_MMA(1, 1, At, B1); PG8_BAR;
            }
        }
        if constexpr (ALIGN_EPI) { if (wr == 0) PG8_BAR; }
        if constexpr (Epi::RESCALE) { E.fin(acc, cur, ui, wr, wc, fr, fq); } else if constexpr (!Epi::AFTER_DRAIN) { E(acc, cur, wr, wc, fr, fq); S.done(cur); }
        if (!has_next) break;
#pragma unroll
        for (int a = 0; a < 2; ++a)
#pragma unroll
            for (int b = 0; b < 2; ++b)
#pragma unroll
                for (int m = 0; m < 4; ++m)
#pragma unroll
                    for (int n = 0; n < 2; ++n) acc[a][b][m][n] = (f32x4){0.f, 0.f, 0.f, 0.f};
        cur = nxt; cA = nA; cB = nB; ++ui;
        if constexpr (ALIGN_EPI) { if (wr == 1) PG8_BAR; }
    }
    PG8_WAIT_V(0);
    if constexpr (!ALIGN_EPI) { if (wr == 0) PG8_BAR; }
    PG8_BAR;
    if constexpr (Epi::AFTER_DRAIN) { E.fused(acc, cur, wr, wc, fr, fq, lds, wid, lane); S.done(cur); }
#undef PG8_SA
#undef PG8_SB
#undef PG8_STAGE
#undef PG8_LDA
#undef PG8_LDB
#undef PG8_MMA
#undef PG8_WAIT_V
#undef PG8_WAIT_L
#undef PG8_BAR
#undef PG8_SCHED
}
}

#include <hip/hip_bf16.h>
#include <cmath>
namespace attn_body {
using bf16=__hip_bfloat16;
using bf16x8=__attribute__((ext_vector_type(8)))short;
using s16x4=__attribute__((ext_vector_type(4)))short;
using f32x16=__attribute__((ext_vector_type(16)))float;
using u32x4=__attribute__((ext_vector_type(4)))unsigned;
constexpr int D=64,DM=3584;
constexpr int NW=8,QBLK=32,QB=QBLK*NW,KVBLK=64;
constexpr int ATTN_PITCH=DM, ATTN_UNIT_ROWS=QB;
__device__ __forceinline__ int crow(int r,int hi){return (r&3)+8*(r>>2)+4*hi;}
#define SBAR() __builtin_amdgcn_sched_barrier(0)
constexpr int NSLOT=3, SLOTB=8192;
constexpr int LDS_K=0, LDS_V=NSLOT*SLOTB, LDS_WS=2*NSLOT*SLOTB, LDS_OST=LDS_WS+NW*64*4, LDS_BYTES=LDS_OST+NW*4096;
constexpr float C2=0.125f*1.4426950408889634f;
__device__ __forceinline__ void glds16(const void*gsrc,unsigned lds_dst){unsigned keep;
  asm volatile("s_mov_b32 %0, m0\n\ts_mov_b32 m0, %2\n\ts_nop 0\n\tglobal_load_lds_dwordx4 %1, off\n\ts_mov_b32 m0, %0":"=&s"(keep):"v"(gsrc),"s"(lds_dst):"memory");}
__device__ __forceinline__ float max3f(float a,float b,float c){float r;asm("v_max3_f32 %0, %1, %2, %3":"=v"(r):"v"(a),"v"(b),"v"(c));return r;}
__device__ __forceinline__ float max2f(float a,float b){float r;asm("v_max_f32_e32 %0, %1, %2":"=v"(r):"v"(a),"v"(b));return r;}
__device__ __forceinline__ float fadd_s(float a,float b){float r;asm("v_add_f32_e32 %0, %1, %2":"=v"(r):"v"(a),"v"(b));return r;}
__device__ __forceinline__ float fsub_s(float a,float b){float r;asm("v_sub_f32_e32 %0, %1, %2":"=v"(r):"v"(a),"v"(b));return r;}
typedef float f32x2_t __attribute__((ext_vector_type(2))); typedef __bf16 bf16x2_t __attribute__((ext_vector_type(2)));
__device__ __forceinline__ unsigned cvtpk_s(float lo,float hi){f32x2_t v={lo,hi};bf16x2_t b=__builtin_convertvector(v,bf16x2_t);return __builtin_bit_cast(unsigned,b);}
#define WAIT_BAR(N) asm volatile("s_waitcnt vmcnt(" #N ") lgkmcnt(0)\n\ts_barrier":::"memory")

__device__ __forceinline__ void qkt(f32x16&p0,f32x16&p1,const char*Kslot,const bf16x8*qr,const f32x16&negm,int r32,int hi){
  const char*kb=Kslot+hi*1024+r32*16;
  #pragma unroll
  for(int d0=0;d0<4;++d0){
    const bf16x8 b0=*reinterpret_cast<const bf16x8*>(kb+d0*2048);
    const bf16x8 b1=*reinterpret_cast<const bf16x8*>(kb+d0*2048+512);
    if(d0==0){p0=__builtin_amdgcn_mfma_f32_32x32x16_bf16(b0,qr[0],negm,0,0,0);p1=__builtin_amdgcn_mfma_f32_32x32x16_bf16(b1,qr[0],negm,0,0,0);}
    else{p0=__builtin_amdgcn_mfma_f32_32x32x16_bf16(b0,qr[d0],p0,0,0,0);p1=__builtin_amdgcn_mfma_f32_32x32x16_bf16(b1,qr[d0],p1,0,0,0);}}
}
typedef __attribute__((address_space(3))) const char* lds_cptr;
typedef short v4i16_t __attribute__((ext_vector_type(4)));
__device__ __forceinline__ void kload8(bf16x8*kf,lds_cptr kp){
  kf[0]=*(const __attribute__((address_space(3))) bf16x8*)(kp);      kf[1]=*(const __attribute__((address_space(3))) bf16x8*)(kp+512);
  kf[2]=*(const __attribute__((address_space(3))) bf16x8*)(kp+2048); kf[3]=*(const __attribute__((address_space(3))) bf16x8*)(kp+2560);
  kf[4]=*(const __attribute__((address_space(3))) bf16x8*)(kp+4096); kf[5]=*(const __attribute__((address_space(3))) bf16x8*)(kp+4608);
  kf[6]=*(const __attribute__((address_space(3))) bf16x8*)(kp+6144); kf[7]=*(const __attribute__((address_space(3))) bf16x8*)(kp+6656);
}
__device__ __forceinline__ void kload2(bf16x8*kf,lds_cptr kp,int j){ kf[2*j]=*(const __attribute__((address_space(3))) bf16x8*)(kp+j*2048); kf[2*j+1]=*(const __attribute__((address_space(3))) bf16x8*)(kp+j*2048+512); }
__device__ __forceinline__ s16x4 vtr(lds_cptr p){ return __builtin_bit_cast(s16x4,__builtin_amdgcn_ds_read_tr16_b64_v4i16((__attribute__((address_space(3))) v4i16_t*)p)); }
__device__ __forceinline__ float rowmax(const f32x16&p0,const f32x16&p1){
  float a=max3f(p0[0],p0[1],p1[0]),b=max3f(p0[2],p0[3],p1[1]);a=max3f(a,p1[2],p1[3]);
  #pragma unroll
  for(int r=4;r<16;r+=4){a=max3f(a,p0[r],p0[r+1]);b=max3f(b,p0[r+2],p0[r+3]);a=max3f(a,p1[r],p1[r+1]);b=max3f(b,p1[r+2],p1[r+3]);}
  const float m=max2f(a,b);
  auto rr=__builtin_amdgcn_permlane32_swap(__float_as_uint(m),__float_as_uint(m),false,false);
  return max2f(__uint_as_float(rr[0]),__uint_as_float(rr[1]));
}
__device__ __forceinline__ void pv(f32x16*o,int vb,bf16x8 pa0,bf16x8 pa1,bf16x8 pa2,bf16x8 pa3){
  #pragma unroll
  for(int d0=0;d0<2;++d0){s16x4 lo[4],hi[4];
    #pragma unroll
    for(int ks=0;ks<4;++ks){
      asm volatile("ds_read_b64_tr_b16 %0,%1 offset:%c2":"=&v"(lo[ks]):"v"(vb),"i"(d0*4096+ks*1024):"memory");
      asm volatile("ds_read_b64_tr_b16 %0,%1 offset:%c2":"=&v"(hi[ks]):"v"(vb),"i"(d0*4096+ks*1024+512):"memory");}
    asm volatile("s_waitcnt lgkmcnt(0)":::"memory");SBAR();
    #define PK(k) (bf16x8){lo[k][0],lo[k][1],lo[k][2],lo[k][3],hi[k][0],hi[k][1],hi[k][2],hi[k][3]}
    o[d0]=__builtin_amdgcn_mfma_f32_32x32x16_bf16(pa0,PK(0),o[d0],0,0,0);
    o[d0]=__builtin_amdgcn_mfma_f32_32x32x16_bf16(pa1,PK(1),o[d0],0,0,0);
    o[d0]=__builtin_amdgcn_mfma_f32_32x32x16_bf16(pa2,PK(2),o[d0],0,0,0);
    o[d0]=__builtin_amdgcn_mfma_f32_32x32x16_bf16(pa3,PK(3),o[d0],0,0,0);
    #undef PK
  }
}

#ifndef ATTN_STORE16
#define ATTN_STORE16(p,v) (*(u32x4*)(p)=(v))
#endif
template<int THRL,bool FAST> __device__ __forceinline__ void attn_unit(float bref,long rowbase,int seqlen,int h,int qb,const bf16*Q,const bf16*__restrict__ K,const bf16*__restrict__ V,bf16*O,float*SSQ,char*shm){
  int tid_l=threadIdx.x; asm volatile("":"+v"(tid_l)); const int tid=tid_l,lane=tid&63,r32=lane&31,hi=lane>>5; const int wid=__builtin_amdgcn_readfirstlane(tid>>6);
  const int q0=qb*QB; const int kvh=h>>2;
  const bf16*Qw=Q+(rowbase+q0+wid*QBLK)*DM+h*D;
  constexpr int KDM=64; constexpr long KVTOK=81920;
  const bf16*Kh=K+((long)kvh*KVTOK+rowbase)*KDM,*Vh=V+((long)kvh*KVTOK+rowbase)*KDM;
  const unsigned lds0=(unsigned)(uintptr_t)shm;
  float*wsf=(float*)(shm+LDS_WS)+wid*64;
  const bf16*ksrc=Kh+(long)lane*KDM+wid*8;
  const bf16*vsrc=Vh+(long)(16*(wid&3)+(lane>>2))*KDM+(wid>>2)*32+(lane&3)*8;
  const unsigned kdst=lds0+LDS_K+wid*1024, vdst=lds0+LDS_V+wid*1024;
  #define DMA_K(t,slot) glds16(ksrc+(long)(t)*KVBLK*KDM,(unsigned)__builtin_amdgcn_readfirstlane(kdst+(slot)))
  #define DMA_V(t,slot) glds16(vsrc+(long)(t)*KVBLK*KDM,(unsigned)__builtin_amdgcn_readfirstlane(vdst+(slot)))
  const int vb0=(int)(lds0+LDS_V)+((lane>>4)&1)*32+(lane&3)*8+(4*hi+((lane&15)>>2))*64;
  const char*Kbase=shm+LDS_K; bf16x8 kf[8];
  const lds_cptr shm3=(lds_cptr)shm; const lds_cptr kp0=shm3+LDS_K+hi*1024+r32*16; const lds_cptr vp0=shm3+LDS_V+((lane>>4)&1)*32+(lane&3)*8+(4*hi+((lane&15)>>2))*64;
  const int NT=seqlen/KVBLK;
  DMA_K(0,0);DMA_V(0,0);DMA_K(1,SLOTB);
  bf16x8 qr[4];
  #pragma unroll
  for(int d0=0;d0<4;++d0)qr[d0]=*reinterpret_cast<const bf16x8*>(&Qw[(long)r32*DM+d0*16+hi*8]);
  float mhat=FAST?bref:0.f,l_reg=0.f;f32x16 o[2];o[0]=f32x16{};o[1]=f32x16{};f32x16 negm=f32x16{};
  if constexpr(FAST){
    #pragma unroll
    for(int r=0;r<16;++r)negm[r]=-bref;}
  asm volatile("":"+v"(negm));
  #define CMASK(P0,P1,t) do{}while(0)
  bool resc=false;
  #define START(P0,P1) do{ resc=false; \
    if constexpr(!FAST){ const float rm=rowmax(P0,P1); const float dl=rm; mhat=fadd_s(mhat,dl); \
      _Pragma("unroll") for(int r=0;r<16;++r){P0[r]=fsub_s(P0[r],dl);P1[r]=fsub_s(P1[r],dl);} \
      _Pragma("unroll") for(int r=0;r<16;++r)negm[r]=-mhat; asm volatile("":"+v"(negm)); } \
    _Pragma("unroll") for(int r=0;r<16;++r)P0[r]=__builtin_amdgcn_exp2f(P0[r]); }while(0)
  #define RESC() do{ if(resc){ asm volatile("s_waitcnt lgkmcnt(0)":::"memory"); \
      _Pragma("unroll") for(int d_=0;d_<2;++d_) _Pragma("unroll") for(int r=0;r<16;++r)o[d_][r]*=wsf[crow(r,hi)]; } }while(0)
  f32x16 pA0,pA1,pB0,pB1;
  int sl_prev=0,sl_cur=0,sl_next=SLOTB;
  #define ROT() do{sl_prev=sl_cur;sl_cur=sl_next;sl_next=(sl_next==(NSLOT-1)*SLOTB)?0:sl_next+SLOTB;}while(0)
  DMA_K(2,2*SLOTB);
  WAIT_BAR(3);
  qkt(pA0,pA1,Kbase,qr,negm,r32,hi);asm volatile("s_nop 15\n\ts_nop 7":"+v"(pA0),"+v"(pA1));
  START(pA0,pA1);
  _Pragma("unroll") for(int r=0;r<16;++r)pA1[r]=__builtin_amdgcn_exp2f(pA1[r]);
  WAIT_BAR(0);
  DMA_K(3,0);DMA_V(1,SLOTB);
  ROT();
  kload8(kf,kp0+sl_cur);
  WAIT_BAR(2);
  s16x4 vlo[8],vhi[8]; u32x4 pw0,pw1,pw2,pw3;
  #define PKW(P,B) cvtpk_s(P[B],P[B+1])
  #define PAF(k) __builtin_bit_cast(bf16x8,pw##k)
  #define VFR(i) (bf16x8){vlo[i][0],vlo[i][1],vlo[i][2],vlo[i][3],vhi[i][0],vhi[i][1],vhi[i][2],vhi[i][3]}
  #define PIN(x) asm volatile("":"+v"(x))
  #define MX3(a,b,c) __builtin_fmaxf(__builtin_fmaxf((a),(b)),(c))
  #define GAPA(MF,A0,A1,A2,A3,W0,W1,PW) do{ MF; sacc+=A0; sacc+=A1; sacc+=A2; sacc+=A3; PIN(sacc); W0; W1; PIN(PW); SBAR(); }while(0)
  #define EX(v) __builtin_amdgcn_exp2f(v)
  #define GAPB(MF,X,B) do{ MF; X[B]=EX(X[B]); X[B+1]=EX(X[B+1]); X[B+2]=EX(X[B+2]); X[B+3]=EX(X[B+3]); PIN(X); SBAR(); }while(0)
  #define VRD(i) do{ vlo[i]=vtr(vp_+(((i)>>2)*4096+((i)&3)*1024)); vhi[i]=vtr(vp_+(((i)>>2)*4096+((i)&3)*1024+512)); }while(0)
  #define KRD(G,j) do{ if(G){ kload2(kf,kp0+sl_next,j); SBAR(); } }while(0)
  #define STEP(C0,C1,P0,P1,t,GK,GV,GL) do{ SBAR(); \
    const lds_cptr vp_=vp0+sl_prev; \
    VRD(0); SBAR(); float sacc=(P0[0]+P0[1]); \
    GAPA(C0=__builtin_amdgcn_mfma_f32_32x32x16_bf16(kf[0],qr[0],negm,0,0,0), P0[2],P0[3],P0[4],P0[5],     pw0[0]=PKW(P0,0), pw0[1]=PKW(P0,2), pw0); \
    VRD(4); SBAR(); GAPA(C1=__builtin_amdgcn_mfma_f32_32x32x16_bf16(kf[1],qr[0],negm,0,0,0), P0[6],P0[7],P0[8],P0[9],     pw0[2]=PKW(P0,4), pw0[3]=PKW(P0,6), pw0); \
    VRD(1); SBAR(); GAPA(C0=__builtin_amdgcn_mfma_f32_32x32x16_bf16(kf[2],qr[1],C0,0,0,0),   P0[10],P0[11],P0[12],P0[13], pw1[0]=PKW(P0,8), pw1[1]=PKW(P0,10), pw1); \
    VRD(5); SBAR(); GAPA(C1=__builtin_amdgcn_mfma_f32_32x32x16_bf16(kf[3],qr[1],C1,0,0,0),   P0[14],P0[15],P1[0],P1[1],   pw1[2]=PKW(P0,12),pw1[3]=PKW(P0,14), pw1); \
    VRD(2); SBAR(); GAPA(C0=__builtin_amdgcn_mfma_f32_32x32x16_bf16(kf[4],qr[2],C0,0,0,0),   P1[2],P1[3],P1[4],P1[5],     pw2[0]=PKW(P1,0), pw2[1]=PKW(P1,2), pw2); \
    VRD(6); SBAR(); GAPA(C1=__builtin_amdgcn_mfma_f32_32x32x16_bf16(kf[5],qr[2],C1,0,0,0),   P1[6],P1[7],P1[8],P1[9],     pw2[2]=PKW(P1,4), pw2[3]=PKW(P1,6), pw2); \
    VRD(3); SBAR(); GAPA(C0=__builtin_amdgcn_mfma_f32_32x32x16_bf16(kf[6],qr[3],C0,0,0,0),   P1[10],P1[11],P1[12],P1[13], pw3[0]=PKW(P1,8), pw3[1]=PKW(P1,10), pw3); \
    VRD(7); SBAR(); GAPA(C1=__builtin_amdgcn_mfma_f32_32x32x16_bf16(kf[7],qr[3],C1,0,0,0),   P1[14],P1[15],0.f,0.f,       pw3[2]=PKW(P1,12),pw3[3]=PKW(P1,14), pw3); \
    l_reg+=sacc; \
    if(GK){DMA_K((t)+3,sl_cur);} if(GV){DMA_V((t)+1,sl_next);} \
    CMASK(C0,C1,t); \
    if constexpr(!FAST){ float a=MX3(C0[0],C0[1],C1[0]),b=MX3(C0[2],C0[3],C1[1]); a=MX3(a,C1[2],C1[3]); \
      _Pragma("unroll") for(int r=4;r<16;r+=4){a=MX3(a,C0[r],C0[r+1]);b=MX3(b,C0[r+2],C0[r+3]);a=MX3(a,C1[r],C1[r+1]);b=MX3(b,C1[r+2],C1[r+3]);} \
      float rm=__builtin_fmaxf(a,b); { auto rr=__builtin_amdgcn_permlane32_swap(__float_as_uint(rm),__float_as_uint(rm),false,false); rm=__builtin_fmaxf(__uint_as_float(rr[0]),__uint_as_float(rr[1])); } \
      resc=false; \
      if(__builtin_expect(__any(rm>(float)THRL),0)){ const float dl=__builtin_fmaxf(rm,0.f); mhat+=dl; \
        _Pragma("unroll") for(int r=0;r<16;++r){C0[r]-=dl;C1[r]-=dl;} \
        _Pragma("unroll") for(int r=0;r<16;++r)negm[r]=-mhat; asm volatile("":"+v"(negm)); \
        const float f=__builtin_amdgcn_exp2f(-dl); l_reg*=f; if(hi==0)wsf[r32]=f; resc=true; } } \
    SBAR(); \
    GAPB(o[0]=__builtin_amdgcn_mfma_f32_32x32x16_bf16(PAF(0),VFR(0),o[0],0,0,0), C0,0); \
    GAPB(o[1]=__builtin_amdgcn_mfma_f32_32x32x16_bf16(PAF(0),VFR(4),o[1],0,0,0), C0,4); \
    KRD(GL,0); GAPB(o[0]=__builtin_amdgcn_mfma_f32_32x32x16_bf16(PAF(1),VFR(1),o[0],0,0,0), C0,8); \
    KRD(GL,1); GAPB(o[1]=__builtin_amdgcn_mfma_f32_32x32x16_bf16(PAF(1),VFR(5),o[1],0,0,0), C0,12); \
    KRD(GL,2); GAPB(o[0]=__builtin_amdgcn_mfma_f32_32x32x16_bf16(PAF(2),VFR(2),o[0],0,0,0), C1,0); \
    KRD(GL,3); GAPB(o[1]=__builtin_amdgcn_mfma_f32_32x32x16_bf16(PAF(2),VFR(6),o[1],0,0,0), C1,4); \
    GAPB(o[0]=__builtin_amdgcn_mfma_f32_32x32x16_bf16(PAF(3),VFR(3),o[0],0,0,0), C1,8); \
    GAPB(o[1]=__builtin_amdgcn_mfma_f32_32x32x16_bf16(PAF(3),VFR(7),o[1],0,0,0), C1,12); \
    }while(0)
  int t=1;
  for(;t+5<NT;t+=2){
    STEP(pB0,pB1,pA0,pA1,t,true,true,true);     WAIT_BAR(2); RESC(); ROT();
    STEP(pA0,pA1,pB0,pB1,t+1,true,true,true);   WAIT_BAR(2); RESC(); ROT();
  }
  #define ENDW(tt) do{ if((tt)+3<NT){WAIT_BAR(2);} else if((tt)+2<NT){WAIT_BAR(1);} else {WAIT_BAR(0);} }while(0)
  for(;t+1<NT;t+=2){
    STEP(pB0,pB1,pA0,pA1,t,(t+3<NT),(t+1<NT),(t+1<NT));       ENDW(t);   RESC(); ROT();
    STEP(pA0,pA1,pB0,pB1,t+1,(t+4<NT),(t+2<NT),(t+2<NT));     ENDW(t+1); RESC(); ROT();
  }
  STEP(pB0,pB1,pA0,pA1,NT-1,false,false,false); RESC();
  { float sacc=pB0[0]+pB0[1]; _Pragma("unroll") for(int r=2;r<16;++r)sacc+=pB0[r]; _Pragma("unroll") for(int r=0;r<16;++r)sacc+=pB1[r]; l_reg+=sacc;
    pw0=(u32x4){PKW(pB0,0),PKW(pB0,2),PKW(pB0,4),PKW(pB0,6)};pw1=(u32x4){PKW(pB0,8),PKW(pB0,10),PKW(pB0,12),PKW(pB0,14)};pw2=(u32x4){PKW(pB1,0),PKW(pB1,2),PKW(pB1,4),PKW(pB1,6)};pw3=(u32x4){PKW(pB1,8),PKW(pB1,10),PKW(pB1,12),PKW(pB1,14)};
    SBAR(); pv(o,vb0+sl_cur,PAF(0),PAF(1),PAF(2),PAF(3)); }
  #undef PKW
  #undef PAF
  #undef VFR
  #undef PIN
  #undef MX3
  #undef GAPA
  #undef GAPB
  #undef EX
  #undef VRD
  #undef KRD
  #undef STEP
  #undef ENDW
  {auto rr=__builtin_amdgcn_permlane32_swap(__float_as_uint(l_reg),__float_as_uint(l_reg),false,false);l_reg=__uint_as_float(rr[0])+__uint_as_float(rr[1]);}
  if(hi==0)wsf[32+r32]=l_reg;asm volatile("s_waitcnt lgkmcnt(0)":::"memory");
  float rli[16];
  #pragma unroll
  for(int r=0;r<16;++r)rli[r]=__builtin_amdgcn_rcpf(wsf[32+crow(r,hi)]);
  bf16*Ow=O+(rowbase+q0+wid*QBLK)*DM+h*D;
  { bf16*stg=(bf16*)(shm+LDS_OST)+wid*2048;
    #pragma unroll
    for(int r=0;r<16;++r){const int orow=crow(r,hi);
      #pragma unroll
      for(int d0=0;d0<2;++d0)stg[orow*64+d0*32+r32]=__float2bfloat16(o[d0][r]*rli[r]);}
    asm volatile("s_waitcnt lgkmcnt(0)":::"memory");
    #pragma unroll
    for(int i=0;i<4;++i){const int row=i*8+(lane>>3),ch=lane&7; const u32x4 v=*(const u32x4*)(stg+row*64+ch*8); ATTN_STORE16(Ow+(long)row*DM+ch*8,v);
      float q=0.f;
      #pragma unroll
      for(int e=0;e<4;++e){const float a=__uint_as_float(v[e]<<16),b=__uint_as_float(v[e]&0xffff0000u);q+=a*a+b*b;}
      q+=__shfl_xor(q,1);q+=__shfl_xor(q,2);q+=__shfl_xor(q,4);
      if(ch==0)SSQ[(rowbase+q0+wid*QBLK+row)*8+h]=q;} }
  asm volatile("s_waitcnt lgkmcnt(0)\n\ts_barrier":::"memory");
  #undef DMA_K
  #undef DMA_V
  #undef CMASK
  #undef START
  #undef RESC
  #undef ROT
}
constexpr int ATTN_LDS_BYTES=LDS_BYTES;
struct AttnTensors { const bf16* Q; const bf16* K; const bf16* V; bf16* O; float* SSQ; };
template<int THRL,bool FAST> __device__ __forceinline__ void attn_phase(float bref,char*lds,const AttnTensors&T,int vcu,int G){
  for(int u=vcu;u<2560;u+=G){
    long rowbase;int seqlen,h,qb;
    if(u<512){rowbase=0;seqlen=16384;h=u>>6;qb=u&63;}
    else{const int u2=u-512;const int s=u2>>8;rowbase=16384+(long)s*8192;seqlen=8192;h=(u2>>5)&7;qb=u2&31;}
    attn_unit<THRL,FAST>(bref,rowbase,seqlen,h,qb,T.Q,T.K,T.V,T.O,T.SSQ,lds);
  }
}
#undef SBAR
#undef WAIT_BAR
}

namespace cg = cooperative_groups;
#ifndef PHMASK
#define PHMASK 0xffff
#endif

#define LAS __attribute__((address_space(3)))
typedef unsigned short bf16;
typedef unsigned v4u __attribute__((ext_vector_type(4)));
typedef unsigned v2u __attribute__((ext_vector_type(2)));
typedef float f32x4 __attribute__((ext_vector_type(4)));
typedef short bf16x8 __attribute__((ext_vector_type(8)));

constexpr int NTOK = 81920, PP = 3584;
constexpr int QC = 1024, XC = 1536, KC = 3072, VC = 3200, DTC = 3328;
constexpr int NCHUNK = 640;
constexpr float LOG2E = 1.4426950408889634f, EPSN = 1e-6f;
constexpr size_t MiB = 1u << 20;
constexpr size_t WS_TAB = 0, WS_WIN = 1 * MiB, WS_WOUT = 8 * MiB, WS_WXQ = 11 * MiB, WS_WXKV = 12 * MiB, WS_WXO = 14 * MiB, WS_WGU = 15 * MiB, WS_WD = 26 * MiB,
                 WS_MEMN = 32 * MiB, WS_MKV = 37 * MiB, WS_XN = 42 * MiB, WS_DT = 42 * MiB, WS_CS = 52 * MiB, WS_DEC = 62 * MiB, WS_SSQS = 64 * MiB, WS_SSQA = 66 * MiB, WS_KC = 122 * MiB, WS_VC = 1002 * MiB,
                 WS_PROJ = 202 * MiB, WS_Q2 = 202 * MiB, WS_CA = 282 * MiB, WS_HID = 202 * MiB, WS_XBC = 762 * MiB, WS_RAW = 762 * MiB, WS_X2B0 = 642 * MiB, WS_X2B1 = 922 * MiB, WS_END = 1022 * MiB, WS_BAR = 512 * 1024;
constexpr int LDS_BYTES = 152 * 1024;

__device__ __forceinline__ unsigned f2bf(float f) { unsigned u = __builtin_bit_cast(unsigned, f); return (u + 0x7fffu + ((u >> 16) & 1u)) >> 16; }
typedef float f32x2_t __attribute__((ext_vector_type(2))); typedef __bf16 bf16x2_t __attribute__((ext_vector_type(2)));
__device__ __forceinline__ unsigned pk2(float lo, float hi) { f32x2_t v = {lo, hi}; bf16x2_t b = __builtin_convertvector(v, bf16x2_t); return __builtin_bit_cast(unsigned, b); }
__device__ __forceinline__ float bflo(unsigned w) { return __builtin_bit_cast(float, w << 16); }
__device__ __forceinline__ float bfhi(unsigned w) { return __builtin_bit_cast(float, w & 0xffff0000u); }
__device__ __forceinline__ float bf1(bf16 h) { return __builtin_bit_cast(float, ((unsigned)h) << 16); }
__device__ __forceinline__ float wave_sum(float v) {
#pragma unroll
    for (int o = 1; o < 64; o <<= 1) v += __shfl_xor(v, o);
    return v;
}
__device__ __forceinline__ float ex2(float x) { return __builtin_amdgcn_exp2f(x); }
__device__ __forceinline__ f32x4 mfma16(bf16x8 a, bf16x8 b, f32x4 c) { return __builtin_amdgcn_mfma_f32_16x16x32_bf16(a, b, c, 0, 0, 0); }
__device__ __forceinline__ const float* xrow(const float* xp, const float* xs, int t) { return t < 16384 ? xp + (size_t)t * 1024 : xs + (size_t)(t - 16384) * 1024; }
#define LDS_WAIT() asm volatile("s_waitcnt lgkmcnt(0)" ::: "memory")
#define LBAR() asm volatile("s_waitcnt lgkmcnt(0)\n\ts_barrier" ::: "memory")

struct EpiStore {
    static constexpr bool PERM = true, AFTER_DRAIN = false, RESCALE = false;
    bf16* O; int ldc; float scale; const float* rs;
    __device__ __forceinline__ void operator()(const f32x4 (&acc)[2][2][4][2], const pg8::Unit& u, int wr, int wc, int fr, int fq) const {
        const int row0 = u.pm * 256 + wr * 64 + fr, col0 = u.pn * 256 + wc * 32 + 8 * fq;
#pragma unroll
        for (int ai = 0; ai < 2; ++ai)
#pragma unroll
            for (int m = 0; m < 4; ++m) { bf16* rowp = O + (size_t)(row0 + ai * 128 + m * 16) * ldc + col0; const float sc = rs ? scale * rs[row0 + ai * 128 + m * 16] : scale;
#pragma unroll
                for (int bj = 0; bj < 2; ++bj) { const f32x4 v0 = acc[ai][bj][m][0] * sc, v1 = acc[ai][bj][m][1] * sc;
                    v4u w; w.x = pk2(v0[0], v0[1]); w.y = pk2(v0[2], v0[3]); w.z = pk2(v1[0], v1[1]); w.w = pk2(v1[2], v1[3]);
                    *(v4u*)(rowp + bj * 128) = w; } }
    }
};
struct EpiProj {
    static constexpr bool PERM = true, AFTER_DRAIN = false, RESCALE = false;
    bf16* O; bf16* VCp;
    __device__ __forceinline__ void operator()(const f32x4 (&acc)[2][2][4][2], const pg8::Unit& u, int wr, int wc, int fr, int fq) const {
        const int row0 = u.pm * 256 + wr * 64 + fr, col0 = u.pn * 256 + wc * 32 + 8 * fq;
        if (u.pn == 13 && wc != 0) return;
#pragma unroll
        for (int ai = 0; ai < 2; ++ai)
#pragma unroll
            for (int m = 0; m < 4; ++m) { const int row = row0 + ai * 128 + m * 16; bf16* rowp = O + (size_t)row * PP + col0;
#pragma unroll
                for (int bj = 0; bj < 2; ++bj) { if (u.pn == 13 && bj == 1) continue;
                    const f32x4 v0 = acc[ai][bj][m][0], v1 = acc[ai][bj][m][1];
                    v4u w; w.x = pk2(v0[0], v0[1]); w.y = pk2(v0[2], v0[3]); w.z = pk2(v1[0], v1[1]); w.w = pk2(v1[2], v1[3]);
                    if (u.pn == 12 && bj == 1) { const int cv = wc * 32 + 8 * fq; *(v4u*)(VCp + ((size_t)(cv >> 6) * NTOK + row) * 64 + (cv & 63)) = w; }
                    else *(v4u*)(rowp + bj * 128) = w; } }
    }
};
struct EpiRowScale {
    static constexpr bool PERM = true, AFTER_DRAIN = false, RESCALE = true;
    bf16* O; int ldc; const LAS float* Rl;
    __device__ __forceinline__ void rescale(f32x4 (&acc)[2][2][4][2], int ui, int t, int wr, int fr) const {
        const LAS float* rp = Rl + (size_t)ui * 1024 + (wr * 64 + fr) * 4 + (t == 8 ? 0 : 1);
#pragma unroll
        for (int ai = 0; ai < 2; ++ai)
#pragma unroll
            for (int m = 0; m < 4; ++m) { const float f = rp[(ai * 128 + m * 16) * 4];
#pragma unroll
                for (int bj = 0; bj < 2; ++bj)
#pragma unroll
                    for (int n = 0; n < 2; ++n) acc[ai][bj][m][n] = acc[ai][bj][m][n] * f; }
    }
    __device__ __forceinline__ void fin(const f32x4 (&acc)[2][2][4][2], const pg8::Unit& u, int ui, int wr, int wc, int fr, int fq) const {
        const int row0 = u.pm * 256 + wr * 64 + fr, col0 = u.pn * 256 + wc * 32 + 8 * fq; const LAS float* rp = Rl + (size_t)ui * 1024 + (wr * 64 + fr) * 4 + 2;
#pragma unroll
        for (int ai = 0; ai < 2; ++ai)
#pragma unroll
            for (int m = 0; m < 4; ++m) { bf16* rowp = O + (size_t)(row0 + ai * 128 + m * 16) * ldc + col0; const float scale = rp[(ai * 128 + m * 16) * 4];
#pragma unroll
                for (int bj = 0; bj < 2; ++bj) { const f32x4 v0 = acc[ai][bj][m][0] * scale, v1 = acc[ai][bj][m][1] * scale;
                    v4u w; w.x = pk2(v0[0], v0[1]); w.y = pk2(v0[2], v0[3]); w.z = pk2(v1[0], v1[1]); w.w = pk2(v1[2], v1[3]);
                    *(v4u*)(rowp + bj * 128) = w; } }
    }
    __device__ __forceinline__ void operator()(const f32x4 (&acc)[2][2][4][2], const pg8::Unit& u, int wr, int wc, int fr, int fq) const {}
};
struct EpiSwiglu {
    static constexpr bool PERM = true, AFTER_DRAIN = false, RESCALE = false;
    bf16* O; int ldc; const float* rs;
    __device__ __forceinline__ void operator()(const f32x4 (&acc)[2][2][4][2], const pg8::Unit& u, int wr, int wc, int fr, int fq) const {
        const int row0 = u.pm * 256 + wr * 64 + fr, col0 = u.pn * 128 + wc * 32 + 8 * fq;
#pragma unroll
        for (int ai = 0; ai < 2; ++ai)
#pragma unroll
            for (int m = 0; m < 4; ++m) { bf16* rowp = O + (size_t)(row0 + ai * 128 + m * 16) * ldc + col0; float h[8]; const float sc = rs[row0 + ai * 128 + m * 16];
#pragma unroll
                for (int n = 0; n < 2; ++n)
#pragma unroll
                    for (int i = 0; i < 4; ++i) { const float g = acc[ai][0][m][n][i] * sc, up = acc[ai][1][m][n][i] * sc; h[4 * n + i] = g * __builtin_amdgcn_rcpf(1.f + ex2(-g * LOG2E)) * up; }
                v4u w; w.x = pk2(h[0], h[1]); w.y = pk2(h[2], h[3]); w.z = pk2(h[4], h[5]); w.w = pk2(h[6], h[7]);
                *(v4u*)rowp = w; }
    }
};

__device__ __forceinline__ void tr_item(const float* W, int pitch, int k0, int ncol0, bf16* WT, int dstK, int drow0, LAS float* scr, int lane, const float* gk = nullptr) {
    float tv[32];
#pragma unroll
    for (int i = 0; i < 32; ++i) { const int kk = 2 * i + (lane >> 5); tv[i] = W[(size_t)(k0 + kk) * pitch + ncol0 + (lane & 31)]; if (gk) tv[i] *= gk[kk]; }
#pragma unroll
    for (int i = 0; i < 32; ++i) { const int kk = 2 * i + (lane >> 5); scr[kk * 33 + (lane & 31)] = tv[i]; }
    LDS_WAIT(); asm volatile("" ::: "memory");
    const int c = lane & 7;
#pragma unroll
    for (int j = 0; j < 4; ++j) { const int n = (lane >> 3) + 8 * j; const LAS float* s = scr + (8 * c) * 33 + n;
        v4u o; o.x = pk2(s[0 * 33], s[1 * 33]); o.y = pk2(s[2 * 33], s[3 * 33]); o.z = pk2(s[4 * 33], s[5 * 33]); o.w = pk2(s[6 * 33], s[7 * 33]);
        *(v4u*)(WT + (size_t)(drow0 + n) * dstK + k0 + 8 * c) = o; }
    LDS_WAIT(); asm volatile("" ::: "memory");
}

constexpr int XSPLIT = 61440;
template <int RB> __device__ __forceinline__ void norm_rows(const float* xp, const float* xs, const bf16* xb_in0, const bf16* xb_in1, const bf16* RAW, const float* gpost, float* out, bf16* xb_out0, bf16* xb_out1,
                                                            const float* gpre, bf16* XN, float* rs_out, int gw, int NGW, int lane) {
    for (int tb = gw; tb < NTOK; tb += NGW * RB) {
        f32x4 v[RB][4]; v2u rw[RB][4];
#pragma unroll
        for (int k = 0; k < RB; ++k) { const int t = tb + k * NGW; if (t < NTOK) {
            if (xp) { const float* base = xrow(xp, xs, t);
#pragma unroll
                for (int j = 0; j < 4; ++j) v[k][j] = ((const f32x4*)base)[lane + 64 * j]; }
            else { const bf16* base = t < XSPLIT ? xb_in0 + (size_t)t * 1024 : xb_in1 + (size_t)(t - XSPLIT) * 1024;
#pragma unroll
                for (int j = 0; j < 4; ++j) { const v2u w = *(const v2u*)(base + 4 * (lane + 64 * j)); v[k][j] = (f32x4){bflo(w.x), bfhi(w.x), bflo(w.y), bfhi(w.y)}; } }
            if (RAW) {
#pragma unroll
                for (int j = 0; j < 4; ++j) rw[k][j] = *(const v2u*)(RAW + (size_t)t * 1024 + 4 * (lane + 64 * j)); } } }
#pragma unroll
        for (int k = 0; k < RB; ++k) { const int t = tb + k * NGW; if (t < NTOK) {
            if (RAW) {
                f32x4 r[4]; float ss = 0.f;
#pragma unroll
                for (int j = 0; j < 4; ++j) { const v2u w = rw[k][j]; r[j] = (f32x4){bflo(w.x), bfhi(w.x), bflo(w.y), bfhi(w.y)};
                    ss += (r[j].x * r[j].x + r[j].y * r[j].y) + (r[j].z * r[j].z + r[j].w * r[j].w); }
                const float rstd = 1.0f / sqrtf(wave_sum(ss) * (1.f / 1024.f) + EPSN);
#pragma unroll
                for (int j = 0; j < 4; ++j) { const f32x4 g = ((const f32x4*)gpost)[lane + 64 * j]; v[k][j] = v[k][j] + r[j] * rstd * g; }
            }
            if (out) {
#pragma unroll
                for (int j = 0; j < 4; ++j) ((f32x4*)(out + (size_t)t * 1024))[lane + 64 * j] = v[k][j]; }
            if (xb_out0) { bf16* ob = t < XSPLIT ? xb_out0 + (size_t)t * 1024 : xb_out1 + (size_t)(t - XSPLIT) * 1024;
#pragma unroll
                for (int j = 0; j < 4; ++j) { v2u w; w.x = pk2(v[k][j].x, v[k][j].y); w.y = pk2(v[k][j].z, v[k][j].w); *(v2u*)(ob + 4 * (lane + 64 * j)) = w; } }
            if (XN || rs_out) {
                float s2 = 0.f;
#pragma unroll
                for (int j = 0; j < 4; ++j) s2 += (v[k][j].x * v[k][j].x + v[k][j].y * v[k][j].y) + (v[k][j].z * v[k][j].z + v[k][j].w * v[k][j].w);
                const float rstd2 = 1.0f / sqrtf(wave_sum(s2) * (1.f / 1024.f) + EPSN);
                if (rs_out && lane == 0) rs_out[t] = rstd2;
                if (XN) {
#pragma unroll
                for (int j = 0; j < 4; ++j) { const f32x4 g = ((const f32x4*)gpre)[lane + 64 * j]; const f32x4 o = v[k][j] * rstd2 * g;
                    v2u w; w.x = pk2(o.x, o.y); w.y = pk2(o.z, o.w); *(v2u*)(XN + (size_t)t * 1024 + 4 * (lane + 64 * j)) = w; } }
            } } }
    }
}

template <int NCH  > __device__ __forceinline__ void lds_transpose128(const bf16* src, int pitch, LAS unsigned char* dst, int tid) {
#pragma unroll
    for (int rep = 0; rep < NCH / 8; ++rep) { const int it = tid + 512 * rep, i = it & 63, ch = it >> 6;
        const bf16* p = src + (size_t)(2 * i) * pitch + ch * 8; const v4u r0 = *(const v4u*)p, r1 = *(const v4u*)(p + pitch);
#pragma unroll
        for (int j = 0; j < 8; ++j) { const unsigned a = r0[j >> 1], b = r1[j >> 1]; const unsigned lo = (j & 1) ? (a >> 16) : (a & 0xffffu), hi = (j & 1) ? (b & 0xffff0000u) : (b << 16);
            *(LAS unsigned*)(dst + (ch * 8 + j) * 272 + 4 * i) = lo | hi; } }
}
__device__ __forceinline__ void lds_copy128(const bf16* src, int pitch, LAS unsigned char* dst, int tid) {
#pragma unroll
    for (int rep = 0; rep < 4; ++rep) { const int it = tid + 512 * rep, r = it >> 4, ch = it & 15; *(LAS v4u*)(dst + r * 272 + ch * 16) = *(const v4u*)(src + (size_t)r * pitch + ch * 8); }
}
__device__ __forceinline__ bf16x8 scale8(v4u x, f32x4 w0, f32x4 w1) {
    v4u o; o.x = pk2(bflo(x.x) * w0.x, bfhi(x.x) * w0.y); o.y = pk2(bflo(x.y) * w0.z, bfhi(x.y) * w0.w); o.z = pk2(bflo(x.z) * w1.x, bfhi(x.z) * w1.y); o.w = pk2(bflo(x.w) * w1.z, bfhi(x.w) * w1.w);
    return __builtin_bit_cast(bf16x8, o);
}
__device__ __forceinline__ bf16x8 scale8s(v4u x, float w) {
    v4u o; o.x = pk2(bflo(x.x) * w, bfhi(x.x) * w); o.y = pk2(bflo(x.y) * w, bfhi(x.y) * w); o.z = pk2(bflo(x.z) * w, bfhi(x.z) * w); o.w = pk2(bflo(x.w) * w, bfhi(x.w) * w);
    return __builtin_bit_cast(bf16x8, o);
}

__device__ __forceinline__ void ssdA_load(const bf16* XBC, const float* DT, const float* CS, int u, int tid, v4u (&pb)[2][2], v4u (&px)[4][2], float (&pw)[2][3]) {
    const int c = u >> 2, g = (u >> 1) & 1, hh = u & 1, h0 = 8 * g + 4 * hh; const size_t tok0 = (size_t)c * 128;
#pragma unroll
    for (int rep = 0; rep < 2; ++rep) { const int it = tid + 512 * rep, i = it & 63, ch = it >> 6; const bf16* p = XBC + (tok0 + 2 * i) * 1536 + 1024 + g * 128 + ch * 8; pb[rep][0] = *(const v4u*)p; pb[rep][1] = *(const v4u*)(p + 1536); }
#pragma unroll
    for (int rep = 0; rep < 4; ++rep) { const int it = tid + 512 * rep, i = it & 63, ch = it >> 6; const bf16* p = XBC + (tok0 + 2 * i) * 1536 + h0 * 64 + ch * 8; px[rep][0] = *(const v4u*)p; px[rep][1] = *(const v4u*)(p + 1536); }
#pragma unroll
    for (int rep = 0; rep < 2; ++rep) { const int idx = tid + 512 * rep, hd = idx >> 8, dir = (idx >> 7) & 1, s = idx & 127, j = dir * 16 + h0 + hd;
        pw[rep][0] = CS[(tok0 + s) * 32 + j]; pw[rep][1] = CS[(tok0 + (dir ? 0 : 127)) * 32 + j]; pw[rep][2] = DT[(tok0 + s) * 32 + j]; }
}
__device__ __forceinline__ void tr_write(LAS unsigned char* dst, int ch, int i, v4u r0, v4u r1) {
#pragma unroll
    for (int j = 0; j < 8; ++j) { const unsigned a = r0[j >> 1], b = r1[j >> 1]; const unsigned lo = (j & 1) ? (a >> 16) : (a & 0xffffu), hi = (j & 1) ? (b & 0xffff0000u) : (b << 16);
        *(LAS unsigned*)(dst + (ch * 8 + j) * 272 + 4 * i) = lo | hi; }
}
__device__ __forceinline__ void ssd_states(LAS unsigned char* lds, const bf16* XBC, const float* DT, const float* CS, bf16* ST, int vcu, int G, int tid0) {
    const int wave = __builtin_amdgcn_readfirstlane(tid0 >> 6);
    LAS unsigned char* BT = lds; LAS unsigned char* XT = lds + 34816; LAS float* Wv = (LAS float*)(lds + 34816 + 69632);
    v4u pb[2][2], px[4][2]; float pw[2][3];
    if (vcu < 4 * NCHUNK) ssdA_load(XBC, DT, CS, vcu, tid0, pb, px, pw);
    for (int u = vcu; u < 4 * NCHUNK; u += G) {
        int tid = tid0; asm volatile("" : "+v"(tid));
        const int lane = tid & 63, fr = lane & 15, fq = lane >> 4;
        const int c = u >> 2, g = (u >> 1) & 1, hh = u & 1, h0 = 8 * g + 4 * hh;
#pragma unroll
        for (int rep = 0; rep < 2; ++rep) { const int it = tid + 512 * rep; tr_write(BT, it >> 6, it & 63, pb[rep][0], pb[rep][1]); }
#pragma unroll
        for (int rep = 0; rep < 4; ++rep) { const int it = tid + 512 * rep; tr_write(XT, it >> 6, it & 63, px[rep][0], px[rep][1]); }
#pragma unroll
        for (int rep = 0; rep < 2; ++rep) Wv[tid + 512 * rep] = ex2(pw[rep][1] - pw[rep][0]) * pw[rep][2];
        LBAR();
        if (u + G < 4 * NCHUNK) ssdA_load(XBC, DT, CS, u + G, tid, pb, px, pw);
        const int hd = wave >> 1, dir = wave & 1;
        f32x4 acc[8][4];
#pragma unroll
        for (int a = 0; a < 8; ++a)
#pragma unroll
            for (int b = 0; b < 4; ++b) acc[a][b] = (f32x4){0.f, 0.f, 0.f, 0.f};
#pragma unroll 1
        for (int ks = 0; ks < 4; ++ks) {
            const LAS float* wp = Wv + (hd * 2 + dir) * 128 + ks * 32 + fq * 8; const f32x4 w0 = *(const LAS f32x4*)wp, w1 = *(const LAS f32x4*)(wp + 4);
            bf16x8 bfr[4];
#pragma unroll
            for (int pt = 0; pt < 4; ++pt) bfr[pt] = scale8(*(const LAS v4u*)(XT + (hd * 64 + pt * 16 + fr) * 272 + (ks * 32 + fq * 8) * 2), w0, w1);
#pragma unroll
            for (int nt = 0; nt < 8; ++nt) { const bf16x8 a = *(const LAS bf16x8*)(BT + (nt * 16 + fr) * 272 + (ks * 32 + fq * 8) * 2);
#pragma unroll
                for (int pt = 0; pt < 4; ++pt) acc[nt][pt] = mfma16(a, bfr[pt], acc[nt][pt]); }
        }
        bf16* dst = ST + ((size_t)(c * 2 + dir) * 16 + (h0 + hd)) * 8192;
#pragma unroll
        for (int nt = 0; nt < 8; ++nt)
#pragma unroll
            for (int pt = 0; pt < 4; ++pt) { v2u w; w.x = pk2(acc[nt][pt][0], acc[nt][pt][1]); w.y = pk2(acc[nt][pt][2], acc[nt][pt][3]); *(v2u*)(dst + (pt * 16 + fr) * 128 + nt * 16 + fq * 4) = w; }
        LBAR();
    }
}

__device__ __forceinline__ void ssd_pass(bf16* ST, const float* DEC, int gtid, int NT_) {
    for (int it = gtid; it < 18 * 16384; it += NT_) {
        const int sd = it >> 14, v = it & 16383, s = sd >> 1, dir = sd & 1, head = v >> 10;
        const int c0 = s == 0 ? 0 : 128 + (s - 1) * 64, nc = s == 0 ? 128 : 64;
        float h[8];
#pragma unroll
        for (int k = 0; k < 8; ++k) h[k] = 0.f;
        for (int i = 0; i < nc; i += 8) {
            v4u sv[8]; float d[8]; bf16* pp[8];
#pragma unroll
            for (int q = 0; q < 8; ++q) { const int c = dir ? (c0 + nc - 1 - (i + q)) : (c0 + i + q); pp[q] = ST + ((size_t)(c * 2 + dir) * 16) * 8192 + (size_t)v * 8; sv[q] = *(const v4u*)pp[q]; d[q] = DEC[c * 32 + dir * 16 + head]; }
#pragma unroll
            for (int q = 0; q < 8; ++q) { v4u o; o.x = pk2(h[0], h[1]); o.y = pk2(h[2], h[3]); o.z = pk2(h[4], h[5]); o.w = pk2(h[6], h[7]); *(v4u*)pp[q] = o;
                h[0] = d[q] * h[0] + bflo(sv[q].x); h[1] = d[q] * h[1] + bfhi(sv[q].x); h[2] = d[q] * h[2] + bflo(sv[q].y); h[3] = d[q] * h[3] + bfhi(sv[q].y);
                h[4] = d[q] * h[4] + bflo(sv[q].z); h[5] = d[q] * h[5] + bfhi(sv[q].z); h[6] = d[q] * h[6] + bflo(sv[q].w); h[7] = d[q] * h[7] + bfhi(sv[q].w); }
        }
    }
}

__device__ __forceinline__ void ssd_out(LAS unsigned char* lds, const bf16* XBC, const float* DT, const float* CS, const bf16* ST, bf16* PROJ, const float* dskip, float* SSQS, int vcu, int G, int tid0) {
    const int wave = __builtin_amdgcn_readfirstlane(tid0 >> 6);
    LAS unsigned char* Cm = lds; LAS unsigned char* CBm = lds + 34816; LAS unsigned char* XT = lds + 69632; LAS float* Vv = (LAS float*)(lds + 69632 + 69632);
    for (int u = vcu; u < 4 * NCHUNK; u += G) {
        int tid = tid0; asm volatile("" : "+v"(tid));
        const int c = u >> 2, g = (u >> 1) & 1, hh = u & 1, h0 = 8 * g + 4 * hh; const size_t tok0 = (size_t)c * 128;
        v4u pc[4], pbn[4]; float pv[4];
#pragma unroll
        for (int rep = 0; rep < 4; ++rep) { const int it = tid + 512 * rep, r = it >> 4, ch = it & 15; const bf16* p = XBC + (tok0 + r) * 1536 + 1024 + g * 128 + ch * 8; pbn[rep] = *(const v4u*)p; pc[rep] = *(const v4u*)(p + 256); }
#pragma unroll
        for (int rep = 0; rep < 4; ++rep) { const int idx = tid + 512 * rep, hd = idx >> 9, kind = (idx >> 7) & 3, s = idx & 127, j = (kind & 1) * 16 + h0 + hd; pv[rep] = (kind < 2 ? CS : DT)[(tok0 + s) * 32 + j]; }
#pragma unroll
        for (int rep = 0; rep < 4; ++rep) { const int it = tid + 512 * rep, r = it >> 4, ch = it & 15; *(LAS v4u*)(Cm + r * 272 + ch * 16) = pc[rep]; *(LAS v4u*)(XT + r * 272 + ch * 16) = pbn[rep]; Vv[it] = pv[rep]; }
        LBAR();
        asm volatile("" : "+v"(tid));
        int lane = tid & 63, fr = lane & 15, fq = lane >> 4;
        {
            f32x4 cb[8];
#pragma unroll
            for (int st = 0; st < 8; ++st) cb[st] = (f32x4){0.f, 0.f, 0.f, 0.f};
#pragma unroll
            for (int ks = 0; ks < 4; ++ks) { const bf16x8 cf = *(const LAS bf16x8*)(Cm + (wave * 16 + fr) * 272 + (ks * 32 + fq * 8) * 2);
#pragma unroll
                for (int st = 0; st < 8; ++st) { const bf16x8 bfg = *(const LAS bf16x8*)(XT + (st * 16 + fr) * 272 + (ks * 32 + fq * 8) * 2); cb[st] = mfma16(bfg, cf, cb[st]); } }
#pragma unroll
            for (int st = 0; st < 8; ++st) { v2u w; w.x = pk2(cb[st][0], cb[st][1]); w.y = pk2(cb[st][2], cb[st][3]); *(LAS v2u*)(CBm + (wave * 16 + fr) * 272 + (st * 16 + fq * 4) * 2) = w; }
        }
        LBAR();
        asm volatile("" : "+v"(tid));
#pragma unroll
        for (int rep = 0; rep < 4; ++rep) { const int it = tid + 512 * rep, i = it & 63, ch = it >> 6; const bf16* p = XBC + (tok0 + 2 * i) * 1536 + h0 * 64 + ch * 8; tr_write(XT, ch, i, *(const v4u*)p, *(const v4u*)(p + 1536)); }
        LBAR();
        asm volatile("" : "+v"(tid)); lane = tid & 63; fr = lane & 15; fq = lane >> 4;
        const int hd = wave >> 1, lh = wave & 1, h = h0 + hd;
        const LAS float* csf = Vv + hd * 512, *csb = csf + 128, *dtf = csf + 256, *dtb = csf + 384;
        bf16x8 hf[4][4], hbk[4][4];
        f32x4 acc[4][4];
#pragma unroll
        for (int a = 0; a < 4; ++a)
#pragma unroll
            for (int b = 0; b < 4; ++b) acc[a][b] = (f32x4){0.f, 0.f, 0.f, 0.f};
        float csf_l[4], csb_l[4];
#pragma unroll
        for (int lt = 0; lt < 4; ++lt) { const int l = 16 * (4 * lh + lt) + fr; csf_l[lt] = csf[l]; csb_l[lt] = csb[l]; }
#pragma unroll 1
        for (int ks = 0; ks < 4; ++ks) {
            bf16x8 xb[4];
#pragma unroll
            for (int pt = 0; pt < 4; ++pt) xb[pt] = *(const LAS bf16x8*)(XT + (hd * 64 + pt * 16 + fr) * 272 + (ks * 32 + fq * 8) * 2);
            const int s0 = ks * 32 + fq * 8;
            const f32x4 sf0 = *(const LAS f32x4*)(csf + s0), sf1 = *(const LAS f32x4*)(csf + s0 + 4), sb0 = *(const LAS f32x4*)(csb + s0), sb1 = *(const LAS f32x4*)(csb + s0 + 4);
            const f32x4 df0 = *(const LAS f32x4*)(dtf + s0), df1 = *(const LAS f32x4*)(dtf + s0 + 4), db0 = *(const LAS f32x4*)(dtb + s0), db1 = *(const LAS f32x4*)(dtb + s0 + 4);
#pragma unroll
            for (int lt = 0; lt < 4; ++lt) { const int l = 16 * (4 * lh + lt) + fr;
                const v4u cbw = *(const LAS v4u*)(CBm + l * 272 + s0 * 2); float m[8];
                const int Lt = 4 * lh + lt; const bool allf = (32 * ks + 31 < 16 * Lt), allb = (32 * ks > 16 * Lt + 15);
                if (allf) {
#pragma unroll
                    for (int j = 0; j < 8; ++j) { const float sfj = j < 4 ? sf0[j & 3] : sf1[j & 3], dfj = j < 4 ? df0[j & 3] : df1[j & 3]; const unsigned cw = cbw[j >> 1]; m[j] = ((j & 1) ? bfhi(cw) : bflo(cw)) * (ex2(csf_l[lt] - sfj) * dfj); }
                } else if (allb) {
#pragma unroll
                    for (int j = 0; j < 8; ++j) { const float sbj = j < 4 ? sb0[j & 3] : sb1[j & 3], dbj = j < 4 ? db0[j & 3] : db1[j & 3]; const unsigned cw = cbw[j >> 1]; m[j] = ((j & 1) ? bfhi(cw) : bflo(cw)) * (ex2(csb_l[lt] - sbj) * dbj); }
                } else {
#pragma unroll
                    for (int j = 0; j < 8; ++j) { const int s = s0 + j; const float sfj = j < 4 ? sf0[j & 3] : sf1[j & 3], sbj = j < 4 ? sb0[j & 3] : sb1[j & 3], dfj = j < 4 ? df0[j & 3] : df1[j & 3], dbj = j < 4 ? db0[j & 3] : db1[j & 3];
                        const float mf = (s <= l) ? ex2(csf_l[lt] - sfj) * dfj : 0.f, mb = (s >= l) ? ex2(csb_l[lt] - sbj) * dbj : 0.f;
                        const unsigned cw = cbw[j >> 1]; m[j] = ((j & 1) ? bfhi(cw) : bflo(cw)) * (mf + mb); }
                }
                v4u mw; mw.x = pk2(m[0], m[1]); mw.y = pk2(m[2], m[3]); mw.z = pk2(m[4], m[5]); mw.w = pk2(m[6], m[7]); const bf16x8 a = __builtin_bit_cast(bf16x8, mw);
#pragma unroll
                for (int pt = 0; pt < 4; ++pt) acc[lt][pt] = mfma16(a, xb[pt], acc[lt][pt]); }
        }
        { const bf16* Hp = ST + ((size_t)(c * 2 + 0) * 16 + h) * 8192 + fr * 128 + fq * 8;
#pragma unroll
          for (int ks = 0; ks < 4; ++ks)
#pragma unroll
            for (int pt = 0; pt < 4; ++pt) hf[ks][pt] = *(const bf16x8*)(Hp + pt * 2048 + ks * 32); }
        { float e_l[4];
#pragma unroll
          for (int lt = 0; lt < 4; ++lt) e_l[lt] = ex2(csf_l[lt]);
#pragma unroll
          for (int ks = 0; ks < 4; ++ks) {
#pragma unroll
            for (int lt = 0; lt < 4; ++lt) { const int l = 16 * (4 * lh + lt) + fr; const bf16x8 a = scale8s(*(const LAS v4u*)(Cm + l * 272 + (ks * 32 + fq * 8) * 2), e_l[lt]);
#pragma unroll
                for (int pt = 0; pt < 4; ++pt) acc[lt][pt] = mfma16(a, hf[ks][pt], acc[lt][pt]); }
            __builtin_amdgcn_sched_barrier(0);
            if (ks >= 1 && ks <= 2) {
                const bf16* Hp = ST + ((size_t)(c * 2 + 1) * 16 + h) * 8192 + fr * 128 + fq * 8;
#pragma unroll
                for (int k2 = 2 * (ks - 1); k2 < 2 * (ks - 1) + 2; ++k2)
#pragma unroll
                    for (int pt = 0; pt < 4; ++pt) hbk[k2][pt] = *(const bf16x8*)(Hp + pt * 2048 + k2 * 32);
                __builtin_amdgcn_sched_barrier(0); } } }
        { float e_l[4];
#pragma unroll
          for (int lt = 0; lt < 4; ++lt) e_l[lt] = ex2(csb_l[lt]);
#pragma unroll
          for (int ks = 0; ks < 4; ++ks) {
#pragma unroll
            for (int lt = 0; lt < 4; ++lt) { const int l = 16 * (4 * lh + lt) + fr; const bf16x8 a = scale8s(*(const LAS v4u*)(Cm + l * 272 + (ks * 32 + fq * 8) * 2), e_l[lt]);
#pragma unroll
                for (int pt = 0; pt < 4; ++pt) acc[lt][pt] = mfma16(a, hbk[ks][pt], acc[lt][pt]); }
            __builtin_amdgcn_sched_barrier(0);
 } }
        LBAR();
        LAS unsigned char* ZT = lds;
#pragma unroll
        for (int rep = 0; rep < 8; ++rep) { const int it = tid + 512 * rep, r = it >> 5, ch = it & 31; *(LAS v4u*)(ZT + r * 528 + ch * 16) = *(const v4u*)(PROJ + (tok0 + r) * PP + h0 * 64 + ch * 8); }
        LBAR();
        asm volatile("" : "+v"(tid)); lane = tid & 63; fr = lane & 15; fq = lane >> 4;
        const float dsk = dskip[h];
#pragma unroll
        for (int lt = 0; lt < 4; ++lt) {
#pragma unroll
            for (int pt = 0; pt < 4; ++pt) { const int lb = 16 * (4 * lh + lt) + 4 * fq, p = pt * 16 + fr;
                const v2u xw = *(const LAS v2u*)(XT + (hd * 64 + p) * 272 + lb * 2); const float xv[4] = {bflo(xw.x), bfhi(xw.x), bflo(xw.y), bfhi(xw.y)};
#pragma unroll
                for (int r = 0; r < 4; ++r) { LAS bf16* zp = (LAS bf16*)(ZT + (lb + r) * 528 + (hd * 64 + p) * 2); const float z = bf1(*zp); const float y = (acc[lt][pt][r] + xv[r] * dsk) * z * __builtin_amdgcn_rcpf(1.f + ex2(-z * LOG2E)); *zp = (bf16)f2bf(y); } }
            __builtin_amdgcn_sched_barrier(0); }
        LBAR();
#pragma unroll
        for (int rep = 0; rep < 8; ++rep) { const int it = tid + 512 * rep, r = it >> 5, ch = it & 31; const v4u yv = *(const LAS v4u*)(ZT + r * 528 + ch * 16); *(v4u*)(PROJ + (tok0 + r) * PP + h0 * 64 + ch * 8) = yv;
            float q = (bflo(yv.x) * bflo(yv.x) + bfhi(yv.x) * bfhi(yv.x)) + (bflo(yv.y) * bflo(yv.y) + bfhi(yv.y) * bfhi(yv.y)) + (bflo(yv.z) * bflo(yv.z) + bfhi(yv.z) * bfhi(yv.z)) + (bflo(yv.w) * bflo(yv.w) + bfhi(yv.w) * bfhi(yv.w));
            q += __shfl_xor(q, 1); q += __shfl_xor(q, 2); q += __shfl_xor(q, 4); q += __shfl_xor(q, 8); q += __shfl_xor(q, 16);
            if (ch == 0) SSQS[(tok0 + r) * 4 + g * 2 + hh] = q; }
        LBAR();
    }
}

__device__ __forceinline__ void xa_scores(const LAS unsigned char* Kl, const bf16* qrow, int fr, int fq, v4u (&pa)[8], float& sum) {
    bf16x8 qf[4];
#pragma unroll
    for (int ks = 0; ks < 4; ++ks) qf[ks] = *(const bf16x8*)(qrow + 32 * ks);
    f32x4 s[16];
#pragma unroll
    for (int mt = 0; mt < 16; ++mt) { s[mt] = (f32x4){0.f, 0.f, 0.f, 0.f};
#pragma unroll
        for (int ks = 0; ks < 4; ++ks) s[mt] = mfma16(*(const LAS bf16x8*)(Kl + (mt * 16 + fr) * 272 + (ks * 32 + fq * 8) * 2), qf[ks], s[mt]);
        if (mt & 1) __builtin_amdgcn_sched_barrier(0); }
    float mx = -3.0e38f;
#pragma unroll
    for (int mt = 0; mt < 16; ++mt) mx = fmaxf(fmaxf(mx, fmaxf(s[mt][0], s[mt][1])), fmaxf(s[mt][2], s[mt][3]));
    mx = fmaxf(mx, __shfl_xor(mx, 16)); mx = fmaxf(mx, __shfl_xor(mx, 32));
    float sm = 0.f;
#pragma unroll
    for (int mt = 0; mt < 16; ++mt)
#pragma unroll
        for (int r = 0; r < 4; ++r) { const float e = ex2(s[mt][r] - mx); s[mt][r] = e; sm += e; }
    sm += __shfl_xor(sm, 16); sm += __shfl_xor(sm, 32); sum = sm;
#pragma unroll
    for (int kk = 0; kk < 8; ++kk) { v4u pw; pw.x = pk2(s[2 * kk][0], s[2 * kk][1]); pw.y = pk2(s[2 * kk][2], s[2 * kk][3]); pw.z = pk2(s[2 * kk + 1][0], s[2 * kk + 1][1]); pw.w = pk2(s[2 * kk + 1][2], s[2 * kk + 1][3]); pa[kk] = pw; }
    __builtin_amdgcn_sched_barrier(0);
}
__device__ __forceinline__ void xattn(LAS unsigned char* lds, const bf16* Q2, const bf16* MKV, bf16* CA, int vcu, int G, int tid0) {
    const int wave = __builtin_amdgcn_readfirstlane(tid0 >> 6);
    LAS unsigned char* Kl = lds; LAS unsigned char* VT = lds + 69632;
    const int per = (1280 + G - 1) / G; int loaded = -1;
    const int u1 = (vcu + 1) * per < 1280 ? (vcu + 1) * per : 1280;
    for (int u = vcu * per; u < u1; ++u) {
        int tid = tid0; asm volatile("" : "+v"(tid));
        const int lane = tid & 63, fr = lane & 15, fq = lane >> 4;
        int seq, head, tile;
        if (u < 256) { seq = 0; head = u >> 6; tile = u & 63; } else { const int u2 = u - 256, pr = u2 >> 5; seq = 1 + (pr >> 2); head = pr & 3; tile = u2 & 31; }
        const int key = seq * 4 + head;
        if (key != loaded) {
            __syncthreads();
            const bf16* Kg = MKV + (size_t)(seq * 256) * 1024 + head * 128; const bf16* Vg = Kg + 512;
#pragma unroll
            for (int rep = 0; rep < 8; ++rep) { const int it = tid + 512 * rep, m = it >> 4, ch = it & 15; *(LAS v4u*)(Kl + m * 272 + ch * 16) = *(const v4u*)(Kg + (size_t)m * 1024 + ch * 8); }
#pragma unroll
            for (int rep = 0; rep < 4; ++rep) { const int it = tid + 512 * rep, i = it & 127, ch = it >> 7;
                const bf16* p = Vg + (size_t)(2 * i) * 1024 + ch * 8; const v4u r0 = *(const v4u*)p, r1 = *(const v4u*)(p + 1024);
#pragma unroll
                for (int j = 0; j < 8; ++j) { const unsigned a = r0[j >> 1], b = r1[j >> 1]; const unsigned lo = (j & 1) ? (a >> 16) : (a & 0xffffu), hi = (j & 1) ? (b & 0xffff0000u) : (b << 16);
                    *(LAS unsigned*)(VT + (ch * 8 + j) * 528 + 4 * i) = lo | hi; } }
            __syncthreads(); loaded = key;
        }
        const int tokb = (seq == 0 ? 0 : 16384 + (seq - 1) * 8192) + tile * 256 + wave * 32;
        v4u pa[2][8]; float sum[2];
#pragma unroll
        for (int itr = 0; itr < 2; ++itr) xa_scores(Kl, Q2 + (size_t)(tokb + 16 * itr + fr) * 512 + head * 128 + fq * 8, fr, fq, pa[itr], sum[itr]);
        f32x4 o[2][8];
#pragma unroll
        for (int itr = 0; itr < 2; ++itr)
#pragma unroll
            for (int dt = 0; dt < 8; ++dt) o[itr][dt] = (f32x4){0.f, 0.f, 0.f, 0.f};
#pragma unroll
        for (int kk = 0; kk < 8; ++kk) {
#pragma unroll
            for (int dt = 0; dt < 8; ++dt) { const LAS unsigned char* vp = VT + (dt * 16 + fr) * 528 + (kk * 32 + fq * 4) * 2; const v2u lo = *(const LAS v2u*)vp, hi = *(const LAS v2u*)(vp + 32);
                v4u vw; vw.x = lo.x; vw.y = lo.y; vw.z = hi.x; vw.w = hi.y; const bf16x8 vb = __builtin_bit_cast(bf16x8, vw);
                o[0][dt] = mfma16(vb, __builtin_bit_cast(bf16x8, pa[0][kk]), o[0][dt]); o[1][dt] = mfma16(vb, __builtin_bit_cast(bf16x8, pa[1][kk]), o[1][dt]); }
            __builtin_amdgcn_sched_barrier(0);
        }
#pragma unroll
        for (int itr = 0; itr < 2; ++itr) { const int l0 = tokb + 16 * itr; const float inv = 1.0f / sum[itr]; bf16* cp = CA + (size_t)(l0 + fr) * 512 + head * 128 + fq * 4;
#pragma unroll
            for (int dt = 0; dt < 8; ++dt) { v2u w; w.x = pk2(o[itr][dt][0] * inv, o[itr][dt][1] * inv); w.y = pk2(o[itr][dt][2] * inv, o[itr][dt][3] * inv); *(v2u*)(cp + dt * 16) = w; } }
    }
}

typedef __attribute__((address_space(1))) unsigned gu32;
#define RLX_AGENT __ATOMIC_RELAXED, __HIP_MEMORY_SCOPE_AGENT
#define XB_TMO      128
#define XB_XCNT(j)  (256  + 64 * (j))
#define XB_XSUB(j)  (1280 + 64 * (j))
#define XB_XGEN(j)  (2304 + 64 * (j))
#define XB_TOP      3328
#define XB_TOPGEN   3392
#define XCD_BAR_WORDS 3456
#define XB_SPIN_CAP (1u << 18)

__device__ __forceinline__ unsigned xb_ld(unsigned* p)              { return __hip_atomic_load(p, __ATOMIC_RELAXED, __HIP_MEMORY_SCOPE_AGENT); }
__device__ __forceinline__ unsigned xb_add(unsigned* p, unsigned v) { return __hip_atomic_fetch_add(p, v, __ATOMIC_RELAXED, __HIP_MEMORY_SCOPE_AGENT); }
__device__ __forceinline__ unsigned xb_xcc_id() { return (unsigned)__builtin_amdgcn_s_getreg((3 << 11) | 20) & 0xFu; }
#define XB_SPIN(cond, bar) do { unsigned _sp = 0; while (cond) { __builtin_amdgcn_s_sleep(1); \
    if ((++_sp & 255u) == 0u) { if (xb_ld(&(bar)[XB_TMO])) break; if (_sp > XB_SPIN_CAP) { atomicAdd(&(bar)[XB_TMO], 1u); break; } } } } while (0)

struct XcdBarrier {
    unsigned* bar; unsigned x;
    volatile LAS unsigned* st;
};

__device__ __forceinline__ XcdBarrier xcd_barrier_post(unsigned* bar, volatile LAS unsigned* st) {
    XcdBarrier b; b.bar = bar; b.x = xb_xcc_id(); b.st = st;
    if (threadIdx.x == 0) (void)xb_add(&bar[XB_XCNT(b.x)], 1u);
    return b;
}
__device__ __forceinline__ void xcd_barrier_complete(unsigned* bar, unsigned x, unsigned& nloc, unsigned& nx) {
    const unsigned G = gridDim.x * gridDim.y * gridDim.z;
    unsigned sum, cnt, mine, sp = 0u;
    for (;;) {
        sum = 0u; cnt = 0u; mine = 0u;
#pragma unroll
        for (unsigned j = 0; j < 16; ++j) { const unsigned c = xb_ld(&bar[XB_XCNT(j)]); sum += c; cnt += (c > 0u) ? 1u : 0u; mine = (j == x) ? c : mine; }
        if (sum == G) break;
        __builtin_amdgcn_s_sleep(1);
        if ((++sp & 255u) == 0u) { if (xb_ld(&bar[XB_TMO])) break; if (sp > XB_SPIN_CAP) { atomicAdd(&bar[XB_TMO], 1u); break; } }
    }
    nloc = mine > 0u ? mine : 1u; nx = cnt > 0u ? cnt : 1u;
}

__device__ __forceinline__ void xcd_barrier(const XcdBarrier& b) {
    asm volatile("s_waitcnt vmcnt(0)" ::: "memory");
    __syncthreads();
    if (threadIdx.x == 0) {
        unsigned* bar = b.bar;
        __builtin_amdgcn_s_waitcnt(0);
        unsigned nloc = b.st[0], nx = b.st[1];
        if (nloc == 0u) { xcd_barrier_complete(bar, b.x, nloc, nx); b.st[0] = nloc; b.st[1] = nx; }
        const unsigned old = xb_add(&bar[XB_XSUB(b.x)], 1u);
        const unsigned gen = old / nloc;
        if (old + 1u == (gen + 1u) * nloc) {
            __builtin_amdgcn_fence(__ATOMIC_RELEASE, "agent");
            asm volatile("s_waitcnt vmcnt(0)" ::: "memory");
            const unsigned og = xb_add(&bar[XB_TOP], 1u);
            const unsigned tg = og / nx;
            if (og + 1u == (tg + 1u) * nx) xb_add(&bar[XB_TOPGEN], 1u);
            else XB_SPIN(xb_ld(&bar[XB_TOPGEN]) == tg, bar);
            __builtin_amdgcn_fence(__ATOMIC_ACQUIRE, "agent");
            xb_add(&bar[XB_XGEN(b.x)], 1u);
            asm volatile("s_waitcnt vmcnt(0)" ::: "memory");
        } else {
            XB_SPIN(xb_ld(&bar[XB_XGEN(b.x)]) == gen, bar);
            __builtin_amdgcn_fence(__ATOMIC_ACQUIRE, "agent");
            asm volatile("s_waitcnt vmcnt(0)" ::: "memory");
        }
    }
    __syncthreads();
}


struct Args { const float* in[29]; float* out; unsigned char* ws; };
__global__ void __launch_bounds__(512, 2) hymba_fwd(Args args) {
    extern __shared__ __attribute__((aligned(16))) unsigned char lds_raw[];
    cg::grid_group grid = cg::this_grid();
    LAS unsigned char* lds = (LAS unsigned char*)lds_raw;
    const int wave = __builtin_amdgcn_readfirstlane((int)threadIdx.x >> 6);
    const int G = gridDim.x; const int bx = blockIdx.x; const int vcu = (G % 8 == 0) ? (bx % 8) * (G / 8) + bx / 8 : bx;
    const int gw = vcu * 8 + wave, NGW = G * 8, NTH = G * 512;
#define PH_VARS int tid = threadIdx.x; asm volatile("" : "+v"(tid)); const int lane = tid & 63; const int gtid = vcu * 512 + tid; (void)lane; (void)gtid;
    unsigned char* ws = args.ws;
    const float* xp = args.in[0]; const float* xs = args.in[1];
    bf16* WIN = (bf16*)(ws + WS_WIN); bf16* WOUT = (bf16*)(ws + WS_WOUT); bf16* WXQ = (bf16*)(ws + WS_WXQ); bf16* WXKV = (bf16*)(ws + WS_WXKV); bf16* WXO = (bf16*)(ws + WS_WXO);
    bf16* WGU = (bf16*)(ws + WS_WGU); bf16* WD = (bf16*)(ws + WS_WD); bf16* MEMN = (bf16*)(ws + WS_MEMN); bf16* MKV = (bf16*)(ws + WS_MKV); bf16* XN = (bf16*)(ws + WS_XN);
    float* DT = (float*)(ws + WS_DT); float* CS = (float*)(ws + WS_CS); float* DEC = (float*)(ws + WS_DEC); float* TAB = (float*)(ws + WS_TAB); bf16* KC_ = (bf16*)(ws + WS_KC); bf16* VC_ = (bf16*)(ws + WS_VC); float* SSQS = (float*)(ws + WS_SSQS); float* RS1 = (float*)(ws + 64 * 1024); float* RS2 = (float*)(ws + 528 * 1024);   float* SSQA = (float*)(ws + WS_SSQA);
    bf16* PROJ = (bf16*)(ws + WS_PROJ); bf16* Q2 = (bf16*)(ws + WS_Q2); bf16* CA = (bf16*)(ws + WS_CA); bf16* HID = (bf16*)(ws + WS_HID); bf16* XBC = (bf16*)(ws + WS_XBC); bf16* RAW = (bf16*)(ws + WS_RAW);
    bf16* X1B = (bf16*)args.out; bf16* X2B0 = (bf16*)(ws + WS_X2B0); bf16* X2B1 = (bf16*)(ws + WS_X2B1);
    bf16* ST = (bf16*)args.out;
    volatile LAS unsigned* bst = (volatile LAS unsigned*)(lds + LDS_BYTES - 16);
    if (threadIdx.x < 4) bst[threadIdx.x] = 0u;
    __syncthreads();
    if (blockIdx.x == 0) for (int i = threadIdx.x; i < XCD_BAR_WORDS; i += 512) ((unsigned*)(ws + WS_BAR))[i] = 0u;
    XcdBarrier xbar; xbar.bar = (unsigned*)(ws + WS_BAR); xbar.x = 0; xbar.st = bst;
#define GRID_BAR() xcd_barrier(xbar)

#if (PHMASK >> 0) & 1
    { PH_VARS
    {
        LAS float* scr = (LAS float*)(lds + wave * 16384);
        for (int it = gw; it < 7696; it += NGW) {
            int r = it;
#define TRY(W_, pitch_, Krows_, col0_, ncols_, WT_, drow0_, mode_) { const int nb_ = (ncols_) / 32, cnt_ = ((Krows_) / 64) * nb_; if (r < cnt_) { const int kb = r / nb_, n0 = (r % nb_) * 32; \
                const int dr = (mode_) ? (drow0_) + 256 * (n0 / 128) + (n0 % 128) : (drow0_) + n0; tr_item(W_, pitch_, kb * 64, (col0_) + n0, WT_, Krows_, dr, scr, lane); continue; } r -= cnt_; }
            TRY(args.in[5], 3360, 1024, 0, 1024, WIN, 0, 0)
            TRY(args.in[5], 3360, 1024, 1024, 1536, WIN, XC, 0)
            TRY(args.in[5], 3360, 1024, 2560, 32, WIN, DTC, 0)
            TRY(args.in[5], 3360, 1024, 2592, 512, WIN, QC, 0)
            TRY(args.in[5], 3360, 1024, 3104, 128, WIN, KC, 0)
            TRY(args.in[5], 3360, 1024, 3232, 128, WIN, VC, 0)
            { const int nb_ = 32, cnt_ = 24 * nb_; if (r < cnt_) { const int kb = r / nb_, n0 = (r % nb_) * 32; const float* gk = kb < 16 ? args.in[11] + kb * 64 : args.in[14] + (kb - 16) * 64;
                tr_item(args.in[15], 1024, kb * 64, n0, WOUT, 1536, n0, scr, lane, gk); continue; } r -= cnt_; }
            { const int nb_ = 16, cnt_ = 16 * nb_; if (r < cnt_) { const int kb = r / nb_, n0 = (r % nb_) * 32; tr_item(args.in[19], 512, kb * 64, n0, WXQ, 1024, n0, scr, lane, args.in[17] + kb * 64); continue; } r -= cnt_; }
            TRY(args.in[20], 512, 1024, 0, 512, WXKV, 0, 0)
            TRY(args.in[21], 512, 1024, 0, 512, WXKV, 512, 0)
            TRY(args.in[22], 1024, 512, 0, 1024, WXO, 0, 0)
            { const int nb_ = 88, cnt_ = 16 * nb_; if (r < cnt_) { const int kb = r / nb_, n0 = (r % nb_) * 32; tr_item(args.in[25], 2816, kb * 64, n0, WGU, 1024, 256 * (n0 / 128) + (n0 % 128), scr, lane, args.in[24] + kb * 64); continue; } r -= cnt_; }
            { const int nb_ = 88, cnt_ = 16 * nb_; if (r < cnt_) { const int kb = r / nb_, n0 = (r % nb_) * 32; tr_item(args.in[26], 2816, kb * 64, n0, WGU, 1024, 128 + 256 * (n0 / 128) + (n0 % 128), scr, lane, args.in[24] + kb * 64); continue; } r -= cnt_; }
            TRY(args.in[27], 1024, 2816, 0, 1024, WD, 0, 0)
#undef TRY
        }
        for (int i = gtid; i < 224 * 1024 / 8; i += NTH) ((v4u*)(WIN + (size_t)3360 * 1024))[i] = (v4u){0u, 0u, 0u, 0u};
        for (int i = gtid; i < 320 * 16; i += NTH) { const int pos = i >> 4, f = i & 15; const double m4 = (f & 3) == 0 ? 1.0 : (f & 3) == 1 ? 0.56234132519034908 : (f & 3) == 2 ? 0.31622776601683794 : 0.17782794100389228;
            const double e4 = (f >> 2) == 0 ? 1.0 : (f >> 2) == 1 ? 0.1 : (f >> 2) == 2 ? 0.01 : 0.001; const double pv = (double)(pos < 256 ? pos : pos - 256);
            double rev = pv * (m4 * e4) * 0.15915494309189535; rev -= floor(rev); const float rf = (float)rev;
            TAB[2 * i] = __builtin_amdgcn_cosf(rf); TAB[2 * i + 1] = __builtin_amdgcn_sinf(rf); }
        norm_rows<4>(xp, xs, nullptr, nullptr, nullptr, nullptr, nullptr, nullptr, nullptr, args.in[4], XN, nullptr, gw, NGW, lane);
        for (int t = gw; t < 2304; t += NGW) {
            const float* base = t < 256 ? args.in[2] + (size_t)t * 1024 : args.in[3] + (size_t)(t - 256) * 1024; f32x4 v[4]; float s2 = 0.f;
#pragma unroll
            for (int j = 0; j < 4; ++j) { v[j] = ((const f32x4*)base)[lane + 64 * j]; s2 += (v[j].x * v[j].x + v[j].y * v[j].y) + (v[j].z * v[j].z + v[j].w * v[j].w); }
            const float rstd = 1.0f / sqrtf(wave_sum(s2) * (1.f / 1024.f) + EPSN);
#pragma unroll
            for (int j = 0; j < 4; ++j) { const f32x4 g = ((const f32x4*)args.in[18])[lane + 64 * j]; const f32x4 o = v[j] * rstd * g; v2u w; w.x = pk2(o.x, o.y); w.y = pk2(o.z, o.w); *(v2u*)(MEMN + (size_t)t * 1024 + 4 * (lane + 64 * j)) = w; }
        }
    }
    }
#endif
    grid.sync();
    xbar = xcd_barrier_post((unsigned*)(ws + WS_BAR), bst);
#if (PHMASK >> 1) & 1
    { PH_VARS
    {
        pg8::Gemm g{XN, WIN, NTOK, PP, 1024, 1024, 0, 1 << 30}; pg8::StaticOrder S; S.init(NTOK, PP, G, bx); EpiProj E{PROJ, VC_};
        pg8::gemm_phase<EpiProj, pg8::StaticOrder, true, true>(lds, g, S, E);
        pg8::Gemm g2{MEMN, WXKV, 2304, 1024, 1024, 1024, 0, 1 << 30}; pg8::StaticOrder S2; S2.init(2304, 1024, G, (bx + 128) % G); EpiStore E2{MKV, 1024, 1.0f, nullptr};
        pg8::gemm_phase<EpiStore, pg8::StaticOrder, true, true>(lds, g2, S2, E2);
    }
    }
#endif
    GRID_BAR();
#if (PHMASK >> 2) & 1
    { PH_VARS
    {
        const float* conv_w = args.in[6]; const float* conv_b = args.in[7];
        for (int item = gw; item < 30720; item += NGW) {
            const int run = item / 3, j = item - run * 3, t0 = run * 8, c0 = (lane + 64 * j) * 8;
            const int s0 = t0 < 16384 ? 0 : 16384 + ((t0 - 16384) >> 13) * 8192, len = t0 < 16384 ? 16384 : 8192, pos0 = t0 - s0;
            v4u rows[12];
#pragma unroll
            for (int i = 0; i < 12; ++i) { const int tt = pos0 + i - 2; rows[i] = (v4u){0u, 0u, 0u, 0u}; if (tt >= 0 && tt < len) rows[i] = *(const v4u*)(PROJ + (size_t)(t0 + i - 2) * PP + XC + c0); }
            f32x4 w[5][2];
#pragma unroll
            for (int dk = 0; dk < 5; ++dk) { w[dk][0] = *(const f32x4*)(conv_w + dk * 1536 + c0); w[dk][1] = *(const f32x4*)(conv_w + dk * 1536 + c0 + 4); }
            const f32x4 b0 = *(const f32x4*)(conv_b + c0), b1 = *(const f32x4*)(conv_b + c0 + 4);
#pragma unroll
            for (int o_ = 0; o_ < 8; ++o_) { float a[8] = {b0.x, b0.y, b0.z, b0.w, b1.x, b1.y, b1.z, b1.w};
#pragma unroll
                for (int dk = 0; dk < 5; ++dk) { const v4u r = rows[o_ + dk]; const f32x4 w0 = w[dk][0], w1 = w[dk][1];
                    a[0] += w0.x * bflo(r.x); a[1] += w0.y * bfhi(r.x); a[2] += w0.z * bflo(r.y); a[3] += w0.w * bfhi(r.y); a[4] += w1.x * bflo(r.z); a[5] += w1.y * bfhi(r.z); a[6] += w1.z * bflo(r.w); a[7] += w1.w * bfhi(r.w); }
#pragma unroll
                for (int k = 0; k < 8; ++k) a[k] = a[k] * __builtin_amdgcn_rcpf(1.f + ex2(-a[k] * LOG2E));
                v4u o; o.x = pk2(a[0], a[1]); o.y = pk2(a[2], a[3]); o.z = pk2(a[4], a[5]); o.w = pk2(a[6], a[7]); *(v4u*)(XBC + (size_t)(t0 + o_) * 1536 + c0) = o; }
        }
        for (int tb = gw * 4; tb < NTOK; tb += NGW * 4) {
            const int s0 = tb < 16384 ? 0 : 16384 + ((tb - 16384) >> 13) * 8192;
            v4u rin[5]; bf16* ptrs[5];
#pragma unroll
            for (int part = 0; part < 5; ++part) { const int t = part < 4 ? tb + part : tb + (lane >> 4); ptrs[part] = PROJ + (size_t)t * PP + (part < 4 ? QC + lane * 8 : KC + (lane & 15) * 8); rin[part] = *(const v4u*)ptrs[part]; }
#pragma unroll
            for (int part = 0; part < 5; ++part) {
                const int t = part < 4 ? tb + part : tb + (lane >> 4), pos = t - s0, prow = pos >> 6, pcol = pos & 63, i = lane & 7;
                const v4u r = rin[part]; float x[8] = {bflo(r.x), bfhi(r.x), bflo(r.y), bfhi(r.y), bflo(r.z), bfhi(r.z), bflo(r.w), bfhi(r.w)};
                float ss = 0.f;
#pragma unroll
                for (int k = 0; k < 8; ++k) ss += x[k] * x[k];
                ss += __shfl_xor(ss, 1); ss += __shfl_xor(ss, 2); ss += __shfl_xor(ss, 4);
                const float rstd = 1.0f / sqrtf(ss * (1.f / 64.f) + EPSN); const float* gn = args.in[part < 4 ? 12 : 13] + i * 8;
                const f32x4 g0 = *(const f32x4*)gn, g1 = *(const f32x4*)(gn + 4); const float gg[8] = {g0.x, g0.y, g0.z, g0.w, g1.x, g1.y, g1.z, g1.w};
                const float* tbp = TAB + ((size_t)((i < 4) ? prow : 256 + pcol) * 16 + 8 * (i & 1)) * 2; const f32x4 t0 = *(const f32x4*)tbp, t1 = *(const f32x4*)(tbp + 4), t2 = *(const f32x4*)(tbp + 8), t3 = *(const f32x4*)(tbp + 12);
                const float cs_[8] = {t0.x, t0.z, t1.x, t1.z, t2.x, t2.z, t3.x, t3.z}, sn_[8] = {t0.y, t0.w, t1.y, t1.w, t2.y, t2.w, t3.y, t3.w};
                const float sc = part < 4 ? 0.125f * LOG2E : 1.0f; float y[8];
#pragma unroll
                for (int k = 0; k < 8; ++k) { const float xv = x[k] * rstd * gg[k]; const float ov = __shfl_xor(xv, 2); y[k] = ((i & 2) ? (xv * cs_[k] + ov * sn_[k]) : (xv * cs_[k] - ov * sn_[k])) * sc; }
                v4u o; o.x = pk2(y[0], y[1]); o.y = pk2(y[2], y[3]); o.z = pk2(y[4], y[5]); o.w = pk2(y[6], y[7]);
                if (part < 4) *(v4u*)ptrs[part] = o;
                else *(v4u*)(KC_ + ((size_t)((lane >> 3) & 1) * NTOK + t) * 64 + i * 8) = o;
            }
        }
        for (int c = gw; c < NCHUNK; c += NGW) {
            const int j = lane & 31, hf = lane >> 5, dir = j >> 4; const float bias = args.in[8][j], al2 = -__expf(args.in[9][j]) * LOG2E; const size_t tok0 = (size_t)c * 128;
            float tot = 0.f;
#pragma unroll 1
            for (int i0 = 0; i0 < 64; i0 += 16) { float dtv[16];
#pragma unroll
                for (int i = 0; i < 16; ++i) { const int o = hf * 64 + i0 + i, tk = dir ? 127 - o : o; dtv[i] = bf1(PROJ[(tok0 + tk) * PP + DTC + j]); }
#pragma unroll
                for (int i = 0; i < 16; ++i) { const float xr = dtv[i] + bias; const float dt = xr > 15.f ? xr : log1pf(__expf(xr)); tot += dt * al2; } }
            const float other = __shfl_xor(tot, 32); float run = hf ? other : 0.f;
#pragma unroll 1
            for (int i0 = 0; i0 < 64; i0 += 16) { float dtv[16];
#pragma unroll
                for (int i = 0; i < 16; ++i) { const int o = hf * 64 + i0 + i, tk = dir ? 127 - o : o; dtv[i] = bf1(PROJ[(tok0 + tk) * PP + DTC + j]); }
#pragma unroll
                for (int i = 0; i < 16; ++i) { const int o = hf * 64 + i0 + i, tk = dir ? 127 - o : o; const float xr = dtv[i] + bias; const float dt = xr > 15.f ? xr : log1pf(__expf(xr)); run += dt * al2;
                    DT[(tok0 + tk) * 32 + j] = dt; CS[(tok0 + tk) * 32 + j] = run; } }
            if (hf == 0) DEC[c * 32 + j] = ex2(tot + other);
        }
    }
    }
#endif
    GRID_BAR();
#if (PHMASK >> 3) & 1
    { PH_VARS
    ssd_states(lds, XBC, DT, CS, ST, vcu, G, tid);
    }
#endif
    GRID_BAR();
#if (PHMASK >> 4) & 1
    { PH_VARS
    ssd_pass(ST, DEC, gtid, NTH);
    {
        const attn_body::AttnTensors AT{(const attn_body::bf16*)(PROJ + QC), (const attn_body::bf16*)KC_, (const attn_body::bf16*)VC_, (attn_body::bf16*)(PROJ + QC), SSQA};
        float mq = fabsf(args.in[12][lane]), mk = fabsf(args.in[13][lane]);
#pragma unroll
        for (int o_ = 1; o_ < 64; o_ <<= 1) { mq = fmaxf(mq, __shfl_xor(mq, o_)); mk = fmaxf(mk, __shfl_xor(mk, o_)); }
        const float bref = 0.125f * LOG2E * 64.f * mq * mk * 1.02f + 0.1f;
        if (bref <= 40.f) attn_body::attn_phase<8, true>(bref, (char*)lds_raw, AT, vcu, G);
        else attn_body::attn_phase<8, false>(0.f, (char*)lds_raw, AT, vcu, G);
    }
    }
#endif
    GRID_BAR();
#if (PHMASK >> 5) & 1
    { PH_VARS
    ssd_out(lds, XBC, DT, CS, ST, PROJ, args.in[10], SSQS, vcu, G, tid);
    }
#endif
    GRID_BAR();
#if (PHMASK >> 7) & 1
    { PH_VARS
    { pg8::Gemm g{PROJ, WOUT, NTOK, 1024, 1536, PP, 0, 1 << 30}; pg8::StaticOrder S; S.init(NTOK, 1024, G, bx);
      LAS float* Rl = (LAS float*)(lds + 131072);
      { pg8::Unit uu; for (int i = 0; i < 5 && S.next(i, uu); ++i) if (tid < 256) { const size_t row = (size_t)uu.pm * 256 + tid;
            const f32x4 sv = *(const f32x4*)(SSQS + row * 4), a0 = *(const f32x4*)(SSQA + row * 8), a1 = *(const f32x4*)(SSQA + row * 8 + 4);
            const float d0 = (sv.x + sv.y) * (1.f / 512.f) + EPSN, d1 = (sv.z + sv.w) * (1.f / 512.f) + EPSN, d2 = (((a0.x + a0.y) + (a0.z + a0.w)) + ((a1.x + a1.y) + (a1.z + a1.w))) * (1.f / 512.f) + EPSN;
            *(LAS f32x4*)(Rl + (size_t)i * 1024 + tid * 4) = (f32x4){sqrtf(d1 / d0), sqrtf(d2 / d1), 1.0f / sqrtf(d2), 0.f}; }
        __syncthreads(); }
      EpiRowScale E{RAW, 1024, Rl}; pg8::gemm_phase<EpiRowScale, pg8::StaticOrder, true, true>(lds, g, S, E); }
    }
#endif
    GRID_BAR();
#if (PHMASK >> 8) & 1
    { PH_VARS
    norm_rows<4>(xp, xs, nullptr, nullptr, RAW, args.in[16], nullptr, X1B, X1B + (size_t)XSPLIT * 1024, nullptr, nullptr, RS1, gw, NGW, lane);
    }
#endif
    GRID_BAR();
#if (PHMASK >> 9) & 1
    { PH_VARS
    { pg8::Gemm g{X1B, WXQ, NTOK, 512, 1024, 1024, 0, 1 << 30}; pg8::StaticOrder S; S.init(NTOK, 512, G, bx); EpiStore E{Q2, 512, 0.08838834764831845f * LOG2E, RS1}; pg8::gemm_phase<EpiStore, pg8::StaticOrder, true, true>(lds, g, S, E); }
    }
#endif
    GRID_BAR();
#if (PHMASK >> 10) & 1
    { PH_VARS
    xattn(lds, Q2, MKV, CA, vcu, G, tid);
    }
#endif
    GRID_BAR();
#if (PHMASK >> 11) & 1
    { PH_VARS
    { pg8::Gemm g{CA, WXO, NTOK, 1024, 512, 512, 0, 1 << 30}; pg8::StaticOrder S; S.init(NTOK, 1024, G, bx); EpiStore E{RAW, 1024, 1.0f, nullptr}; pg8::gemm_phase<EpiStore, pg8::StaticOrder, true, true>(lds, g, S, E); }
    }
#endif
    GRID_BAR();
#if (PHMASK >> 12) & 1
    { PH_VARS
    norm_rows<4>(nullptr, nullptr, X1B, X1B + (size_t)XSPLIT * 1024, RAW, args.in[23], nullptr, X2B0, X2B1, nullptr, nullptr, RS2, gw, NGW, lane);
    }
#endif
    GRID_BAR();
#if (PHMASK >> 13) & 1
    { PH_VARS
    { pg8::Gemm g{X2B0, WGU, NTOK, 5632, 1024, 1024, (long)((const char*)X2B1 - (const char*)X2B0), XSPLIT / 256}; pg8::StaticOrder S; S.init(NTOK, 5632, G, bx); EpiSwiglu E{HID, 2816, RS2}; pg8::gemm_phase<EpiSwiglu, pg8::StaticOrder, true, true>(lds, g, S, E); }
    }
#endif
    GRID_BAR();
#if (PHMASK >> 14) & 1
    { PH_VARS
    { pg8::Gemm g{HID, WD, NTOK, 1024, 2816, 2816, 0, 1 << 30}; pg8::StaticOrder S; S.init(NTOK, 1024, G, bx); EpiStore E{RAW, 1024, 1.0f, nullptr}; pg8::gemm_phase<EpiStore, pg8::StaticOrder, true, true>(lds, g, S, E); }
    }
#endif
    GRID_BAR();
#if (PHMASK >> 15) & 1
    { PH_VARS
    norm_rows<4>(nullptr, nullptr, X2B0, X2B1, RAW, args.in[28], args.out, nullptr, nullptr, nullptr, nullptr, nullptr, gw, NGW, lane);
    }
#endif
}

extern "C" void kernel_launch(void* const* d_in, const int* in_sizes, int n_in, void* d_out, int out_size, void* d_ws, size_t ws_size, hipStream_t stream) {
    static int grid = 0;
    if (grid == 0) {
        if (n_in != 29 || out_size != NTOK * 1024 || ws_size < WS_END) { fprintf(stderr, "kernel_launch: unexpected shapes (n_in %d, out %d, ws %zu)\n", n_in, out_size, ws_size); grid = -1; return; }
        int dev = 0, cus = 0, per_cu = 0;
        if (hipGetDevice(&dev) != hipSuccess || hipDeviceGetAttribute(&cus, hipDeviceAttributeMultiprocessorCount, dev) != hipSuccess) { grid = -1; return; }
        if (hipFuncSetAttribute((const void*)hymba_fwd, hipFuncAttributeMaxDynamicSharedMemorySize, LDS_BYTES) != hipSuccess) { fprintf(stderr, "kernel_launch: hipFuncSetAttribute failed\n"); grid = -1; return; }
        if (hipOccupancyMaxActiveBlocksPerMultiprocessor(&per_cu, (const void*)hymba_fwd, 512, LDS_BYTES) != hipSuccess || per_cu < 1) { fprintf(stderr, "kernel_launch: occupancy query says %d\n", per_cu); per_cu = 1; }
        (void)hipGetLastError();
        grid = cus * (per_cu > 1 ? 1 : per_cu);
    }
    if (grid < 0) return;
    Args a{};
    for (int i = 0; i < 29; ++i) a.in[i] = (const float*)d_in[i];
    a.out = (float*)d_out; a.ws = (unsigned char*)d_ws;
    void* kargs[] = {&a};
    const hipError_t e = hipLaunchCooperativeKernel((const void*)hymba_fwd, dim3(grid), dim3(512), kargs, LDS_BYTES, stream);
    if (e != hipSuccess) fprintf(stderr, "kernel_launch: cooperative launch failed: %s (grid %d)\n", hipGetErrorString(e), grid);
}
```

```cpp
#include <hip/hip_runtime.h>
#include <hip/hip_cooperative_groups.h>
#include <cstdio>
#include <cstdint>
namespace pg8 {
#define PG8_LAS __attribute__((address_space(3)))
typedef unsigned short bf16_t;
typedef short bf16x8 __attribute__((ext_vector_type(8)));
typedef float f32x4 __attribute__((ext_vector_type(4)));
typedef unsigned u32x4 __attribute__((ext_vector_type(4)));
constexpr int BM = 256, BK = 64, HALF = 128, HTB = HALF * BK * 2  , STAGE_BYTES = 8 * HTB, NXCD = 8, WGM = 8;

__host__ __device__ __forceinline__ int lds_byte(int r, int c) { const int st = (r >> 4) * 2 + (c >> 5), rr = r & 15, cc = c & 31, ob = rr * 64 + cc * 2; return st * 1024 + (ob ^ (((ob >> 9) & 1) << 5)); }
__host__ __device__ __forceinline__ void stage_rc(int b, int& R, int& C) { const int st = b / 1024, sb = b % 1024, swz = sb ^ (((sb >> 9) & 1) << 5); R = (st >> 1) * 16 + swz / 64; C = (st & 1) * 32 + (swz % 64) / 2; }
__host__ __device__ __forceinline__ int perm32(int rho) { const int n = rho >> 4, i = rho & 15; return 8 * (i >> 2) + 4 * n + (i & 3); }

struct Unit { int pm, pn; };
struct Gemm { const bf16_t* A; const bf16_t* Bt; int M, N, K, lda; long a2off; int pm2; };

struct StaticOrder {
    int nM, nN, nwg, G, c;
    __host__ __device__ __forceinline__ void init(int M, int N, int G_, int c_) { nM = M / BM; nN = N / BM; nwg = nM * nN; G = G_; c = c_; }
    __host__ __device__ __forceinline__ bool next(int i, Unit& u) const {
        const long L = (long)i * G + c; if (L >= nwg) return false;
        int wgid = (int)L; { const int q = nwg / NXCD, r = nwg % NXCD, xcd = wgid % NXCD, off = wgid / NXCD; wgid = (xcd < r ? xcd * (q + 1) : r * (q + 1) + (xcd - r) * q) + off; }
        const int nig = WGM * nN, gid = wgid / nig, fm = gid * WGM, gsz = (nM - fm) < WGM ? (nM - fm) : WGM;
        u.pm = fm + ((wgid % nig) % gsz); u.pn = (wgid % nig) / gsz; return true;
    }
    __device__ __forceinline__ void a_ready(const Unit&) const {}
    __device__ __forceinline__ void done(const Unit&) const {}
};

template <class Epi, class Sched, bool ALIGN_EPI = false, bool SP2 = false>
__device__ __forceinline__ void gemm_phase(PG8_LAS unsigned char* lds, const Gemm g, const Sched& S, const Epi& E) {
    int tid_l = threadIdx.x; asm volatile("" : "+v"(tid_l));
    const int tid = tid_l, wid = __builtin_amdgcn_readfirstlane(tid >> 6), lane = tid & 63, wr = wid >> 2, wc = wid & 3, fr = lane & 15, fq = lane >> 4;
    const int K = g.K, nt = K / BK, lda = g.lda;
    unsigned voffA[2], voffB[2];
#pragma unroll
    for (int i = 0; i < 2; ++i) { int R, C; stage_rc(tid * 16 + i * 8192, R, C); const int Rb = Epi::PERM ? ((R & ~31) + perm32(R & 31)) : R;
        voffA[i] = (unsigned)(R * lda + C) * 2u; voffB[i] = (unsigned)(Rb * K + C) * 2u; }
    const size_t kstep = (size_t)(BK * 2);
    const size_t hstepB = (size_t)HALF * K * 2, hstepA = (size_t)HALF * lda * 2;
    const size_t tstepB = 2 * hstepB, tstepA = 2 * hstepA;
    const unsigned ldsw = (unsigned)wid * 1024u;
    const int aoff = lds_byte(wr * 64 + fr, fq * 8), boff = lds_byte(wc * 32 + fr, fq * 8);
#define PG8_SA(b, h) (((b) * 2 + (h)) * HTB)
#define PG8_SB(b, h) ((4 + (b) * 2 + (h)) * HTB)
#define PG8_STAGE(bufoff, gbase, voff) do { _Pragma("unroll") for (int _i = 0; _i < 2; ++_i) \
        __builtin_amdgcn_global_load_lds((const unsigned*)((const char*)(gbase) + (voff)[_i]), (PG8_LAS unsigned*)(lds + (bufoff) + ldsw + _i * 8192), 16, 0, 0); } while (0)
#define PG8_LDA(dst, b, h) do { _Pragma("unroll") for (int m = 0; m < 4; ++m) _Pragma("unroll") for (int k = 0; k < 2; ++k) dst[m][k] = *(const PG8_LAS bf16x8*)(lds + PG8_SA(b, h) + aoff + m * 2048 + k * 1024); } while (0)
#define PG8_LDB(dst, b, h) do { _Pragma("unroll") for (int n = 0; n < 2; ++n) _Pragma("unroll") for (int k = 0; k < 2; ++k) dst[n][k] = *(const PG8_LAS bf16x8*)(lds + PG8_SB(b, h) + boff + n * 2048 + k * 1024); } while (0)
#define PG8_MMA(ai, bj, At, Bt) do { __builtin_amdgcn_s_setprio(1); _Pragma("unroll") for (int m = 0; m < 4; ++m) _Pragma("unroll") for (int n = 0; n < 2; ++n) _Pragma("unroll") for (int k = 0; k < 2; ++k) \
        acc[ai][bj][m][n] = __builtin_amdgcn_mfma_f32_16x16x32_bf16(Bt[n][k], At[m][k], acc[ai][bj][m][n], 0, 0, 0); __builtin_amdgcn_s_setprio(0); } while (0)
#define PG8_WAIT_V(n) asm volatile("s_waitcnt vmcnt(" #n ")" ::: "memory")
#define PG8_WAIT_L(n) asm volatile("s_waitcnt lgkmcnt(" #n ")" ::: "memory")
#define PG8_BAR __builtin_amdgcn_s_barrier()
#define PG8_SCHED __builtin_amdgcn_sched_barrier(0)
    Unit cur, nxt; int ui = 0;
    if (!S.next(0, cur)) return;
    f32x4 acc[2][2][4][2];
#pragma unroll
    for (int a = 0; a < 2; ++a)
#pragma unroll
        for (int b = 0; b < 2; ++b)
#pragma unroll
            for (int m = 0; m < 4; ++m)
#pragma unroll
                for (int n = 0; n < 2; ++n) acc[a][b][m][n] = (f32x4){0.f, 0.f, 0.f, 0.f};
    bf16x8 At[4][2], B0[2][2], B1[2][2];
    const char* cA = (const char*)g.A + (cur.pm < g.pm2 ? (long)cur.pm * (long)tstepA : g.a2off + (long)(cur.pm - g.pm2) * (long)tstepA); const char* cB = (const char*)g.Bt + (size_t)cur.pn * tstepB;
    S.a_ready(cur);
    if constexpr (SP2) {
        PG8_STAGE(PG8_SB(0, 0), cB, voffB); PG8_STAGE(PG8_SB(0, 1), cB + hstepB, voffB); PG8_STAGE(PG8_SA(0, 0), cA, voffA); PG8_STAGE(PG8_SA(0, 1), cA + hstepA, voffA);
        if (wr == 1) PG8_BAR;
        PG8_WAIT_V(2); PG8_BAR;
        PG8_STAGE(PG8_SB(1, 0), cB + kstep, voffB); PG8_STAGE(PG8_SA(1, 0), cA + kstep, voffA); PG8_STAGE(PG8_SB(1, 1), cB + hstepB + kstep, voffB);
        PG8_WAIT_V(6); PG8_BAR;
    } else {
        PG8_STAGE(PG8_SB(0, 0), cB, voffB); PG8_STAGE(PG8_SA(0, 0), cA, voffA); PG8_STAGE(PG8_SB(0, 1), cB + hstepB, voffB); PG8_STAGE(PG8_SA(0, 1), cA + hstepA, voffA);
        if (wr == 1) PG8_BAR;
        PG8_WAIT_V(4); PG8_BAR;
        PG8_STAGE(PG8_SB(1, 0), cB + kstep, voffB); PG8_STAGE(PG8_SA(1, 0), cA + kstep, voffA); PG8_STAGE(PG8_SB(1, 1), cB + hstepB + kstep, voffB);
        PG8_WAIT_V(6); PG8_BAR;
    }
    for (;;) {
        const bool has_next = S.next(ui + 1, nxt);
        const char* nA = has_next ? (const char*)g.A + (nxt.pm < g.pm2 ? (long)nxt.pm * (long)tstepA : g.a2off + (long)(nxt.pm - g.pm2) * (long)tstepA) : cA; const char* nB = has_next ? (const char*)g.Bt + (size_t)nxt.pn * tstepB : cB;
        for (int t = 0; t < nt; t += 2) {
            if constexpr (Epi::RESCALE) { if (t == 8 || t == 16) E.rescale(acc, ui, t, wr, fr); }
            const bool last = (t == nt - 2);
            const char* a1 = cA + (size_t)(t + 1) * kstep;
            const char* a2 = last ? nA : cA + (size_t)(t + 2) * kstep; const char* b2 = last ? nB : cB + (size_t)(t + 2) * kstep;
            const char* a3 = a2 + kstep; const char* b3 = b2 + kstep;
            if (last && has_next) S.a_ready(nxt);
            if constexpr (SP2) {
            PG8_LDB(B0, 0, 0); PG8_LDB(B1, 0, 1); PG8_SCHED; PG8_LDA(At, 0, 0); PG8_STAGE(PG8_SA(1, 1), a1 + hstepA, voffA);
            PG8_WAIT_V(8); PG8_WAIT_L(0); PG8_BAR; PG8_MMA(0, 0, At, B0); PG8_MMA(0, 1, At, B1); PG8_BAR; PG8_SCHED;
            PG8_LDA(At, 0, 1); PG8_STAGE(PG8_SB(0, 0), b2, voffB); PG8_STAGE(PG8_SB(0, 1), b2 + hstepB, voffB); PG8_STAGE(PG8_SA(0, 0), a2, voffA);
            PG8_WAIT_V(8); PG8_WAIT_L(0); PG8_BAR; PG8_MMA(1, 0, At, B0); PG8_MMA(1, 1, At, B1); PG8_BAR; PG8_SCHED;
            PG8_LDB(B0, 1, 0); PG8_LDB(B1, 1, 1); PG8_SCHED; PG8_LDA(At, 1, 0); PG8_STAGE(PG8_SA(0, 1), a2 + hstepA, voffA);
            PG8_WAIT_V(8); PG8_WAIT_L(0); PG8_BAR; PG8_MMA(0, 0, At, B0); PG8_MMA(0, 1, At, B1); PG8_BAR; PG8_SCHED;
            PG8_LDA(At, 1, 1); PG8_STAGE(PG8_SB(1, 0), b3, voffB); PG8_STAGE(PG8_SB(1, 1), b3 + hstepB, voffB); PG8_STAGE(PG8_SA(1, 0), a3, voffA);
            PG8_WAIT_V(8); PG8_WAIT_L(0); PG8_BAR; PG8_MMA(1, 0, At, B0); PG8_MMA(1, 1, At, B1); PG8_BAR; PG8_SCHED;
            } else {
            PG8_LDB(B0, 0, 0); PG8_SCHED; PG8_LDA(At, 0, 0); PG8_STAGE(PG8_SA(1, 1), a1 + hstepA, voffA);
            PG8_WAIT_L(8); PG8_BAR; PG8_WAIT_L(0); PG8_MMA(0, 0, At, B0); PG8_BAR; PG8_SCHED;
            PG8_LDB(B1, 0, 1); PG8_STAGE(PG8_SB(0, 0), b2, voffB);
            PG8_BAR; PG8_WAIT_L(0); PG8_MMA(0, 1, At, B1); PG8_BAR;
            PG8_LDA(At, 0, 1); PG8_STAGE(PG8_SA(0, 0), a2, voffA);
            PG8_BAR; PG8_WAIT_L(0); PG8_MMA(1, 0, At, B0); PG8_BAR; PG8_SCHED;
            PG8_STAGE(PG8_SB(0, 1), b2 + hstepB, voffB);
            PG8_WAIT_V(6); PG8_BAR; PG8_MMA(1, 1, At, B1); PG8_BAR;
            PG8_LDB(B0, 1, 0); PG8_SCHED; PG8_LDA(At, 1, 0); PG8_STAGE(PG8_SA(0, 1), a2 + hstepA, voffA);
            PG8_WAIT_L(8); PG8_BAR; PG8_WAIT_L(0); PG8_MMA(0, 0, At, B0); PG8_BAR; PG8_SCHED;
            PG8_LDB(B1, 1, 1); PG8_STAGE(PG8_SB(1, 0), b3, voffB);
            PG8_BAR; PG8_WAIT_L(0); PG8_MMA(0, 1, At, B1); PG8_BAR;
            PG8_LDA(At, 1, 1); PG8_STAGE(PG8_SA(1, 0), a3, voffA);
            PG8_BAR; PG8_WAIT_L(0); PG8_MMA(1, 0, At, B0); PG8_BAR; PG8_SCHED;
            PG8_STAGE(PG8_SB(1, 1), b3 + hstepB, voffB);
            PG8_WAIT_V(6); PG8_BAR; PG8_MMA(1, 1, At, B1); PG8_BAR;
            }
        }
        if constexpr (ALIGN_EPI) { if (wr == 0) PG8_BAR; }
        if constexpr (Epi::RESCALE) { E.fin(acc, cur, ui, wr, wc, fr, fq); } else if constexpr (!Epi::AFTER_DRAIN) { E(acc, cur, wr, wc, fr, fq); S.done(cur); }
        if (!has_next) break;
#pragma unroll
        for (int a = 0; a < 2; ++a)
#pragma unroll
            for (int b = 0; b < 2; ++b)
#pragma unroll
                for (int m = 0; m < 4; ++m)
#pragma unroll
                    for (int n = 0; n < 2; ++n) acc[a][b][m][n] = (f32x4){0.f, 0.f, 0.f, 0.f};
        cur = nxt; cA = nA; cB = nB; ++ui;
        if constexpr (ALIGN_EPI) { if (wr == 1) PG8_BAR; }
    }
    PG8_WAIT_V(0);
    if constexpr (!ALIGN_EPI) { if (wr == 0) PG8_BAR; }
    PG8_BAR;
    if constexpr (Epi::AFTER_DRAIN) { E.fused(acc, cur, wr, wc, fr, fq, lds, wid, lane); S.done(cur); }
#undef PG8_SA
#undef PG8_SB
#undef PG8_STAGE
#undef PG8_LDA
#undef PG8_LDB
#undef PG8_MMA
#undef PG8_WAIT_V
#undef PG8_WAIT_L
#undef PG8_BAR
#undef PG8_SCHED
}
}

#include <hip/hip_bf16.h>
#include <cmath>
namespace attn_body {
using bf16=__hip_bfloat16;
using bf16x8=__attribute__((ext_vector_type(8)))short;
using s16x4=__attribute__((ext_vector_type(4)))short;
using f32x16=__attribute__((ext_vector_type(16)))float;
using u32x4=__attribute__((ext_vector_type(4)))unsigned;
constexpr int D=64,DM=3584;
constexpr int NW=8,QBLK=32,QB=QBLK*NW,KVBLK=64;
constexpr int ATTN_PITCH=DM, ATTN_UNIT_ROWS=QB;
__device__ __forceinline__ int crow(int r,int hi){return (r&3)+8*(r>>2)+4*hi;}
#define SBAR() __builtin_amdgcn_sched_barrier(0)
constexpr int NSLOT=3, SLOTB=8192;
constexpr int LDS_K=0, LDS_V=NSLOT*SLOTB, LDS_WS=2*NSLOT*SLOTB, LDS_OST=LDS_WS+NW*64*4, LDS_BYTES=LDS_OST+NW*4096;
constexpr float C2=0.125f*1.4426950408889634f;
__device__ __forceinline__ void glds16(const void*gsrc,unsigned lds_dst){unsigned keep;
  asm volatile("s_mov_b32 %0, m0\n\ts_mov_b32 m0, %2\n\ts_nop 0\n\tglobal_load_lds_dwordx4 %1, off\n\ts_mov_b32 m0, %0":"=&s"(keep):"v"(gsrc),"s"(lds_dst):"memory");}
__device__ __forceinline__ float max3f(float a,float b,float c){float r;asm("v_max3_f32 %0, %1, %2, %3":"=v"(r):"v"(a),"v"(b),"v"(c));return r;}
__device__ __forceinline__ float max2f(float a,float b){float r;asm("v_max_f32_e32 %0, %1, %2":"=v"(r):"v"(a),"v"(b));return r;}
__device__ __forceinline__ float fadd_s(float a,float b){float r;asm("v_add_f32_e32 %0, %1, %2":"=v"(r):"v"(a),"v"(b));return r;}
__device__ __forceinline__ float fsub_s(float a,float b){float r;asm("v_sub_f32_e32 %0, %1, %2":"=v"(r):"v"(a),"v"(b));return r;}
typedef float f32x2_t __attribute__((ext_vector_type(2))); typedef __bf16 bf16x2_t __attribute__((ext_vector_type(2)));
__device__ __forceinline__ unsigned cvtpk_s(float lo,float hi){f32x2_t v={lo,hi};bf16x2_t b=__builtin_convertvector(v,bf16x2_t);return __builtin_bit_cast(unsigned,b);}
#define WAIT_BAR(N) asm volatile("s_waitcnt vmcnt(" #N ") lgkmcnt(0)\n\ts_barrier":::"memory")

__device__ __forceinline__ void qkt(f32x16&p0,f32x16&p1,const char*Kslot,const bf16x8*qr,const f32x16&negm,int r32,int hi){
  const char*kb=Kslot+hi*1024+r32*16;
  #pragma unroll
  for(int d0=0;d0<4;++d0){
    const bf16x8 b0=*reinterpret_cast<const bf16x8*>(kb+d0*2048);
    const bf16x8 b1=*reinterpret_cast<const bf16x8*>(kb+d0*2048+512);
    if(d0==0){p0=__builtin_amdgcn_mfma_f32_32x32x16_bf16(b0,qr[0],negm,0,0,0);p1=__builtin_amdgcn_mfma_f32_32x32x16_bf16(b1,qr[0],negm,0,0,0);}
    else{p0=__builtin_amdgcn_mfma_f32_32x32x16_bf16(b0,qr[d0],p0,0,0,0);p1=__builtin_amdgcn_mfma_f32_32x32x16_bf16(b1,qr[d0],p1,0,0,0);}}
}
typedef __attribute__((address_space(3))) const char* lds_cptr;
typedef short v4i16_t __attribute__((ext_vector_type(4)));
__device__ __forceinline__ void kload8(bf16x8*kf,lds_cptr kp){
  kf[0]=*(const __attribute__((address_space(3))) bf16x8*)(kp);      kf[1]=*(const __attribute__((address_space(3))) bf16x8*)(kp+512);
  kf[2]=*(const __attribute__((address_space(3))) bf16x8*)(kp+2048); kf[3]=*(const __attribute__((address_space(3))) bf16x8*)(kp+2560);
  kf[4]=*(const __attribute__((address_space(3))) bf16x8*)(kp+4096); kf[5]=*(const __attribute__((address_space(3))) bf16x8*)(kp+4608);
  kf[6]=*(const __attribute__((address_space(3))) bf16x8*)(kp+6144); kf[7]=*(const __attribute__((address_space(3))) bf16x8*)(kp+6656);
}
__device__ __forceinline__ void kload2(bf16x8*kf,lds_cptr kp,int j){ kf[2*j]=*(const __attribute__((address_space(3))) bf16x8*)(kp+j*2048); kf[2*j+1]=*(const __attribute__((address_space(3))) bf16x8*)(kp+j*2048+512); }
__device__ __forceinline__ s16x4 vtr(lds_cptr p){ return __builtin_bit_cast(s16x4,__builtin_amdgcn_ds_read_tr16_b64_v4i16((__attribute__((address_space(3))) v4i16_t*)p)); }
__device__ __forceinline__ float rowmax(const f32x16&p0,const f32x16&p1){
  float a=max3f(p0[0],p0[1],p1[0]),b=max3f(p0[2],p0[3],p1[1]);a=max3f(a,p1[2],p1[3]);
  #pragma unroll
  for(int r=4;r<16;r+=4){a=max3f(a,p0[r],p0[r+1]);b=max3f(b,p0[r+2],p0[r+3]);a=max3f(a,p1[r],p1[r+1]);b=max3f(b,p1[r+2],p1[r+3]);}
  const float m=max2f(a,b);
  auto rr=__builtin_amdgcn_permlane32_swap(__float_as_uint(m),__float_as_uint(m),false,false);
  return max2f(__uint_as_float(rr[0]),__uint_as_float(rr[1]));
}
__device__ __forceinline__ void pv(f32x16*o,int vb,bf16x8 pa0,bf16x8 pa1,bf16x8 pa2,bf16x8 pa3){
  #pragma unroll
  for(int d0=0;d0<2;++d0){s16x4 lo[4],hi[4];
    #pragma unroll
    for(int ks=0;ks<4;++ks){
      asm volatile("ds_read_b64_tr_b16 %0,%1 offset:%c2":"=&v"(lo[ks]):"v"(vb),"i"(d0*4096+ks*1024):"memory");
      asm volatile("ds_read_b64_tr_b16 %0,%1 offset:%c2":"=&v"(hi[ks]):"v"(vb),"i"(d0*4096+ks*1024+512):"memory");}
    asm volatile("s_waitcnt lgkmcnt(0)":::"memory");SBAR();
    #define PK(k) (bf16x8){lo[k][0],lo[k][1],lo[k][2],lo[k][3],hi[k][0],hi[k][1],hi[k][2],hi[k][3]}
    o[d0]=__builtin_amdgcn_mfma_f32_32x32x16_bf16(pa0,PK(0),o[d0],0,0,0);
    o[d0]=__builtin_amdgcn_mfma_f32_32x32x16_bf16(pa1,PK(1),o[d0],0,0,0);
    o[d0]=__builtin_amdgcn_mfma_f32_32x32x16_bf16(pa2,PK(2),o[d0],0,0,0);
    o[d0]=__builtin_amdgcn_mfma_f32_32x32x16_bf16(pa3,PK(3),o[d0],0,0,0);
    #undef PK
  }
}

#ifndef ATTN_STORE16
#define ATTN_STORE16(p,v) (*(u32x4*)(p)=(v))
#endif
template<int THRL,bool FAST> __device__ __forceinline__ void attn_unit(float bref,long rowbase,int seqlen,int h,int qb,const bf16*Q,const bf16*__restrict__ K,const bf16*__restrict__ V,bf16*O,float*SSQ,char*shm){
  int tid_l=threadIdx.x; asm volatile("":"+v"(tid_l)); const int tid=tid_l,lane=tid&63,r32=lane&31,hi=lane>>5; const int wid=__builtin_amdgcn_readfirstlane(tid>>6);
  const int q0=qb*QB; const int kvh=h>>2;
  const bf16*Qw=Q+(rowbase+q0+wid*QBLK)*DM+h*D;
  constexpr int KDM=64; constexpr long KVTOK=81920;
  const bf16*Kh=K+((long)kvh*KVTOK+rowbase)*KDM,*Vh=V+((long)kvh*KVTOK+rowbase)*KDM;
  const unsigned lds0=(unsigned)(uintptr_t)shm;
  float*wsf=(float*)(shm+LDS_WS)+wid*64;
  const bf16*ksrc=Kh+(long)lane*KDM+wid*8;
  const bf16*vsrc=Vh+(long)(16*(wid&3)+(lane>>2))*KDM+(wid>>2)*32+(lane&3)*8;
  const unsigned kdst=lds0+LDS_K+wid*1024, vdst=lds0+LDS_V+wid*1024;
  #define DMA_K(t,slot) glds16(ksrc+(long)(t)*KVBLK*KDM,(unsigned)__builtin_amdgcn_readfirstlane(kdst+(slot)))
  #define DMA_V(t,slot) glds16(vsrc+(long)(t)*KVBLK*KDM,(unsigned)__builtin_amdgcn_readfirstlane(vdst+(slot)))
  const int vb0=(int)(lds0+LDS_V)+((lane>>4)&1)*32+(lane&3)*8+(4*hi+((lane&15)>>2))*64;
  const char*Kbase=shm+LDS_K; bf16x8 kf[8];
  const lds_cptr shm3=(lds_cptr)shm; const lds_cptr kp0=shm3+LDS_K+hi*1024+r32*16; const lds_cptr vp0=shm3+LDS_V+((lane>>4)&1)*32+(lane&3)*8+(4*hi+((lane&15)>>2))*64;
  const int NT=seqlen/KVBLK;
  DMA_K(0,0);DMA_V(0,0);DMA_K(1,SLOTB);
  bf16x8 qr[4];
  #pragma unroll
  for(int d0=0;d0<4;++d0)qr[d0]=*reinterpret_cast<const bf16x8*>(&Qw[(long)r32*DM+d0*16+hi*8]);
  float mhat=FAST?bref:0.f,l_reg=0.f;f32x16 o[2];o[0]=f32x16{};o[1]=f32x16{};f32x16 negm=f32x16{};
  if constexpr(FAST){
    #pragma unroll
    for(int r=0;r<16;++r)negm[r]=-bref;}
  asm volatile("":"+v"(negm));
  #define CMASK(P0,P1,t) do{}while(0)
  bool resc=false;
  #define START(P0,P1) do{ resc=false; \
    if constexpr(!FAST){ const float rm=rowmax(P0,P1); const float dl=rm; mhat=fadd_s(mhat,dl); \
      _Pragma("unroll") for(int r=0;r<16;++r){P0[r]=fsub_s(P0[r],dl);P1[r]=fsub_s(P1[r],dl);} \
      _Pragma("unroll") for(int r=0;r<16;++r)negm[r]=-mhat; asm volatile("":"+v"(negm)); } \
    _Pragma("unroll") for(int r=0;r<16;++r)P0[r]=__builtin_amdgcn_exp2f(P0[r]); }while(0)
  #define RESC() do{ if(resc){ asm volatile("s_waitcnt lgkmcnt(0)":::"memory"); \
      _Pragma("unroll") for(int d_=0;d_<2;++d_) _Pragma("unroll") for(int r=0;r<16;++r)o[d_][r]*=wsf[crow(r,hi)]; } }while(0)
  f32x16 pA0,pA1,pB0,pB1;
  int sl_prev=0,sl_cur=0,sl_next=SLOTB;
  #define ROT() do{sl_prev=sl_cur;sl_cur=sl_next;sl_next=(sl_next==(NSLOT-1)*SLOTB)?0:sl_next+SLOTB;}while(0)
  DMA_K(2,2*SLOTB);
  WAIT_BAR(3);
  qkt(pA0,pA1,Kbase,qr,negm,r32,hi);asm volatile("s_nop 15\n\ts_nop 7":"+v"(pA0),"+v"(pA1));
  START(pA0,pA1);
  _Pragma("unroll") for(int r=0;r<16;++r)pA1[r]=__builtin_amdgcn_exp2f(pA1[r]);
  WAIT_BAR(0);
  DMA_K(3,0);DMA_V(1,SLOTB);
  ROT();
  kload8(kf,kp0+sl_cur);
  WAIT_BAR(2);
  s16x4 vlo[8],vhi[8]; u32x4 pw0,pw1,pw2,pw3;
  #define PKW(P,B) cvtpk_s(P[B],P[B+1])
  #define PAF(k) __builtin_bit_cast(bf16x8,pw##k)
  #define VFR(i) (bf16x8){vlo[i][0],vlo[i][1],vlo[i][2],vlo[i][3],vhi[i][0],vhi[i][1],vhi[i][2],vhi[i][3]}
  #define PIN(x) asm volatile("":"+v"(x))
  #define MX3(a,b,c) __builtin_fmaxf(__builtin_fmaxf((a),(b)),(c))
  #define GAPA(MF,A0,A1,A2,A3,W0,W1,PW) do{ MF; sacc+=A0; sacc+=A1; sacc+=A2; sacc+=A3; PIN(sacc); W0; W1; PIN(PW); SBAR(); }while(0)
  #define EX(v) __builtin_amdgcn_exp2f(v)
  #define GAPB(MF,X,B) do{ MF; X[B]=EX(X[B]); X[B+1]=EX(X[B+1]); X[B+2]=EX(X[B+2]); X[B+3]=EX(X[B+3]); PIN(X); SBAR(); }while(0)
  #define VRD(i) do{ vlo[i]=vtr(vp_+(((i)>>2)*4096+((i)&3)*1024)); vhi[i]=vtr(vp_+(((i)>>2)*4096+((i)&3)*1024+512)); }while(0)
  #define KRD(G,j) do{ if(G){ kload2(kf,kp0+sl_next,j); SBAR(); } }while(0)
  #define STEP(C0,C1,P0,P1,t,GK,GV,GL) do{ SBAR(); \
    const lds_cptr vp_=vp0+sl_prev; \
    VRD(0); SBAR(); float sacc=(P0[0]+P0[1]); \
    GAPA(C0=__builtin_amdgcn_mfma_f32_32x32x16_bf16(kf[0],qr[0],negm,0,0,0), P0[2],P0[3],P0[4],P0[5],     pw0[0]=PKW(P0,0), pw0[1]=PKW(P0,2), pw0); \
    VRD(4); SBAR(); GAPA(C1=__builtin_amdgcn_mfma_f32_32x32x16_bf16(kf[1],qr[0],negm,0,0,0), P0[6],P0[7],P0[8],P0[9],     pw0[2]=PKW(P0,4), pw0[3]=PKW(P0,6), pw0); \
    VRD(1); SBAR(); GAPA(C0=__builtin_amdgcn_mfma_f32_32x32x16_bf16(kf[2],qr[1],C0,0,0,0),   P0[10],P0[11],P0[12],P0[13], pw1[0]=PKW(P0,8), pw1[1]=PKW(P0,10), pw1); \
    VRD(5); SBAR(); GAPA(C1=__builtin_amdgcn_mfma_f32_32x32x16_bf16(kf[3],qr[1],C1,0,0,0),   P0[14],P0[15],P1[0],P1[1],   pw1[2]=PKW(P0,12),pw1[3]=PKW(P0,14), pw1); \
    VRD(2); SBAR(); GAPA(C0=__builtin_amdgcn_mfma_f32_32x32x16_bf16(kf[4],qr[2],C0,0,0,0),   P1[2],P1[3],P1[4],P1[5],     pw2[0]=PKW(P1,0), pw2[1]=PKW(P1,2), pw2); \
    VRD(6); SBAR(); GAPA(C1=__builtin_amdgcn_mfma_f32_32x32x16_bf16(kf[5],qr[2],C1,0,0,0),   P1[6],P1[7],P1[8],P1[9],     pw2[2]=PKW(P1,4), pw2[3]=PKW(P1,6), pw2); \
    VRD(3); SBAR(); GAPA(C0=__builtin_amdgcn_mfma_f32_32x32x16_bf16(kf[6],qr[3],C0,0,0,0),   P1[10],P1[11],P1[12],P1[13], pw3[0]=PKW(P1,8), pw3[1]=PKW(P1,10), pw3); \
    VRD(7); SBAR(); GAPA(C1=__builtin_amdgcn_mfma_f32_32x32x16_bf16(kf[7],qr[3],C1,0,0,0),   P1[14],P1[15],0.f,0.f,       pw3[2]=PKW(P1,12),pw3[3]=PKW(P1,14), pw3); \
    l_reg+=sacc; \
    if(GK){DMA_K((t)+3,sl_cur);} if(GV){DMA_V((t)+1,sl_next);} \
    CMASK(C0,C1,t); \
    if constexpr(!FAST){ float a=MX3(C0[0],C0[1],C1[0]),b=MX3(C0[2],C0[3],C1[1]); a=MX3(a,C1[2],C1[3]); \
      _Pragma("unroll") for(int r=4;r<16;r+=4){a=MX3(a,C0[r],C0[r+1]);b=MX3(b,C0[r+2],C0[r+3]);a=MX3(a,C1[r],C1[r+1]);b=MX3(b,C1[r+2],C1[r+3]);} \
      float rm=__builtin_fmaxf(a,b); { auto rr=__builtin_amdgcn_permlane32_swap(__float_as_uint(rm),__float_as_uint(rm),false,false); rm=__builtin_fmaxf(__uint_as_float(rr[0]),__uint_as_float(rr[1])); } \
      resc=false; \
      if(__builtin_expect(__any(rm>(float)THRL),0)){ const float dl=__builtin_fmaxf(rm,0.f); mhat+=dl; \
        _Pragma("unroll") for(int r=0;r<16;++r){C0[r]-=dl;C1[r]-=dl;} \
        _Pragma("unroll") for(int r=0;r<16;++r)negm[r]=-mhat; asm volatile("":"+v"(negm)); \
        const float f=__builtin_amdgcn_exp2f(-dl); l_reg*=f; if(hi==0)wsf[r32]=f; resc=true; } } \
    SBAR(); \
    GAPB(o[0]=__builtin_amdgcn_mfma_f32_32x32x16_bf16(PAF(0),VFR(0),o[0],0,0,0), C0,0); \
    GAPB(o[1]=__builtin_amdgcn_mfma_f32_32x32x16_bf16(PAF(0),VFR(4),o[1],0,0,0), C0,4); \
    KRD(GL,0); GAPB(o[0]=__builtin_amdgcn_mfma_f32_32x32x16_bf16(PAF(1),VFR(1),o[0],0,0,0), C0,8); \
    KRD(GL,1); GAPB(o[1]=__builtin_amdgcn_mfma_f32_32x32x16_bf16(PAF(1),VFR(5),o[1],0,0,0), C0,12); \
    KRD(GL,2); GAPB(o[0]=__builtin_amdgcn_mfma_f32_32x32x16_bf16(PAF(2),VFR(2),o[0],0,0,0), C1,0); \
    KRD(GL,3); GAPB(o[1]=__builtin_amdgcn_mfma_f32_32x32x16_bf16(PAF(2),VFR(6),o[1],0,0,0), C1,4); \
    GAPB(o[0]=__builtin_amdgcn_mfma_f32_32x32x16_bf16(PAF(3),VFR(3),o[0],0,0,0), C1,8); \
    GAPB(o[1]=__builtin_amdgcn_mfma_f32_32x32x16_bf16(PAF(3),VFR(7),o[1],0,0,0), C1,12); \
    }while(0)
  int t=1;
  for(;t+5<NT;t+=2){
    STEP(pB0,pB1,pA0,pA1,t,true,true,true);     WAIT_BAR(2); RESC(); ROT();
    STEP(pA0,pA1,pB0,pB1,t+1,true,true,true);   WAIT_BAR(2); RESC(); ROT();
  }
  #define ENDW(tt) do{ if((tt)+3<NT){WAIT_BAR(2);} else if((tt)+2<NT){WAIT_BAR(1);} else {WAIT_BAR(0);} }while(0)
  for(;t+1<NT;t+=2){
    STEP(pB0,pB1,pA0,pA1,t,(t+3<NT),(t+1<NT),(t+1<NT));       ENDW(t);   RESC(); ROT();
    STEP(pA0,pA1,pB0,pB1,t+1,(t+4<NT),(t+2<NT),(t+2<NT));     ENDW(t+1); RESC(); ROT();
  }
  STEP(pB0,pB1,pA0,pA1,NT-1,false,false,false); RESC();
  { float sacc=pB0[0]+pB0[1]; _Pragma("unroll") for(int r=2;r<16;++r)sacc+=pB0[r]; _Pragma("unroll") for(int r=0;r<16;++r)sacc+=pB1[r]; l_reg+=sacc;
    pw0=(u32x4){PKW(pB0,0),PKW(pB0,2),PKW(pB0,4),PKW(pB0,6)};pw1=(u32x4){PKW(pB0,8),PKW(pB0,10),PKW(pB0,12),PKW(pB0,14)};pw2=(u32x4){PKW(pB1,0),PKW(pB1,2),PKW(pB1,4),PKW(pB1,6)};pw3=(u32x4){PKW(pB1,8),PKW(pB1,10),PKW(pB1,12),PKW(pB1,14)};
    SBAR(); pv(o,vb0+sl_cur,PAF(0),PAF(1),PAF(2),PAF(3)); }
  #undef PKW
  #undef PAF
  #undef VFR
  #undef PIN
  #undef MX3
  #undef GAPA
  #undef GAPB
  #undef EX
  #undef VRD
  #undef KRD
  #undef STEP
  #undef ENDW
  {auto rr=__builtin_amdgcn_permlane32_swap(__float_as_uint(l_reg),__float_as_uint(l_reg),false,false);l_reg=__uint_as_float(rr[0])+__uint_as_float(rr[1]);}
  if(hi==0)wsf[32+r32]=l_reg;asm volatile("s_waitcnt lgkmcnt(0)":::"memory");
  float rli[16];
  #pragma unroll
  for(int r=0;r<16;++r)rli[r]=__builtin_amdgcn_rcpf(wsf[32+crow(r,hi)]);
  bf16*Ow=O+(rowbase+q0+wid*QBLK)*DM+h*D;
  { bf16*stg=(bf16*)(shm+LDS_OST)+wid*2048;
    #pragma unroll
    for(int r=0;r<16;++r){const int orow=crow(r,hi);
      #pragma unroll
      for(int d0=0;d0<2;++d0)stg[orow*64+d0*32+r32]=__float2bfloat16(o[d0][r]*rli[r]);}
    asm volatile("s_waitcnt lgkmcnt(0)":::"memory");
    #pragma unroll
    for(int i=0;i<4;++i){const int row=i*8+(lane>>3),ch=lane&7; const u32x4 v=*(const u32x4*)(stg+row*64+ch*8); ATTN_STORE16(Ow+(long)row*DM+ch*8,v);
      float q=0.f;
      #pragma unroll
      for(int e=0;e<4;++e){const float a=__uint_as_float(v[e]<<16),b=__uint_as_float(v[e]&0xffff0000u);q+=a*a+b*b;}
      q+=__shfl_xor(q,1);q+=__shfl_xor(q,2);q+=__shfl_xor(q,4);
      if(ch==0)SSQ[(rowbase+q0+wid*QBLK+row)*8+h]=q;} }
  asm volatile("s_waitcnt lgkmcnt(0)\n\ts_barrier":::"memory");
  #undef DMA_K
  #undef DMA_V
  #undef CMASK
  #undef START
  #undef RESC
  #undef ROT
}
constexpr int ATTN_LDS_BYTES=LDS_BYTES;
struct AttnTensors { const bf16* Q; const bf16* K; const bf16* V; bf16* O; float* SSQ; };
template<int THRL,bool FAST> __device__ __forceinline__ void attn_phase(float bref,char*lds,const AttnTensors&T,int vcu,int G){
  for(int u=vcu;u<2560;u+=G){
    long rowbase;int seqlen,h,qb;
    if(u<512){rowbase=0;seqlen=16384;h=u>>6;qb=u&63;}
    else{const int u2=u-512;const int s=u2>>8;rowbase=16384+(long)s*8192;seqlen=8192;h=(u2>>5)&7;qb=u2&31;}
    attn_unit<THRL,FAST>(bref,rowbase,seqlen,h,qb,T.Q,T.K,T.V,T.O,T.SSQ,lds);
  }
}
#undef SBAR
#undef WAIT_BAR
}

namespace cg = cooperative_groups;
#ifndef PHMASK
#define PHMASK 0xffff
#endif

#define LAS __attribute__((address_space(3)))
typedef unsigned short bf16;
typedef unsigned v4u __attribute__((ext_vector_type(4)));
typedef unsigned v2u __attribute__((ext_vector_type(2)));
typedef float f32x4 __attribute__((ext_vector_type(4)));
typedef short bf16x8 __attribute__((ext_vector_type(8)));

constexpr int NTOK = 81920, PP = 3584;
constexpr int QC = 1024, XC = 1536, KC = 3072, VC = 3200, DTC = 3328;
constexpr int NCHUNK = 640;
constexpr float LOG2E = 1.4426950408889634f, EPSN = 1e-6f;
constexpr size_t MiB = 1u << 20;
constexpr size_t WS_TAB = 0, WS_WIN = 1 * MiB, WS_WOUT = 8 * MiB, WS_WXQ = 11 * MiB, WS_WXKV = 12 * MiB, WS_WXO = 14 * MiB, WS_WGU = 15 * MiB, WS_WD = 26 * MiB,
                 WS_MEMN = 32 * MiB, WS_MKV = 37 * MiB, WS_XN = 42 * MiB, WS_DT = 42 * MiB, WS_CS = 52 * MiB, WS_DEC = 62 * MiB, WS_SSQS = 64 * MiB, WS_SSQA = 66 * MiB, WS_KC = 122 * MiB, WS_VC = 1002 * MiB,
                 WS_PROJ = 202 * MiB, WS_Q2 = 202 * MiB, WS_CA = 282 * MiB, WS_HID = 202 * MiB, WS_XBC = 762 * MiB, WS_RAW = 762 * MiB, WS_X2B0 = 642 * MiB, WS_X2B1 = 922 * MiB, WS_END = 1022 * MiB, WS_BAR = 512 * 1024;
constexpr int LDS_BYTES = 152 * 1024;

__device__ __forceinline__ unsigned f2bf(float f) { unsigned u = __builtin_bit_cast(unsigned, f); return (u + 0x7fffu + ((u >> 16) & 1u)) >> 16; }
typedef float f32x2_t __attribute__((ext_vector_type(2))); typedef __bf16 bf16x2_t __attribute__((ext_vector_type(2)));
__device__ __forceinline__ unsigned pk2(float lo, float hi) { f32x2_t v = {lo, hi}; bf16x2_t b = __builtin_convertvector(v, bf16x2_t); return __builtin_bit_cast(unsigned, b); }
__device__ __forceinline__ float bflo(unsigned w) { return __builtin_bit_cast(float, w << 16); }
__device__ __forceinline__ float bfhi(unsigned w) { return __builtin_bit_cast(float, w & 0xffff0000u); }
__device__ __forceinline__ float bf1(bf16 h) { return __builtin_bit_cast(float, ((unsigned)h) << 16); }
__device__ __forceinline__ float wave_sum(float v) {
#pragma unroll
    for (int o = 1; o < 64; o <<= 1) v += __shfl_xor(v, o);
    return v;
}
__device__ __forceinline__ float ex2(float x) { return __builtin_amdgcn_exp2f(x); }
__device__ __forceinline__ f32x4 mfma16(bf16x8 a, bf16x8 b, f32x4 c) { return __builtin_amdgcn_mfma_f32_16x16x32_bf16(a, b, c, 0, 0, 0); }
__device__ __forceinline__ const float* xrow(const float* xp, const float* xs, int t) { return t < 16384 ? xp + (size_t)t * 1024 : xs + (size_t)(t - 16384) * 1024; }
#define LDS_WAIT() asm volatile("s_waitcnt lgkmcnt(0)" ::: "memory")
#define LBAR() asm volatile("s_waitcnt lgkmcnt(0)\n\ts_barrier" ::: "memory")

struct EpiStore {
    static constexpr bool PERM = true, AFTER_DRAIN = false, RESCALE = false;
    bf16* O; int ldc; float scale; const float* rs;
    __device__ __forceinline__ void operator()(const f32x4 (&acc)[2][2][4][2], const pg8::Unit& u, int wr, int wc, int fr, int fq) const {
        const int row0 = u.pm * 256 + wr * 64 + fr, col0 = u.pn * 256 + wc * 32 + 8 * fq;
#pragma unroll
        for (int ai = 0; ai < 2; ++ai)
#pragma unroll
            for (int m = 0; m < 4; ++m) { bf16* rowp = O + (size_t)(row0 + ai * 128 + m * 16) * ldc + col0; const float sc = rs ? scale * rs[row0 + ai * 128 + m * 16] : scale;
#pragma unroll
                for (int bj = 0; bj < 2; ++bj) { const f32x4 v0 = acc[ai][bj][m][0] * sc, v1 = acc[ai][bj][m][1] * sc;
                    v4u w; w.x = pk2(v0[0], v0[1]); w.y = pk2(v0[2], v0[3]); w.z = pk2(v1[0], v1[1]); w.w = pk2(v1[2], v1[3]);
                    *(v4u*)(rowp + bj * 128) = w; } }
    }
};
struct EpiProj {
    static constexpr bool PERM = true, AFTER_DRAIN = false, RESCALE = false;
    bf16* O; bf16* VCp;
    __device__ __forceinline__ void operator()(const f32x4 (&acc)[2][2][4][2], const pg8::Unit& u, int wr, int wc, int fr, int fq) const {
        const int row0 = u.pm * 256 + wr * 64 + fr, col0 = u.pn * 256 + wc * 32 + 8 * fq;
        if (u.pn == 13 && wc != 0) return;
#pragma unroll
        for (int ai = 0; ai < 2; ++ai)
#pragma unroll
            for (int m = 0; m < 4; ++m) { const int row = row0 + ai * 128 + m * 16; bf16* rowp = O + (size_t)row * PP + col0;
#pragma unroll
                for (int bj = 0; bj < 2; ++bj) { if (u.pn == 13 && bj == 1) continue;
                    const f32x4 v0 = acc[ai][bj][m][0], v1 = acc[ai][bj][m][1];
                    v4u w; w.x = pk2(v0[0], v0[1]); w.y = pk2(v0[2], v0[3]); w.z = pk2(v1[0], v1[1]); w.w = pk2(v1[2], v1[3]);
                    if (u.pn == 12 && bj == 1) { const int cv = wc * 32 + 8 * fq; *(v4u*)(VCp + ((size_t)(cv >> 6) * NTOK + row) * 64 + (cv & 63)) = w; }
                    else *(v4u*)(rowp + bj * 128) = w; } }
    }
};
struct EpiRowScale {
    static constexpr bool PERM = true, AFTER_DRAIN = false, RESCALE = true;
    bf16* O; int ldc; const LAS float* Rl;
    __device__ __forceinline__ void rescale(f32x4 (&acc)[2][2][4][2], int ui, int t, int wr, int fr) const {
        const LAS float* rp = Rl + (size_t)ui * 1024 + (wr * 64 + fr) * 4 + (t == 8 ? 0 : 1);
#pragma unroll
        for (int ai = 0; ai < 2; ++ai)
#pragma unroll
            for (int m = 0; m < 4; ++m) { const float f = rp[(ai * 128 + m * 16) * 4];
#pragma unroll
                for (int bj = 0; bj < 2; ++bj)
#pragma unroll
                    for (int n = 0; n < 2; ++n) acc[ai][bj][m][n] = acc[ai][bj][m][n] * f; }
    }
    __device__ __forceinline__ void fin(const f32x4 (&acc)[2][2][4][2], const pg8::Unit& u, int ui, int wr, int wc, int fr, int fq) const {
        const int row0 = u.pm * 256 + wr * 64 + fr, col0 = u.pn * 256 + wc * 32 + 8 * fq; const LAS float* rp = Rl + (size_t)ui * 1024 + (wr * 64 + fr) * 4 + 2;
#pragma unroll
        for (int ai = 0; ai < 2; ++ai)
#pragma unroll
            for (int m = 0; m < 4; ++m) { bf16* rowp = O + (size_t)(row0 + ai * 128 + m * 16) * ldc + col0; const float scale = rp[(ai * 128 + m * 16) * 4];
#pragma unroll
                for (int bj = 0; bj < 2; ++bj) { const f32x4 v0 = acc[ai][bj][m][0] * scale, v1 = acc[ai][bj][m][1] * scale;
                    v4u w; w.x = pk2(v0[0], v0[1]); w.y = pk2(v0[2], v0[3]); w.z = pk2(v1[0], v1[1]); w.w = pk2(v1[2], v1[3]);
                    *(v4u*)(rowp + bj * 128) = w; } }
    }
    __device__ __forceinline__ void operator()(const f32x4 (&acc)[2][2][4][2], const pg8::Unit& u, int wr, int wc, int fr, int fq) const {}
};
struct EpiSwiglu {
    static constexpr bool PERM = true, AFTER_DRAIN = false, RESCALE = false;
    bf16* O; int ldc; const float* rs;
    __device__ __forceinline__ void operator()(const f32x4 (&acc)[2][2][4][2], const pg8::Unit& u, int wr, int wc, int fr, int fq) const {
        const int row0 = u.pm * 256 + wr * 64 + fr, col0 = u.pn * 128 + wc * 32 + 8 * fq;
#pragma unroll
        for (int ai = 0; ai < 2; ++ai)
#pragma unroll
            for (int m = 0; m < 4; ++m) { bf16* rowp = O + (size_t)(row0 + ai * 128 + m * 16) * ldc + col0; float h[8]; const float sc = rs[row0 + ai * 128 + m * 16];
#pragma unroll
                for (int n = 0; n < 2; ++n)
#pragma unroll
                    for (int i = 0; i < 4; ++i) { const float g = acc[ai][0][m][n][i] * sc, up = acc[ai][1][m][n][i] * sc; h[4 * n + i] = g * __builtin_amdgcn_rcpf(1.f + ex2(-g * LOG2E)) * up; }
                v4u w; w.x = pk2(h[0], h[1]); w.y = pk2(h[2], h[3]); w.z = pk2(h[4], h[5]); w.w = pk2(h[6], h[7]);
                *(v4u*)rowp = w; }
    }
};

__device__ __forceinline__ void tr_item(const float* W, int pitch, int k0, int ncol0, bf16* WT, int dstK, int drow0, LAS float* scr, int lane, const float* gk = nullptr) {
    float tv[32];
#pragma unroll
    for (int i = 0; i < 32; ++i) { const int kk = 2 * i + (lane >> 5); tv[i] = W[(size_t)(k0 + kk) * pitch + ncol0 + (lane & 31)]; if (gk) tv[i] *= gk[kk]; }
#pragma unroll
    for (int i = 0; i < 32; ++i) { const int kk = 2 * i + (lane >> 5); scr[kk * 33 + (lane & 31)] = tv[i]; }
    LDS_WAIT(); asm volatile("" ::: "memory");
    const int c = lane & 7;
#pragma unroll
    for (int j = 0; j < 4; ++j) { const int n = (lane >> 3) + 8 * j; const LAS float* s = scr + (8 * c) * 33 + n;
        v4u o; o.x = pk2(s[0 * 33], s[1 * 33]); o.y = pk2(s[2 * 33], s[3 * 33]); o.z = pk2(s[4 * 33], s[5 * 33]); o.w = pk2(s[6 * 33], s[7 * 33]);
        *(v4u*)(WT + (size_t)(drow0 + n) * dstK + k0 + 8 * c) = o; }
    LDS_WAIT(); asm volatile("" ::: "memory");
}

constexpr int XSPLIT = 61440;
template <int RB> __device__ __forceinline__ void norm_rows(const float* xp, const float* xs, const bf16* xb_in0, const bf16* xb_in1, const bf16* RAW, const float* gpost, float* out, bf16* xb_out0, bf16* xb_out1,
                                                            const float* gpre, bf16* XN, float* rs_out, int gw, int NGW, int lane) {
    for (int tb = gw; tb < NTOK; tb += NGW * RB) {
        f32x4 v[RB][4]; v2u rw[RB][4];
#pragma unroll
        for (int k = 0; k < RB; ++k) { const int t = tb + k * NGW; if (t < NTOK) {
            if (xp) { const float* base = xrow(xp, xs, t);
#pragma unroll
                for (int j = 0; j < 4; ++j) v[k][j] = ((const f32x4*)base)[lane + 64 * j]; }
            else { const bf16* base = t < XSPLIT ? xb_in0 + (size_t)t * 1024 : xb_in1 + (size_t)(t - XSPLIT) * 1024;
#pragma unroll
                for (int j = 0; j < 4; ++j) { const v2u w = *(const v2u*)(base + 4 * (lane + 64 * j)); v[k][j] = (f32x4){bflo(w.x), bfhi(w.x), bflo(w.y), bfhi(w.y)}; } }
            if (RAW) {
#pragma unroll
                for (int j = 0; j < 4; ++j) rw[k][j] = *(const v2u*)(RAW + (size_t)t * 1024 + 4 * (lane + 64 * j)); } } }
#pragma unroll
        for (int k = 0; k < RB; ++k) { const int t = tb + k * NGW; if (t < NTOK) {
            if (RAW) {
                f32x4 r[4]; float ss = 0.f;
#pragma unroll
                for (int j = 0; j < 4; ++j) { const v2u w = rw[k][j]; r[j] = (f32x4){bflo(w.x), bfhi(w.x), bflo(w.y), bfhi(w.y)};
                    ss += (r[j].x * r[j].x + r[j].y * r[j].y) + (r[j].z * r[j].z + r[j].w * r[j].w); }
                const float rstd = 1.0f / sqrtf(wave_sum(ss) * (1.f / 1024.f) + EPSN);
#pragma unroll
                for (int j = 0; j < 4; ++j) { const f32x4 g = ((const f32x4*)gpost)[lane + 64 * j]; v[k][j] = v[k][j] + r[j] * rstd * g; }
            }
            if (out) {
#pragma unroll
                for (int j = 0; j < 4; ++j) ((f32x4*)(out + (size_t)t * 1024))[lane + 64 * j] = v[k][j]; }
            if (xb_out0) { bf16* ob = t < XSPLIT ? xb_out0 + (size_t)t * 1024 : xb_out1 + (size_t)(t - XSPLIT) * 1024;
#pragma unroll
                for (int j = 0; j < 4; ++j) { v2u w; w.x = pk2(v[k][j].x, v[k][j].y); w.y = pk2(v[k][j].z, v[k][j].w); *(v2u*)(ob + 4 * (lane + 64 * j)) = w; } }
            if (XN || rs_out) {
                float s2 = 0.f;
#pragma unroll
                for (int j = 0; j < 4; ++j) s2 += (v[k][j].x * v[k][j].x + v[k][j].y * v[k][j].y) + (v[k][j].z * v[k][j].z + v[k][j].w * v[k][j].w);
                const float rstd2 = 1.0f / sqrtf(wave_sum(s2) * (1.f / 1024.f) + EPSN);
                if (rs_out && lane == 0) rs_out[t] = rstd2;
                if (XN) {
#pragma unroll
                for (int j = 0; j < 4; ++j) { const f32x4 g = ((const f32x4*)gpre)[lane + 64 * j]; const f32x4 o = v[k][j] * rstd2 * g;
                    v2u w; w.x = pk2(o.x, o.y); w.y = pk2(o.z, o.w); *(v2u*)(XN + (size_t)t * 1024 + 4 * (lane + 64 * j)) = w; } }
            } } }
    }
}

template <int NCH  > __device__ __forceinline__ void lds_transpose128(const bf16* src, int pitch, LAS unsigned char* dst, int tid) {
#pragma unroll
    for (int rep = 0; rep < NCH / 8; ++rep) { const int it = tid + 512 * rep, i = it & 63, ch = it >> 6;
        const bf16* p = src + (size_t)(2 * i) * pitch + ch * 8; const v4u r0 = *(const v4u*)p, r1 = *(const v4u*)(p + pitch);
#pragma unroll
        for (int j = 0; j < 8; ++j) { const unsigned a = r0[j >> 1], b = r1[j >> 1]; const unsigned lo = (j & 1) ? (a >> 16) : (a & 0xffffu), hi = (j & 1) ? (b & 0xffff0000u) : (b << 16);
            *(LAS unsigned*)(dst + (ch * 8 + j) * 272 + 4 * i) = lo | hi; } }
}
__device__ __forceinline__ void lds_copy128(const bf16* src, int pitch, LAS unsigned char* dst, int tid) {
#pragma unroll
    for (int rep = 0; rep < 4; ++rep) { const int it = tid + 512 * rep, r = it >> 4, ch = it & 15; *(LAS v4u*)(dst + r * 272 + ch * 16) = *(const v4u*)(src + (size_t)r * pitch + ch * 8); }
}
__device__ __forceinline__ bf16x8 scale8(v4u x, f32x4 w0, f32x4 w1) {
    v4u o; o.x = pk2(bflo(x.x) * w0.x, bfhi(x.x) * w0.y); o.y = pk2(bflo(x.y) * w0.z, bfhi(x.y) * w0.w); o.z = pk2(bflo(x.z) * w1.x, bfhi(x.z) * w1.y); o.w = pk2(bflo(x.w) * w1.z, bfhi(x.w) * w1.w);
    return __builtin_bit_cast(bf16x8, o);
}
__device__ __forceinline__ bf16x8 scale8s(v4u x, float w) {
    v4u o; o.x = pk2(bflo(x.x) * w, bfhi(x.x) * w); o.y = pk2(bflo(x.y) * w, bfhi(x.y) * w); o.z = pk2(bflo(x.z) * w, bfhi(x.z) * w); o.w = pk2(bflo(x.w) * w, bfhi(x.w) * w);
    return __builtin_bit_cast(bf16x8, o);
}

__device__ __forceinline__ void ssdA_load(const bf16* XBC, const float* DT, const float* CS, int u, int tid, v4u (&pb)[2][2], v4u (&px)[4][2], float (&pw)[2][3]) {
    const int c = u >> 2, g = (u >> 1) & 1, hh = u & 1, h0 = 8 * g + 4 * hh; const size_t tok0 = (size_t)c * 128;
#pragma unroll
    for (int rep = 0; rep < 2; ++rep) { const int it = tid + 512 * rep, i = it & 63, ch = it >> 6; const bf16* p = XBC + (tok0 + 2 * i) * 1536 + 1024 + g * 128 + ch * 8; pb[rep][0] = *(const v4u*)p; pb[rep][1] = *(const v4u*)(p + 1536); }
#pragma unroll
    for (int rep = 0; rep < 4; ++rep) { const int it = tid + 512 * rep, i = it & 63, ch = it >> 6; const bf16* p = XBC + (tok0 + 2 * i) * 1536 + h0 * 64 + ch * 8; px[rep][0] = *(const v4u*)p; px[rep][1] = *(const v4u*)(p + 1536); }
#pragma unroll
    for (int rep = 0; rep < 2; ++rep) { const int idx = tid + 512 * rep, hd = idx >> 8, dir = (idx >> 7) & 1, s = idx & 127, j = dir * 16 + h0 + hd;
        pw[rep][0] = CS[(tok0 + s) * 32 + j]; pw[rep][1] = CS[(tok0 + (dir ? 0 : 127)) * 32 + j]; pw[rep][2] = DT[(tok0 + s) * 32 + j]; }
}
__device__ __forceinline__ void tr_write(LAS unsigned char* dst, int ch, int i, v4u r0, v4u r1) {
#pragma unroll
    for (int j = 0; j < 8; ++j) { const unsigned a = r0[j >> 1], b = r1[j >> 1]; const unsigned lo = (j & 1) ? (a >> 16) : (a & 0xffffu), hi = (j & 1) ? (b & 0xffff0000u) : (b << 16);
        *(LAS unsigned*)(dst + (ch * 8 + j) * 272 + 4 * i) = lo | hi; }
}
__device__ __forceinline__ void ssd_states(LAS unsigned char* lds, const bf16* XBC, const float* DT, const float* CS, bf16* ST, int vcu, int G, int tid0) {
    const int wave = __builtin_amdgcn_readfirstlane(tid0 >> 6);
    LAS unsigned char* BT = lds; LAS unsigned char* XT = lds + 34816; LAS float* Wv = (LAS float*)(lds + 34816 + 69632);
    v4u pb[2][2], px[4][2]; float pw[2][3];
    if (vcu < 4 * NCHUNK) ssdA_load(XBC, DT, CS, vcu, tid0, pb, px, pw);
    for (int u = vcu; u < 4 * NCHUNK; u += G) {
        int tid = tid0; asm volatile("" : "+v"(tid));
        const int lane = tid & 63, fr = lane & 15, fq = lane >> 4;
        const int c = u >> 2, g = (u >> 1) & 1, hh = u & 1, h0 = 8 * g + 4 * hh;
#pragma unroll
        for (int rep = 0; rep < 2; ++rep) { const int it = tid + 512 * rep; tr_write(BT, it >> 6, it & 63, pb[rep][0], pb[rep][1]); }
#pragma unroll
        for (int rep = 0; rep < 4; ++rep) { const int it = tid + 512 * rep; tr_write(XT, it >> 6, it & 63, px[rep][0], px[rep][1]); }
#pragma unroll
        for (int rep = 0; rep < 2; ++rep) Wv[tid + 512 * rep] = ex2(pw[rep][1] - pw[rep][0]) * pw[rep][2];
        LBAR();
        if (u + G < 4 * NCHUNK) ssdA_load(XBC, DT, CS, u + G, tid, pb, px, pw);
        const int hd = wave >> 1, dir = wave & 1;
        f32x4 acc[8][4];
#pragma unroll
        for (int a = 0; a < 8; ++a)
#pragma unroll
            for (int b = 0; b < 4; ++b) acc[a][b] = (f32x4){0.f, 0.f, 0.f, 0.f};
#pragma unroll 1
        for (int ks = 0; ks < 4; ++ks) {
            const LAS float* wp = Wv + (hd * 2 + dir) * 128 + ks * 32 + fq * 8; const f32x4 w0 = *(const LAS f32x4*)wp, w1 = *(const LAS f32x4*)(wp + 4);
            bf16x8 bfr[4];
#pragma unroll
            for (int pt = 0; pt < 4; ++pt) bfr[pt] = scale8(*(const LAS v4u*)(XT + (hd * 64 + pt * 16 + fr) * 272 + (ks * 32 + fq * 8) * 2), w0, w1);
#pragma unroll
            for (int nt = 0; nt < 8; ++nt) { const bf16x8 a = *(const LAS bf16x8*)(BT + (nt * 16 + fr) * 272 + (ks * 32 + fq * 8) * 2);
#pragma unroll
                for (int pt = 0; pt < 4; ++pt) acc[nt][pt] = mfma16(a, bfr[pt], acc[nt][pt]); }
        }
        bf16* dst = ST + ((size_t)(c * 2 + dir) * 16 + (h0 + hd)) * 8192;
#pragma unroll
        for (int nt = 0; nt < 8; ++nt)
#pragma unroll
            for (int pt = 0; pt < 4; ++pt) { v2u w; w.x = pk2(acc[nt][pt][0], acc[nt][pt][1]); w.y = pk2(acc[nt][pt][2], acc[nt][pt][3]); *(v2u*)(dst + (pt * 16 + fr) * 128 + nt * 16 + fq * 4) = w; }
        LBAR();
    }
}

__device__ __forceinline__ void ssd_pass(bf16* ST, const float* DEC, int gtid, int NT_) {
    for (int it = gtid; it < 18 * 16384; it += NT_) {
        const int sd = it >> 14, v = it & 16383, s = sd >> 1, dir = sd & 1, head = v >> 10;
        const int c0 = s == 0 ? 0 : 128 + (s - 1) * 64, nc = s == 0 ? 128 : 64;
        float h[8];
#pragma unroll
        for (int k = 0; k < 8; ++k) h[k] = 0.f;
        for (int i = 0; i < nc; i += 8) {
            v4u sv[8]; float d[8]; bf16* pp[8];
#pragma unroll
            for (int q = 0; q < 8; ++q) { const int c = dir ? (c0 + nc - 1 - (i + q)) : (c0 + i + q); pp[q] = ST + ((size_t)(c * 2 + dir) * 16) * 8192 + (size_t)v * 8; sv[q] = *(const v4u*)pp[q]; d[q] = DEC[c * 32 + dir * 16 + head]; }
#pragma unroll
            for (int q = 0; q < 8; ++q) { v4u o; o.x = pk2(h[0], h[1]); o.y = pk2(h[2], h[3]); o.z = pk2(h[4], h[5]); o.w = pk2(h[6], h[7]); *(v4u*)pp[q] = o;
                h[0] = d[q] * h[0] + bflo(sv[q].x); h[1] = d[q] * h[1] + bfhi(sv[q].x); h[2] = d[q] * h[2] + bflo(sv[q].y); h[3] = d[q] * h[3] + bfhi(sv[q].y);
                h[4] = d[q] * h[4] + bflo(sv[q].z); h[5] = d[q] * h[5] + bfhi(sv[q].z); h[6] = d[q] * h[6] + bflo(sv[q].w); h[7] = d[q] * h[7] + bfhi(sv[q].w); }
        }
    }
}

__device__ __forceinline__ void ssd_out(LAS unsigned char* lds, const bf16* XBC, const float* DT, const float* CS, const bf16* ST, bf16* PROJ, const float* dskip, float* SSQS, int vcu, int G, int tid0) {
    const int wave = __builtin_amdgcn_readfirstlane(tid0 >> 6);
    LAS unsigned char* Cm = lds; LAS unsigned char* CBm = lds + 34816; LAS unsigned char* XT = lds + 69632; LAS float* Vv = (LAS float*)(lds + 69632 + 69632);
    for (int u = vcu; u < 4 * NCHUNK; u += G) {
        int tid = tid0; asm volatile("" : "+v"(tid));
        const int c = u >> 2, g = (u >> 1) & 1, hh = u & 1, h0 = 8 * g + 4 * hh; const size_t tok0 = (size_t)c * 128;
        v4u pc[4], pbn[4]; float pv[4];
#pragma unroll
        for (int rep = 0; rep < 4; ++rep) { const int it = tid + 512 * rep, r = it >> 4, ch = it & 15; const bf16* p = XBC + (tok0 + r) * 1536 + 1024 + g * 128 + ch * 8; pbn[rep] = *(const v4u*)p; pc[rep] = *(const v4u*)(p + 256); }
#pragma unroll
        for (int rep = 0; rep < 4; ++rep) { const int idx = tid + 512 * rep, hd = idx >> 9, kind = (idx >> 7) & 3, s = idx & 127, j = (kind & 1) * 16 + h0 + hd; pv[rep] = (kind < 2 ? CS : DT)[(tok0 + s) * 32 + j]; }
#pragma unroll
        for (int rep = 0; rep < 4; ++rep) { const int it = tid + 512 * rep, r = it >> 4, ch = it & 15; *(LAS v4u*)(Cm + r * 272 + ch * 16) = pc[rep]; *(LAS v4u*)(XT + r * 272 + ch * 16) = pbn[rep]; Vv[it] = pv[rep]; }
        LBAR();
        asm volatile("" : "+v"(tid));
        int lane = tid & 63, fr = lane & 15, fq = lane >> 4;
        {
            f32x4 cb[8];
#pragma unroll
            for (int st = 0; st < 8; ++st) cb[st] = (f32x4){0.f, 0.f, 0.f, 0.f};
#pragma unroll
            for (int ks = 0; ks < 4; ++ks) { const bf16x8 cf = *(const LAS bf16x8*)(Cm + (wave * 16 + fr) * 272 + (ks * 32 + fq * 8) * 2);
#pragma unroll
                for (int st = 0; st < 8; ++st) { const bf16x8 bfg = *(const LAS bf16x8*)(XT + (st * 16 + fr) * 272 + (ks * 32 + fq * 8) * 2); cb[st] = mfma16(bfg, cf, cb[st]); } }
#pragma unroll
            for (int st = 0; st < 8; ++st) { v2u w; w.x = pk2(cb[st][0], cb[st][1]); w.y = pk2(cb[st][2], cb[st][3]); *(LAS v2u*)(CBm + (wave * 16 + fr) * 272 + (st * 16 + fq * 4) * 2) = w; }
        }
        LBAR();
        asm volatile("" : "+v"(tid));
#pragma unroll
        for (int rep = 0; rep < 4; ++rep) { const int it = tid + 512 * rep, i = it & 63, ch = it >> 6; const bf16* p = XBC + (tok0 + 2 * i) * 1536 + h0 * 64 + ch * 8; tr_write(XT, ch, i, *(const v4u*)p, *(const v4u*)(p + 1536)); }
        LBAR();
        asm volatile("" : "+v"(tid)); lane = tid & 63; fr = lane & 15; fq = lane >> 4;
        const int hd = wave >> 1, lh = wave & 1, h = h0 + hd;
        const LAS float* csf = Vv + hd * 512, *csb = csf + 128, *dtf = csf + 256, *dtb = csf + 384;
        bf16x8 hf[4][4], hbk[4][4];
        f32x4 acc[4][4];
#pragma unroll
        for (int a = 0; a < 4; ++a)
#pragma unroll
            for (int b = 0; b < 4; ++b) acc[a][b] = (f32x4){0.f, 0.f, 0.f, 0.f};
        float csf_l[4], csb_l[4];
#pragma unroll
        for (int lt = 0; lt < 4; ++lt) { const int l = 16 * (4 * lh + lt) + fr; csf_l[lt] = csf[l]; csb_l[lt] = csb[l]; }
#pragma unroll 1
        for (int ks = 0; ks < 4; ++ks) {
            bf16x8 xb[4];
#pragma unroll
            for (int pt = 0; pt < 4; ++pt) xb[pt] = *(const LAS bf16x8*)(XT + (hd * 64 + pt * 16 + fr) * 272 + (ks * 32 + fq * 8) * 2);
            const int s0 = ks * 32 + fq * 8;
            const f32x4 sf0 = *(const LAS f32x4*)(csf + s0), sf1 = *(const LAS f32x4*)(csf + s0 + 4), sb0 = *(const LAS f32x4*)(csb + s0), sb1 = *(const LAS f32x4*)(csb + s0 + 4);
            const f32x4 df0 = *(const LAS f32x4*)(dtf + s0), df1 = *(const LAS f32x4*)(dtf + s0 + 4), db0 = *(const LAS f32x4*)(dtb + s0), db1 = *(const LAS f32x4*)(dtb + s0 + 4);
#pragma unroll
            for (int lt = 0; lt < 4; ++lt) { const int l = 16 * (4 * lh + lt) + fr;
                const v4u cbw = *(const LAS v4u*)(CBm + l * 272 + s0 * 2); float m[8];
                const int Lt = 4 * lh + lt; const bool allf = (32 * ks + 31 < 16 * Lt), allb = (32 * ks > 16 * Lt + 15);
                if (allf) {
#pragma unroll
                    for (int j = 0; j < 8; ++j) { const float sfj = j < 4 ? sf0[j & 3] : sf1[j & 3], dfj = j < 4 ? df0[j & 3] : df1[j & 3]; const unsigned cw = cbw[j >> 1]; m[j] = ((j & 1) ? bfhi(cw) : bflo(cw)) * (ex2(csf_l[lt] - sfj) * dfj); }
                } else if (allb) {
#pragma unroll
                    for (int j = 0; j < 8; ++j) { const float sbj = j < 4 ? sb0[j & 3] : sb1[j & 3], dbj = j < 4 ? db0[j & 3] : db1[j & 3]; const unsigned cw = cbw[j >> 1]; m[j] = ((j & 1) ? bfhi(cw) : bflo(cw)) * (ex2(csb_l[lt] - sbj) * dbj); }
                } else {
#pragma unroll
                    for (int j = 0; j < 8; ++j) { const int s = s0 + j; const float sfj = j < 4 ? sf0[j & 3] : sf1[j & 3], sbj = j < 4 ? sb0[j & 3] : sb1[j & 3], dfj = j < 4 ? df0[j & 3] : df1[j & 3], dbj = j < 4 ? db0[j & 3] : db1[j & 3];
                        const float mf = (s <= l) ? ex2(csf_l[lt] - sfj) * dfj : 0.f, mb = (s >= l) ? ex2(csb_l[lt] - sbj) * dbj : 0.f;
                        const unsigned cw = cbw[j >> 1]; m[j] = ((j & 1) ? bfhi(cw) : bflo(cw)) * (mf + mb); }
                }
                v4u mw; mw.x = pk2(m[0], m[1]); mw.y = pk2(m[2], m[3]); mw.z = pk2(m[4], m[5]); mw.w = pk2(m[6], m[7]); const bf16x8 a = __builtin_bit_cast(bf16x8, mw);
#pragma unroll
                for (int pt = 0; pt < 4; ++pt) acc[lt][pt] = mfma16(a, xb[pt], acc[lt][pt]); }
        }
        { const bf16* Hp = ST + ((size_t)(c * 2 + 0) * 16 + h) * 8192 + fr * 128 + fq * 8;
#pragma unroll
          for (int ks = 0; ks < 4; ++ks)
#pragma unroll
            for (int pt = 0; pt < 4; ++pt) hf[ks][pt] = *(const bf16x8*)(Hp + pt * 2048 + ks * 32); }
        { float e_l[4];
#pragma unroll
          for (int lt = 0; lt < 4; ++lt) e_l[lt] = ex2(csf_l[lt]);
#pragma unroll
          for (int ks = 0; ks < 4; ++ks) {
#pragma unroll
            for (int lt = 0; lt < 4; ++lt) { const int l = 16 * (4 * lh + lt) + fr; const bf16x8 a = scale8s(*(const LAS v4u*)(Cm + l * 272 + (ks * 32 + fq * 8) * 2), e_l[lt]);
#pragma unroll
                for (int pt = 0; pt < 4; ++pt) acc[lt][pt] = mfma16(a, hf[ks][pt], acc[lt][pt]); }
            __builtin_amdgcn_sched_barrier(0);
            if (ks >= 1 && ks <= 2) {
                const bf16* Hp = ST + ((size_t)(c * 2 + 1) * 16 + h) * 8192 + fr * 128 + fq * 8;
#pragma unroll
                for (int k2 = 2 * (ks - 1); k2 < 2 * (ks - 1) + 2; ++k2)
#pragma unroll
                    for (int pt = 0; pt < 4; ++pt) hbk[k2][pt] = *(const bf16x8*)(Hp + pt * 2048 + k2 * 32);
                __builtin_amdgcn_sched_barrier(0); } } }
        { float e_l[4];
#pragma unroll
          for (int lt = 0; lt < 4; ++lt) e_l[lt] = ex2(csb_l[lt]);
#pragma unroll
          for (int ks = 0; ks < 4; ++ks) {
#pragma unroll
            for (int lt = 0; lt < 4; ++lt) { const int l = 16 * (4 * lh + lt) + fr; const bf16x8 a = scale8s(*(const LAS v4u*)(Cm + l * 272 + (ks * 32 + fq * 8) * 2), e_l[lt]);
#pragma unroll
                for (int pt = 0; pt < 4; ++pt) acc[lt][pt] = mfma16(a, hbk[ks][pt], acc[lt][pt]); }
            __builtin_amdgcn_sched_barrier(0);
 } }
        LBAR();
        LAS unsigned char* ZT = lds;
#pragma unroll
        for (int rep = 0; rep < 8; ++rep) { const int it = tid + 512 * rep, r = it >> 5, ch = it & 31; *(LAS v4u*)(ZT + r * 528 + ch * 16) = *(const v4u*)(PROJ + (tok0 + r) * PP + h0 * 64 + ch * 8); }
        LBAR();
        asm volatile("" : "+v"(tid)); lane = tid & 63; fr = lane & 15; fq = lane >> 4;
        const float dsk = dskip[h];
#pragma unroll
        for (int lt = 0; lt < 4; ++lt) {
#pragma unroll
            for (int pt = 0; pt < 4; ++pt) { const int lb = 16 * (4 * lh + lt) + 4 * fq, p = pt * 16 + fr;
                const v2u xw = *(const LAS v2u*)(XT + (hd * 64 + p) * 272 + lb * 2); const float xv[4] = {bflo(xw.x), bfhi(xw.x), bflo(xw.y), bfhi(xw.y)};
#pragma unroll
                for (int r = 0; r < 4; ++r) { LAS bf16* zp = (LAS bf16*)(ZT + (lb + r) * 528 + (hd * 64 + p) * 2); const float z = bf1(*zp); const float y = (acc[lt][pt][r] + xv[r] * dsk) * z * __builtin_amdgcn_rcpf(1.f + ex2(-z * LOG2E)); *zp = (bf16)f2bf(y); } }
            __builtin_amdgcn_sched_barrier(0); }
        LBAR();
#pragma unroll
        for (int rep = 0; rep < 8; ++rep) { const int it = tid + 512 * rep, r = it >> 5, ch = it & 31; const v4u yv = *(const LAS v4u*)(ZT + r * 528 + ch * 16); *(v4u*)(PROJ + (tok0 + r) * PP + h0 * 64 + ch * 8) = yv;
            float q = (bflo(yv.x) * bflo(yv.x) + bfhi(yv.x) * bfhi(yv.x)) + (bflo(yv.y) * bflo(yv.y) + bfhi(yv.y) * bfhi(yv.y)) + (bflo(yv.z) * bflo(yv.z) + bfhi(yv.z) * bfhi(yv.z)) + (bflo(yv.w) * bflo(yv.w) + bfhi(yv.w) * bfhi(yv.w));
            q += __shfl_xor(q, 1); q += __shfl_xor(q, 2); q += __shfl_xor(q, 4); q += __shfl_xor(q, 8); q += __shfl_xor(q, 16);
            if (ch == 0) SSQS[(tok0 + r) * 4 + g * 2 + hh] = q; }
        LBAR();
    }
}

__device__ __forceinline__ void xa_scores(const LAS unsigned char* Kl, const bf16* qrow, int fr, int fq, v4u (&pa)[8], float& sum) {
    bf16x8 qf[4];
#pragma unroll
    for (int ks = 0; ks < 4; ++ks) qf[ks] = *(const bf16x8*)(qrow + 32 * ks);
    f32x4 s[16];
#pragma unroll
    for (int mt = 0; mt < 16; ++mt) { s[mt] = (f32x4){0.f, 0.f, 0.f, 0.f};
#pragma unroll
        for (int ks = 0; ks < 4; ++ks) s[mt] = mfma16(*(const LAS bf16x8*)(Kl + (mt * 16 + fr) * 272 + (ks * 32 + fq * 8) * 2), qf[ks], s[mt]);
        if (mt & 1) __builtin_amdgcn_sched_barrier(0); }
    float mx = -3.0e38f;
#pragma unroll
    for (int mt = 0; mt < 16; ++mt) mx = fmaxf(fmaxf(mx, fmaxf(s[mt][0], s[mt][1])), fmaxf(s[mt][2], s[mt][3]));
    mx = fmaxf(mx, __shfl_xor(mx, 16)); mx = fmaxf(mx, __shfl_xor(mx, 32));
    float sm = 0.f;
#pragma unroll
    for (int mt = 0; mt < 16; ++mt)
#pragma unroll
        for (int r = 0; r < 4; ++r) { const float e = ex2(s[mt][r] - mx); s[mt][r] = e; sm += e; }
    sm += __shfl_xor(sm, 16); sm += __shfl_xor(sm, 32); sum = sm;
#pragma unroll
    for (int kk = 0; kk < 8; ++kk) { v4u pw; pw.x = pk2(s[2 * kk][0], s[2 * kk][1]); pw.y = pk2(s[2 * kk][2], s[2 * kk][3]); pw.z = pk2(s[2 * kk + 1][0], s[2 * kk + 1][1]); pw.w = pk2(s[2 * kk + 1][2], s[2 * kk + 1][3]); pa[kk] = pw; }
    __builtin_amdgcn_sched_barrier(0);
}
__device__ __forceinline__ void xattn(LAS unsigned char* lds, const bf16* Q2, const bf16* MKV, bf16* CA, int vcu, int G, int tid0) {
    const int wave = __builtin_amdgcn_readfirstlane(tid0 >> 6);
    LAS unsigned char* Kl = lds; LAS unsigned char* VT = lds + 69632;
    const int per = (1280 + G - 1) / G; int loaded = -1;
    const int u1 = (vcu + 1) * per < 1280 ? (vcu + 1) * per : 1280;
    for (int u = vcu * per; u < u1; ++u) {
        int tid = tid0; asm volatile("" : "+v"(tid));
        const int lane = tid & 63, fr = lane & 15, fq = lane >> 4;
        int seq, head, tile;
        if (u < 256) { seq = 0; head = u >> 6; tile = u & 63; } else { const int u2 = u - 256, pr = u2 >> 5; seq = 1 + (pr >> 2); head = pr & 3; tile = u2 & 31; }
        const int key = seq * 4 + head;
        if (key != loaded) {
            __syncthreads();
            const bf16* Kg = MKV + (size_t)(seq * 256) * 1024 + head * 128; const bf16* Vg = Kg + 512;
#pragma unroll
            for (int rep = 0; rep < 8; ++rep) { const int it = tid + 512 * rep, m = it >> 4, ch = it & 15; *(LAS v4u*)(Kl + m * 272 + ch * 16) = *(const v4u*)(Kg + (size_t)m * 1024 + ch * 8); }
#pragma unroll
            for (int rep = 0; rep < 4; ++rep) { const int it = tid + 512 * rep, i = it & 127, ch = it >> 7;
                const bf16* p = Vg + (size_t)(2 * i) * 1024 + ch * 8; const v4u r0 = *(const v4u*)p, r1 = *(const v4u*)(p + 1024);
#pragma unroll
                for (int j = 0; j < 8; ++j) { const unsigned a = r0[j >> 1], b = r1[j >> 1]; const unsigned lo = (j & 1) ? (a >> 16) : (a & 0xffffu), hi = (j & 1) ? (b & 0xffff0000u) : (b << 16);
                    *(LAS unsigned*)(VT + (ch * 8 + j) * 528 + 4 * i) = lo | hi; } }
            __syncthreads(); loaded = key;
        }
        const int tokb = (seq == 0 ? 0 : 16384 + (seq - 1) * 8192) + tile * 256 + wave * 32;
        v4u pa[2][8]; float sum[2];
#pragma unroll
        for (int itr = 0; itr < 2; ++itr) xa_scores(Kl, Q2 + (size_t)(tokb + 16 * itr + fr) * 512 + head * 128 + fq * 8, fr, fq, pa[itr], sum[itr]);
        f32x4 o[2][8];
#pragma unroll
        for (int itr = 0; itr < 2; ++itr)
#pragma unroll
            for (int dt = 0; dt < 8; ++dt) o[itr][dt] = (f32x4){0.f, 0.f, 0.f, 0.f};
#pragma unroll
        for (int kk = 0; kk < 8; ++kk) {
#pragma unroll
            for (int dt = 0; dt < 8; ++dt) { const LAS unsigned char* vp = VT + (dt * 16 + fr) * 528 + (kk * 32 + fq * 4) * 2; const v2u lo = *(const LAS v2u*)vp, hi = *(const LAS v2u*)(vp + 32);
                v4u vw; vw.x = lo.x; vw.y = lo.y; vw.z = hi.x; vw.w = hi.y; const bf16x8 vb = __builtin_bit_cast(bf16x8, vw);
                o[0][dt] = mfma16(vb, __builtin_bit_cast(bf16x8, pa[0][kk]), o[0][dt]); o[1][dt] = mfma16(vb, __builtin_bit_cast(bf16x8, pa[1][kk]), o[1][dt]); }
            __builtin_amdgcn_sched_barrier(0);
        }
#pragma unroll
        for (int itr = 0; itr < 2; ++itr) { const int l0 = tokb + 16 * itr; const float inv = 1.0f / sum[itr]; bf16* cp = CA + (size_t)(l0 + fr) * 512 + head * 128 + fq * 4;
#pragma unroll
            for (int dt = 0; dt < 8; ++dt) { v2u w; w.x = pk2(o[itr][dt][0] * inv, o[itr][dt][1] * inv); w.y = pk2(o[itr][dt][2] * inv, o[itr][dt][3] * inv); *(v2u*)(cp + dt * 16) = w; } }
    }
}

typedef __attribute__((address_space(1))) unsigned gu32;
#define RLX_AGENT __ATOMIC_RELAXED, __HIP_MEMORY_SCOPE_AGENT
#define XB_TMO      128
#define XB_XCNT(j)  (256  + 64 * (j))
#define XB_XSUB(j)  (1280 + 64 * (j))
#define XB_XGEN(j)  (2304 + 64 * (j))
#define XB_TOP      3328
#define XB_TOPGEN   3392
#define XCD_BAR_WORDS 3456
#define XB_SPIN_CAP (1u << 18)

__device__ __forceinline__ unsigned xb_ld(unsigned* p)              { return __hip_atomic_load(p, __ATOMIC_RELAXED, __HIP_MEMORY_SCOPE_AGENT); }
__device__ __forceinline__ unsigned xb_add(unsigned* p, unsigned v) { return __hip_atomic_fetch_add(p, v, __ATOMIC_RELAXED, __HIP_MEMORY_SCOPE_AGENT); }
__device__ __forceinline__ unsigned xb_xcc_id() { return (unsigned)__builtin_amdgcn_s_getreg((3 << 11) | 20) & 0xFu; }
#define XB_SPIN(cond, bar) do { unsigned _sp = 0; while (cond) { __builtin_amdgcn_s_sleep(1); \
    if ((++_sp & 255u) == 0u) { if (xb_ld(&(bar)[XB_TMO])) break; if (_sp > XB_SPIN_CAP) { atomicAdd(&(bar)[XB_TMO], 1u); break; } } } } while (0)

struct XcdBarrier {
    unsigned* bar; unsigned x;
    volatile LAS unsigned* st;
};

__device__ __forceinline__ XcdBarrier xcd_barrier_post(unsigned* bar, volatile LAS unsigned* st) {
    XcdBarrier b; b.bar = bar; b.x = xb_xcc_id(); b.st = st;
    if (threadIdx.x == 0) (void)xb_add(&bar[XB_XCNT(b.x)], 1u);
    return b;
}
__device__ __forceinline__ void xcd_barrier_complete(unsigned* bar, unsigned x, unsigned& nloc, unsigned& nx) {
    const unsigned G = gridDim.x * gridDim.y * gridDim.z;
    unsigned sum, cnt, mine, sp = 0u;
    for (;;) {
        sum = 0u; cnt = 0u; mine = 0u;
#pragma unroll
        for (unsigned j = 0; j < 16; ++j) { const unsigned c = xb_ld(&bar[XB_XCNT(j)]); sum += c; cnt += (c > 0u) ? 1u : 0u; mine = (j == x) ? c : mine; }
        if (sum == G) break;
        __builtin_amdgcn_s_sleep(1);
        if ((++sp & 255u) == 0u) { if (xb_ld(&bar[XB_TMO])) break; if (sp > XB_SPIN_CAP) { atomicAdd(&bar[XB_TMO], 1u); break; } }
    }
    nloc = mine > 0u ? mine : 1u; nx = cnt > 0u ? cnt : 1u;
}

__device__ __forceinline__ void xcd_barrier(const XcdBarrier& b) {
    asm volatile("s_waitcnt vmcnt(0)" ::: "memory");
    __syncthreads();
    if (threadIdx.x == 0) {
        unsigned* bar = b.bar;
        __builtin_amdgcn_s_waitcnt(0);
        unsigned nloc = b.st[0], nx = b.st[1];
        if (nloc == 0u) { xcd_barrier_complete(bar, b.x, nloc, nx); b.st[0] = nloc; b.st[1] = nx; }
        const unsigned old = xb_add(&bar[XB_XSUB(b.x)], 1u);
        const unsigned gen = old / nloc;
        if (old + 1u == (gen + 1u) * nloc) {
            __builtin_amdgcn_fence(__ATOMIC_RELEASE, "agent");
            asm volatile("s_waitcnt vmcnt(0)" ::: "memory");
            const unsigned og = xb_add(&bar[XB_TOP], 1u);
            const unsigned tg = og / nx;
            if (og + 1u == (tg + 1u) * nx) xb_add(&bar[XB_TOPGEN], 1u);
            else XB_SPIN(xb_ld(&bar[XB_TOPGEN]) == tg, bar);
            __builtin_amdgcn_fence(__ATOMIC_ACQUIRE, "agent");
            xb_add(&bar[XB_XGEN(b.x)], 1u);
            asm volatile("s_waitcnt vmcnt(0)" ::: "memory");
        } else {
            XB_SPIN(xb_ld(&bar[XB_XGEN(b.x)]) == gen, bar);
            __builtin_amdgcn_fence(__ATOMIC_ACQUIRE, "agent");
            asm volatile("s_waitcnt vmcnt(0)" ::: "memory");
        }
    }
    __syncthreads();
}


struct Args { const float* in[29]; float* out; unsigned char* ws; };
__global__ void __launch_bounds__(512, 2) hymba_fwd(Args args) {
    extern __shared__ __attribute__((aligned(16))) unsigned char lds_raw[];
    cg::grid_group grid = cg::this_grid();
    LAS unsigned char* lds = (LAS unsigned char*)lds_raw;
    const int wave = __builtin_amdgcn_readfirstlane((int)threadIdx.x >> 6);
    const int G = gridDim.x; const int bx = blockIdx.x; const int vcu = (G % 8 == 0) ? (bx % 8) * (G / 8) + bx / 8 : bx;
    const int gw = vcu * 8 + wave, NGW = G * 8, NTH = G * 512;
#define PH_VARS int tid = threadIdx.x; asm volatile("" : "+v"(tid)); const int lane = tid & 63; const int gtid = vcu * 512 + tid; (void)lane; (void)gtid;
    unsigned char* ws = args.ws;
    const float* xp = args.in[0]; const float* xs = args.in[1];
    bf16* WIN = (bf16*)(ws + WS_WIN); bf16* WOUT = (bf16*)(ws + WS_WOUT); bf16* WXQ = (bf16*)(ws + WS_WXQ); bf16* WXKV = (bf16*)(ws + WS_WXKV); bf16* WXO = (bf16*)(ws + WS_WXO);
    bf16* WGU = (bf16*)(ws + WS_WGU); bf16* WD = (bf16*)(ws + WS_WD); bf16* MEMN = (bf16*)(ws + WS_MEMN); bf16* MKV = (bf16*)(ws + WS_MKV); bf16* XN = (bf16*)(ws + WS_XN);
    float* DT = (float*)(ws + WS_DT); float* CS = (float*)(ws + WS_CS); float* DEC = (float*)(ws + WS_DEC); float* TAB = (float*)(ws + WS_TAB); bf16* KC_ = (bf16*)(ws + WS_KC); bf16* VC_ = (bf16*)(ws + WS_VC); float* SSQS = (float*)(ws + WS_SSQS); float* RS1 = (float*)(ws + 64 * 1024); float* RS2 = (float*)(ws + 528 * 1024);   float* SSQA = (float*)(ws + WS_SSQA);
    bf16* PROJ = (bf16*)(ws + WS_PROJ); bf16* Q2 = (bf16*)(ws + WS_Q2); bf16* CA = (bf16*)(ws + WS_CA); bf16* HID = (bf16*)(ws + WS_HID); bf16* XBC = (bf16*)(ws + WS_XBC); bf16* RAW = (bf16*)(ws + WS_RAW);
    bf16* X1B = (bf16*)args.out; bf16* X2B0 = (bf16*)(ws + WS_X2B0); bf16* X2B1 = (bf16*)(ws + WS_X2B1);
    bf16* ST = (bf16*)args.out;
    volatile LAS unsigned* bst = (volatile LAS unsigned*)(lds + LDS_BYTES - 16);
    if (threadIdx.x < 4) bst[threadIdx.x] = 0u;
    __syncthreads();
    if (blockIdx.x == 0) for (int i = threadIdx.x; i < XCD_BAR_WORDS; i += 512) ((unsigned*)(ws + WS_BAR))[i] = 0u;
    XcdBarrier xbar; xbar.bar = (unsigned*)(ws + WS_BAR); xbar.x = 0; xbar.st = bst;
#define GRID_BAR() xcd_barrier(xbar)

#if (PHMASK >> 0) & 1
    { PH_VARS
    {
        LAS float* scr = (LAS float*)(lds + wave * 16384);
        for (int it = gw; it < 7696; it += NGW) {
            int r = it;
#define TRY(W_, pitch_, Krows_, col0_, ncols_, WT_, drow0_, mode_) { const int nb_ = (ncols_) / 32, cnt_ = ((Krows_) / 64) * nb_; if (r < cnt_) { const int kb = r / nb_, n0 = (r % nb_) * 32; \
                const int dr = (mode_) ? (drow0_) + 256 * (n0 / 128) + (n0 % 128) : (drow0_) + n0; tr_item(W_, pitch_, kb * 64, (col0_) + n0, WT_, Krows_, dr, scr, lane); continue; } r -= cnt_; }
            TRY(args.in[5], 3360, 1024, 0, 1024, WIN, 0, 0)
            TRY(args.in[5], 3360, 1024, 1024, 1536, WIN, XC, 0)
            TRY(args.in[5], 3360, 1024, 2560, 32, WIN, DTC, 0)
            TRY(args.in[5], 3360, 1024, 2592, 512, WIN, QC, 0)
            TRY(args.in[5], 3360, 1024, 3104, 128, WIN, KC, 0)
            TRY(args.in[5], 3360, 1024, 3232, 128, WIN, VC, 0)
            { const int nb_ = 32, cnt_ = 24 * nb_; if (r < cnt_) { const int kb = r / nb_, n0 = (r % nb_) * 32; const float* gk = kb < 16 ? args.in[11] + kb * 64 : args.in[14] + (kb - 16) * 64;
                tr_item(args.in[15], 1024, kb * 64, n0, WOUT, 1536, n0, scr, lane, gk); continue; } r -= cnt_; }
            { const int nb_ = 16, cnt_ = 16 * nb_; if (r < cnt_) { const int kb = r / nb_, n0 = (r % nb_) * 32; tr_item(args.in[19], 512, kb * 64, n0, WXQ, 1024, n0, scr, lane, args.in[17] + kb * 64); continue; } r -= cnt_; }
            TRY(args.in[20], 512, 1024, 0, 512, WXKV, 0, 0)
            TRY(args.in[21], 512, 1024, 0, 512, WXKV, 512, 0)
            TRY(args.in[22], 1024, 512, 0, 1024, WXO, 0, 0)
            { const int nb_ = 88, cnt_ = 16 * nb_; if (r < cnt_) { const int kb = r / nb_, n0 = (r % nb_) * 32; tr_item(args.in[25], 2816, kb * 64, n0, WGU, 1024, 256 * (n0 / 128) + (n0 % 128), scr, lane, args.in[24] + kb * 64); continue; } r -= cnt_; }
            { const int nb_ = 88, cnt_ = 16 * nb_; if (r < cnt_) { const int kb = r / nb_, n0 = (r % nb_) * 32; tr_item(args.in[26], 2816, kb * 64, n0, WGU, 1024, 128 + 256 * (n0 / 128) + (n0 % 128), scr, lane, args.in[24] + kb * 64); continue; } r -= cnt_; }
            TRY(args.in[27], 1024, 2816, 0, 1024, WD, 0, 0)
#undef TRY
        }
        for (int i = gtid; i < 224 * 1024 / 8; i += NTH) ((v4u*)(WIN + (size_t)3360 * 1024))[i] = (v4u){0u, 0u, 0u, 0u};
        for (int i = gtid; i < 320 * 16; i += NTH) { const int pos = i >> 4, f = i & 15; const double m4 = (f & 3) == 0 ? 1.0 : (f & 3) == 1 ? 0.56234132519034908 : (f & 3) == 2 ? 0.31622776601683794 : 0.17782794100389228;
            const double e4 = (f >> 2) == 0 ? 1.0 : (f >> 2) == 1 ? 0.1 : (f >> 2) == 2 ? 0.01 : 0.001; const double pv = (double)(pos < 256 ? pos : pos - 256);
            double rev = pv * (m4 * e4) * 0.15915494309189535; rev -= floor(rev); const float rf = (float)rev;
            TAB[2 * i] = __builtin_amdgcn_cosf(rf); TAB[2 * i + 1] = __builtin_amdgcn_sinf(rf); }
        norm_rows<4>(xp, xs, nullptr, nullptr, nullptr, nullptr, nullptr, nullptr, nullptr, args.in[4], XN, nullptr, gw, NGW, lane);
        for (int t = gw; t < 2304; t += NGW) {
            const float* base = t < 256 ? args.in[2] + (size_t)t * 1024 : args.in[3] + (size_t)(t - 256) * 1024; f32x4 v[4]; float s2 = 0.f;
#pragma unroll
            for (int j = 0; j < 4; ++j) { v[j] = ((const f32x4*)base)[lane + 64 * j]; s2 += (v[j].x * v[j].x + v[j].y * v[j].y) + (v[j].z * v[j].z + v[j].w * v[j].w); }
            const float rstd = 1.0f / sqrtf(wave_sum(s2) * (1.f / 1024.f) + EPSN);
#pragma unroll
            for (int j = 0; j < 4; ++j) { const f32x4 g = ((const f32x4*)args.in[18])[lane + 64 * j]; const f32x4 o = v[j] * rstd * g; v2u w; w.x = pk2(o.x, o.y); w.y = pk2(o.z, o.w); *(v2u*)(MEMN + (size_t)t * 1024 + 4 * (lane + 64 * j)) = w; }
        }
    }
    }
#endif
    grid.sync();
    xbar = xcd_barrier_post((unsigned*)(ws + WS_BAR), bst);
#if (PHMASK >> 1) & 1
    { PH_VARS
    {
        pg8::Gemm g{XN, WIN, NTOK, PP, 1024, 1024, 0, 1 << 30}; pg8::StaticOrder S; S.init(NTOK, PP, G, bx); EpiProj E{PROJ, VC_};
        pg8::gemm_phase<EpiProj, pg8::StaticOrder, true, true>(lds, g, S, E);
        pg8::Gemm g2{MEMN, WXKV, 2304, 1024, 1024, 1024, 0, 1 << 30}; pg8::StaticOrder S2; S2.init(2304, 1024, G, (bx + 128) % G); EpiStore E2{MKV, 1024, 1.0f, nullptr};
        pg8::gemm_phase<EpiStore, pg8::StaticOrder, true, true>(lds, g2, S2, E2);
    }
    }
#endif
    GRID_BAR();
#if (PHMASK >> 2) & 1
    { PH_VARS
    {
        const float* conv_w = args.in[6]; const float* conv_b = args.in[7];
        const bool rebal = (NGW == 2048);
        for (int k_ = 0; k_ < 16; ++k_) {
            int item;
            if (k_ < 15) { item = gw + k_ * NGW; if (rebal && gw < 640 && k_ >= 13) continue; }
            else { if (!rebal || gw < 640 || gw >= 1920) continue; const int e_ = gw - 640; item = (e_ % 640) + (13 + e_ / 640) * NGW; }
            if (item >= 30720) continue;
            const int run = item / 3, j = item - run * 3, t0 = run * 8, c0 = (lane + 64 * j) * 8;
            const int s0 = t0 < 16384 ? 0 : 16384 + ((t0 - 16384) >> 13) * 8192, len = t0 < 16384 ? 16384 : 8192, pos0 = t0 - s0;
            v4u rows[12];
#pragma unroll
            for (int i = 0; i < 12; ++i) { const int tt = pos0 + i - 2; rows[i] = (v4u){0u, 0u, 0u, 0u}; if (tt >= 0 && tt < len) rows[i] = *(const v4u*)(PROJ + (size_t)(t0 + i - 2) * PP + XC + c0); }
            f32x4 w[5][2];
#pragma unroll
            for (int dk = 0; dk < 5; ++dk) { w[dk][0] = *(const f32x4*)(conv_w + dk * 1536 + c0); w[dk][1] = *(const f32x4*)(conv_w + dk * 1536 + c0 + 4); }
            const f32x4 b0 = *(const f32x4*)(conv_b + c0), b1 = *(const f32x4*)(conv_b + c0 + 4);
#pragma unroll
            for (int o_ = 0; o_ < 8; ++o_) { float a[8] = {b0.x, b0.y, b0.z, b0.w, b1.x, b1.y, b1.z, b1.w};
#pragma unroll
                for (int dk = 0; dk < 5; ++dk) { const v4u r = rows[o_ + dk]; const f32x4 w0 = w[dk][0], w1 = w[dk][1];
                    a[0] += w0.x * bflo(r.x); a[1] += w0.y * bfhi(r.x); a[2] += w0.z * bflo(r.y); a[3] += w0.w * bfhi(r.y); a[4] += w1.x * bflo(r.z); a[5] += w1.y * bfhi(r.z); a[6] += w1.z * bflo(r.w); a[7] += w1.w * bfhi(r.w); }
#pragma unroll
                for (int k = 0; k < 8; ++k) a[k] = a[k] * __builtin_amdgcn_rcpf(1.f + ex2(-a[k] * LOG2E));
                v4u o; o.x = pk2(a[0], a[1]); o.y = pk2(a[2], a[3]); o.z = pk2(a[4], a[5]); o.w = pk2(a[6], a[7]); *(v4u*)(XBC + (size_t)(t0 + o_) * 1536 + c0) = o; }
        }
        for (int tb = gw * 4; tb < NTOK; tb += NGW * 4) {
            const int s0 = tb < 16384 ? 0 : 16384 + ((tb - 16384) >> 13) * 8192;
            v4u rin[5]; bf16* ptrs[5];
#pragma unroll
            for (int part = 0; part < 5; ++part) { const int t = part < 4 ? tb + part : tb + (lane >> 4); ptrs[part] = PROJ + (size_t)t * PP + (part < 4 ? QC + lane * 8 : KC + (lane & 15) * 8); rin[part] = *(const v4u*)ptrs[part]; }
#pragma unroll
            for (int part = 0; part < 5; ++part) {
                const int t = part < 4 ? tb + part : tb + (lane >> 4), pos = t - s0, prow = pos >> 6, pcol = pos & 63, i = lane & 7;
                const v4u r = rin[part]; float x[8] = {bflo(r.x), bfhi(r.x), bflo(r.y), bfhi(r.y), bflo(r.z), bfhi(r.z), bflo(r.w), bfhi(r.w)};
                float ss = 0.f;
#pragma unroll
                for (int k = 0; k < 8; ++k) ss += x[k] * x[k];
                ss += __shfl_xor(ss, 1); ss += __shfl_xor(ss, 2); ss += __shfl_xor(ss, 4);
                const float rstd = 1.0f / sqrtf(ss * (1.f / 64.f) + EPSN); const float* gn = args.in[part < 4 ? 12 : 13] + i * 8;
                const f32x4 g0 = *(const f32x4*)gn, g1 = *(const f32x4*)(gn + 4); const float gg[8] = {g0.x, g0.y, g0.z, g0.w, g1.x, g1.y, g1.z, g1.w};
                const float* tbp = TAB + ((size_t)((i < 4) ? prow : 256 + pcol) * 16 + 8 * (i & 1)) * 2; const f32x4 t0 = *(const f32x4*)tbp, t1 = *(const f32x4*)(tbp + 4), t2 = *(const f32x4*)(tbp + 8), t3 = *(const f32x4*)(tbp + 12);
                const float cs_[8] = {t0.x, t0.z, t1.x, t1.z, t2.x, t2.z, t3.x, t3.z}, sn_[8] = {t0.y, t0.w, t1.y, t1.w, t2.y, t2.w, t3.y, t3.w};
                const float sc = part < 4 ? 0.125f * LOG2E : 1.0f; float y[8];
#pragma unroll
                for (int k = 0; k < 8; ++k) { const float xv = x[k] * rstd * gg[k]; const float ov = __shfl_xor(xv, 2); y[k] = ((i & 2) ? (xv * cs_[k] + ov * sn_[k]) : (xv * cs_[k] - ov * sn_[k])) * sc; }
                v4u o; o.x = pk2(y[0], y[1]); o.y = pk2(y[2], y[3]); o.z = pk2(y[4], y[5]); o.w = pk2(y[6], y[7]);
                if (part < 4) *(v4u*)ptrs[part] = o;
                else *(v4u*)(KC_ + ((size_t)((lane >> 3) & 1) * NTOK + t) * 64 + i * 8) = o;
            }
        }
        for (int c = gw; c < NCHUNK; c += NGW) {
            const int j = lane & 31, hf = lane >> 5, dir = j >> 4; const float bias = args.in[8][j], al2 = -__expf(args.in[9][j]) * LOG2E; const size_t tok0 = (size_t)c * 128;
            float tot = 0.f;
#pragma unroll 1
            for (int i0 = 0; i0 < 64; i0 += 16) { float dtv[16];
#pragma unroll
                for (int i = 0; i < 16; ++i) { const int o = hf * 64 + i0 + i, tk = dir ? 127 - o : o; dtv[i] = bf1(PROJ[(tok0 + tk) * PP + DTC + j]); }
#pragma unroll
                for (int i = 0; i < 16; ++i) { const float xr = dtv[i] + bias; const float dt = xr > 15.f ? xr : log1pf(__expf(xr)); tot += dt * al2; } }
            const float other = __shfl_xor(tot, 32); float run = hf ? other : 0.f;
#pragma unroll 1
            for (int i0 = 0; i0 < 64; i0 += 16) { float dtv[16];
#pragma unroll
                for (int i = 0; i < 16; ++i) { const int o = hf * 64 + i0 + i, tk = dir ? 127 - o : o; dtv[i] = bf1(PROJ[(tok0 + tk) * PP + DTC + j]); }
#pragma unroll
                for (int i = 0; i < 16; ++i) { const int o = hf * 64 + i0 + i, tk = dir ? 127 - o : o; const float xr = dtv[i] + bias; const float dt = xr > 15.f ? xr : log1pf(__expf(xr)); run += dt * al2;
                    DT[(tok0 + tk) * 32 + j] = dt; CS[(tok0 + tk) * 32 + j] = run; } }
            if (hf == 0) DEC[c * 32 + j] = ex2(tot + other);
        }
    }
    }
#endif
    GRID_BAR();
#if (PHMASK >> 3) & 1
    { PH_VARS
    ssd_states(lds, XBC, DT, CS, ST, vcu, G, tid);
    }
#endif
    GRID_BAR();
#if (PHMASK >> 4) & 1
    { PH_VARS
    ssd_pass(ST, DEC, gtid, NTH);
    {
        const attn_body::AttnTensors AT{(const attn_body::bf16*)(PROJ + QC), (const attn_body::bf16*)KC_, (const attn_body::bf16*)VC_, (attn_body::bf16*)(PROJ + QC), SSQA};
        float mq = fabsf(args.in[12][lane]), mk = fabsf(args.in[13][lane]);
#pragma unroll
        for (int o_ = 1; o_ < 64; o_ <<= 1) { mq = fmaxf(mq, __shfl_xor(mq, o_)); mk = fmaxf(mk, __shfl_xor(mk, o_)); }
        const float bref = 0.125f * LOG2E * 64.f * mq * mk * 1.02f + 0.1f;
        if (bref <= 40.f) attn_body::attn_phase<8, true>(bref, (char*)lds_raw, AT, vcu, G);
        else attn_body::attn_phase<8, false>(0.f, (char*)lds_raw, AT, vcu, G);
    }
    }
#endif
    GRID_BAR();
#if (PHMASK >> 5) & 1
    { PH_VARS
    ssd_out(lds, XBC, DT, CS, ST, PROJ, args.in[10], SSQS, vcu, G, tid);
    }
#endif
    GRID_BAR();
#if (PHMASK >> 7) & 1
    { PH_VARS
    { pg8::Gemm g{PROJ, WOUT, NTOK, 1024, 1536, PP, 0, 1 << 30}; pg8::StaticOrder S; S.init(NTOK, 1024, G, bx);
      LAS float* Rl = (LAS float*)(lds + 131072);
      { pg8::Unit uu; for (int i = 0; i < 5 && S.next(i, uu); ++i) if (tid < 256) { const size_t row = (size_t)uu.pm * 256 + tid;
            const f32x4 sv = *(const f32x4*)(SSQS + row * 4), a0 = *(const f32x4*)(SSQA + row * 8), a1 = *(const f32x4*)(SSQA + row * 8 + 4);
            const float d0 = (sv.x + sv.y) * (1.f / 512.f) + EPSN, d1 = (sv.z + sv.w) * (1.f / 512.f) + EPSN, d2 = (((a0.x + a0.y) + (a0.z + a0.w)) + ((a1.x + a1.y) + (a1.z + a1.w))) * (1.f / 512.f) + EPSN;
            *(LAS f32x4*)(Rl + (size_t)i * 1024 + tid * 4) = (f32x4){sqrtf(d1 / d0), sqrtf(d2 / d1), 1.0f / sqrtf(d2), 0.f}; }
        __syncthreads(); }
      EpiRowScale E{RAW, 1024, Rl}; pg8::gemm_phase<EpiRowScale, pg8::StaticOrder, true, true>(lds, g, S, E); }
    }
#endif
    GRID_BAR();
#if (PHMASK >> 8) & 1
    { PH_VARS
    norm_rows<4>(xp, xs, nullptr, nullptr, RAW, args.in[16], nullptr, X1B, X1B + (size_t)XSPLIT * 1024, nullptr, nullptr, RS1, gw, NGW, lane);
    }
#endif
    GRID_BAR();
#if (PHMASK >> 9) & 1
    { PH_VARS
    { pg8::Gemm g{X1B, WXQ, NTOK, 512, 1024, 1024, 0, 1 << 30}; pg8::StaticOrder S; S.init(NTOK, 512, G, bx); EpiStore E{Q2, 512, 0.08838834764831845f * LOG2E, RS1}; pg8::gemm_phase<EpiStore, pg8::StaticOrder, true, true>(lds, g, S, E); }
    }
#endif
    GRID_BAR();
#if (PHMASK >> 10) & 1
    { PH_VARS
    xattn(lds, Q2, MKV, CA, vcu, G, tid);
    }
#endif
    GRID_BAR();
#if (PHMASK >> 11) & 1
    { PH_VARS
    { pg8::Gemm g{CA, WXO, NTOK, 1024, 512, 512, 0, 1 << 30}; pg8::StaticOrder S; S.init(NTOK, 1024, G, bx); EpiStore E{RAW, 1024, 1.0f, nullptr}; pg8::gemm_phase<EpiStore, pg8::StaticOrder, true, true>(lds, g, S, E); }
    }
#endif
    GRID_BAR();
#if (PHMASK >> 12) & 1
    { PH_VARS
    norm_rows<4>(nullptr, nullptr, X1B, X1B + (size_t)XSPLIT * 1024, RAW, args.in[23], nullptr, X2B0, X2B1, nullptr, nullptr, RS2, gw, NGW, lane);
    }
#endif
    GRID_BAR();
#if (PHMASK >> 13) & 1
    { PH_VARS
    { pg8::Gemm g{X2B0, WGU, NTOK, 5632, 1024, 1024, (long)((const char*)X2B1 - (const char*)X2B0), XSPLIT / 256}; pg8::StaticOrder S; S.init(NTOK, 5632, G, bx); EpiSwiglu E{HID, 2816, RS2}; pg8::gemm_phase<EpiSwiglu, pg8::StaticOrder, true, true>(lds, g, S, E); }
    }
#endif
    GRID_BAR();
#if (PHMASK >> 14) & 1
    { PH_VARS
    { pg8::Gemm g{HID, WD, NTOK, 1024, 2816, 2816, 0, 1 << 30}; pg8::StaticOrder S; S.init(NTOK, 1024, G, bx); EpiStore E{RAW, 1024, 1.0f, nullptr}; pg8::gemm_phase<EpiStore, pg8::StaticOrder, true, true>(lds, g, S, E); }
    }
#endif
    GRID_BAR();
#if (PHMASK >> 15) & 1
    { PH_VARS
    norm_rows<4>(nullptr, nullptr, X2B0, X2B1, RAW, args.in[28], args.out, nullptr, nullptr, nullptr, nullptr, nullptr, gw, NGW, lane);
    }
#endif
}

extern "C" void kernel_launch(void* const* d_in, const int* in_sizes, int n_in, void* d_out, int out_size, void* d_ws, size_t ws_size, hipStream_t stream) {
    static int grid = 0;
    if (grid == 0) {
        if (n_in != 29 || out_size != NTOK * 1024 || ws_size < WS_END) { fprintf(stderr, "kernel_launch: unexpected shapes (n_in %d, out %d, ws %zu)\n", n_in, out_size, ws_size); grid = -1; return; }
        int dev = 0, cus = 0, per_cu = 0;
        if (hipGetDevice(&dev) != hipSuccess || hipDeviceGetAttribute(&cus, hipDeviceAttributeMultiprocessorCount, dev) != hipSuccess) { grid = -1; return; }
        if (hipFuncSetAttribute((const void*)hymba_fwd, hipFuncAttributeMaxDynamicSharedMemorySize, LDS_BYTES) != hipSuccess) { fprintf(stderr, "kernel_launch: hipFuncSetAttribute failed\n"); grid = -1; return; }
        if (hipOccupancyMaxActiveBlocksPerMultiprocessor(&per_cu, (const void*)hymba_fwd, 512, LDS_BYTES) != hipSuccess || per_cu < 1) { fprintf(stderr, "kernel_launch: occupancy query says %d\n", per_cu); per_cu = 1; }
        (void)hipGetLastError();
        grid = cus * (per_cu > 1 ? 1 : per_cu);
    }
    if (grid < 0) return;
    Args a{};
    for (int i = 0; i < 29; ++i) a.in[i] = (const float*)d_in[i];
    a.out = (float*)d_out; a.ws = (unsigned char*)d_ws;
    void* kargs[] = {&a};
    const hipError_t e = hipLaunchCooperativeKernel((const void*)hymba_fwd, dim3(grid), dim3(512), kargs, LDS_BYTES, stream);
    if (e != hipSuccess) fprintf(stderr, "kernel_launch: cooperative launch failed: %s (grid %d)\n", hipGetErrorString(e), grid);
}
```

```cpp
#include <hip/hip_runtime.h>
#include <hip/hip_cooperative_groups.h>
#include <cstdio>
#include <cstdint>
namespace pg8 {
#define PG8_LAS __attribute__((address_space(3)))
typedef unsigned short bf16_t;
typedef short bf16x8 __attribute__((ext_vector_type(8)));
typedef float f32x4 __attribute__((ext_vector_type(4)));
typedef unsigned u32x4 __attribute__((ext_vector_type(4)));
constexpr int BM = 256, BK = 64, HALF = 128, HTB = HALF * BK * 2  , STAGE_BYTES = 8 * HTB, NXCD = 8, WGM = 8;

__host__ __device__ __forceinline__ int lds_byte(int r, int c) { const int st = (r >> 4) * 2 + (c >> 5), rr = r & 15, cc = c & 31, ob = rr * 64 + cc * 2; return st * 1024 + (ob ^ (((ob >> 9) & 1) << 5)); }
__host__ __device__ __forceinline__ void stage_rc(int b, int& R, int& C) { const int st = b / 1024, sb = b % 1024, swz = sb ^ (((sb >> 9) & 1) << 5); R = (st >> 1) * 16 + swz / 64; C = (st & 1) * 32 + (swz % 64) / 2; }
__host__ __device__ __forceinline__ int perm32(int rho) { const int n = rho >> 4, i = rho & 15; return 8 * (i >> 2) + 4 * n + (i & 3); }

struct Unit { int pm, pn; };
struct Gemm { const bf16_t* A; const bf16_t* Bt; int M, N, K, lda; long a2off; int pm2; };

struct StaticOrder {
    int nM, nN, nwg, G, c;
    __host__ __device__ __forceinline__ void init(int M, int N, int G_, int c_) { nM = M / BM; nN = N / BM; nwg = nM * nN; G = G_; c = c_; }
    __host__ __device__ __forceinline__ bool next(int i, Unit& u) const {
        const long L = (long)i * G + c; if (L >= nwg) return false;
        int wgid = (int)L; { const int q = nwg / NXCD, r = nwg % NXCD, xcd = wgid % NXCD, off = wgid / NXCD; wgid = (xcd < r ? xcd * (q + 1) : r * (q + 1) + (xcd - r) * q) + off; }
        const int nig = WGM * nN, gid = wgid / nig, fm = gid * WGM, gsz = (nM - fm) < WGM ? (nM - fm) : WGM;
        u.pm = fm + ((wgid % nig) % gsz); u.pn = (wgid % nig) / gsz; return true;
    }
    __device__ __forceinline__ void a_ready(const Unit&) const {}
    __device__ __forceinline__ void done(const Unit&) const {}
};

template <class Epi, class Sched, bool ALIGN_EPI = false, bool SP2 = false>
__device__ __forceinline__ void gemm_phase(PG8_LAS unsigned char* lds, const Gemm g, const Sched& S, const Epi& E) {
    int tid_l = threadIdx.x; asm volatile("" : "+v"(tid_l));
    const int tid = tid_l, wid = __builtin_amdgcn_readfirstlane(tid >> 6), lane = tid & 63, wr = wid >> 2, wc = wid & 3, fr = lane & 15, fq = lane >> 4;
    const int K = g.K, nt = K / BK, lda = g.lda;
    unsigned voffA[2], voffB[2];
#pragma unroll
    for (int i = 0; i < 2; ++i) { int R, C; stage_rc(tid * 16 + i * 8192, R, C); const int Rb = Epi::PERM ? ((R & ~31) + perm32(R & 31)) : R;
        voffA[i] = (unsigned)(R * lda + C) * 2u; voffB[i] = (unsigned)(Rb * K + C) * 2u; }
    const size_t kstep = (size_t)(BK * 2);
    const size_t hstepB = (size_t)HALF * K * 2, hstepA = (size_t)HALF * lda * 2;
    const size_t tstepB = 2 * hstepB, tstepA = 2 * hstepA;
    const unsigned ldsw = (unsigned)wid * 1024u;
    const int aoff = lds_byte(wr * 64 + fr, fq * 8), boff = lds_byte(wc * 32 + fr, fq * 8);
#define PG8_SA(b, h) (((b) * 2 + (h)) * HTB)
#define PG8_SB(b, h) ((4 + (b) * 2 + (h)) * HTB)
#define PG8_STAGE(bufoff, gbase, voff) do { _Pragma("unroll") for (int _i = 0; _i < 2; ++_i) \
        __builtin_amdgcn_global_load_lds((const unsigned*)((const char*)(gbase) + (voff)[_i]), (PG8_LAS unsigned*)(lds + (bufoff) + ldsw + _i * 8192), 16, 0, 0); } while (0)
#define PG8_LDA(dst, b, h) do { _Pragma("unroll") for (int m = 0; m < 4; ++m) _Pragma("unroll") for (int k = 0; k < 2; ++k) dst[m][k] = *(const PG8_LAS bf16x8*)(lds + PG8_SA(b, h) + aoff + m * 2048 + k * 1024); } while (0)
#define PG8_LDB(dst, b, h) do { _Pragma("unroll") for (int n = 0; n < 2; ++n) _Pragma("unroll") for (int k = 0; k < 2; ++k) dst[n][k] = *(const PG8_LAS bf16x8*)(lds + PG8_SB(b, h) + boff + n * 2048 + k * 1024); } while (0)
#define PG8_MMA(ai, bj, At, Bt) do { __builtin_amdgcn_s_setprio(1); _Pragma("unroll") for (int m = 0; m < 4; ++m) _Pragma("unroll") for (int n = 0; n < 2; ++n) _Pragma("unroll") for (int k = 0; k < 2; ++k) \
        acc[ai][bj][m][n] = __builtin_amdgcn_mfma_f32_16x16x32_bf16(Bt[n][k], At[m][k], acc[ai][bj][m][n], 0, 0, 0); __builtin_amdgcn_s_setprio(0); } while (0)
#define PG8_WAIT_V(n) asm volatile("s_waitcnt vmcnt(" #n ")" ::: "memory")
#define PG8_WAIT_L(n) asm volatile("s_waitcnt lgkmcnt(" #n ")" ::: "memory")
#define PG8_BAR __builtin_amdgcn_s_barrier()
#define PG8_SCHED __builtin_amdgcn_sched_barrier(0)
    Unit cur, nxt; int ui = 0;
    if (!S.next(0, cur)) return;
    f32x4 acc[2][2][4][2];
#pragma unroll
    for (int a = 0; a < 2; ++a)
#pragma unroll
        for (int b = 0; b < 2; ++b)
#pragma unroll
            for (int m = 0; m < 4; ++m)
#pragma unroll
                for (int n = 0; n < 2; ++n) acc[a][b][m][n] = (f32x4){0.f, 0.f, 0.f, 0.f};
    bf16x8 At[4][2], B0[2][2], B1[2][2];
    const char* cA = (const char*)g.A + (cur.pm < g.pm2 ? (long)cur.pm * (long)tstepA : g.a2off + (long)(cur.pm - g.pm2) * (long)tstepA); const char* cB = (const char*)g.Bt + (size_t)cur.pn * tstepB;
    S.a_ready(cur);
    if constexpr (SP2) {
        PG8_STAGE(PG8_SB(0, 0), cB, voffB); PG8_STAGE(PG8_SB(0, 1), cB + hstepB, voffB); PG8_STAGE(PG8_SA(0, 0), cA, voffA); PG8_STAGE(PG8_SA(0, 1), cA + hstepA, voffA);
        if (wr == 1) PG8_BAR;
        PG8_WAIT_V(2); PG8_BAR;
        PG8_STAGE(PG8_SB(1, 0), cB + kstep, voffB); PG8_STAGE(PG8_SA(1, 0), cA + kstep, voffA); PG8_STAGE(PG8_SB(1, 1), cB + hstepB + kstep, voffB);
        PG8_WAIT_V(6); PG8_BAR;
    } else {
        PG8_STAGE(PG8_SB(0, 0), cB, voffB); PG8_STAGE(PG8_SA(0, 0), cA, voffA); PG8_STAGE(PG8_SB(0, 1), cB + hstepB, voffB); PG8_STAGE(PG8_SA(0, 1), cA + hstepA, voffA);
        if (wr == 1) PG8_BAR;
        PG8_WAIT_V(4); PG8_BAR;
        PG8_STAGE(PG8_SB(1, 0), cB + kstep, voffB); PG8_STAGE(PG8_SA(1, 0), cA + kstep, voffA); PG8_STAGE(PG8_SB(1, 1), cB + hstepB + kstep, voffB);
        PG8_WAIT_V(6); PG8_BAR;
    }
    for (;;) {
        const bool has_next = S.next(ui + 1, nxt);
        const char* nA = has_next ? (const char*)g.A + (nxt.pm < g.pm2 ? (long)nxt.pm * (long)tstepA : g.a2off + (long)(nxt.pm - g.pm2) * (long)tstepA) : cA; const char* nB = has_next ? (const char*)g.Bt + (size_t)nxt.pn * tstepB : cB;
        for (int t = 0; t < nt; t += 2) {
            if constexpr (Epi::RESCALE) { if (t == 8 || t == 16) E.rescale(acc, ui, t, wr, fr); }
            const bool last = (t == nt - 2);
            const char* a1 = cA + (size_t)(t + 1) * kstep;
            const char* a2 = last ? nA : cA + (size_t)(t + 2) * kstep; const char* b2 = last ? nB : cB + (size_t)(t + 2) * kstep;
            const char* a3 = a2 + kstep; const char* b3 = b2 + kstep;
            if (last && has_next) S.a_ready(nxt);
            if constexpr (SP2) {
            PG8_LDB(B0, 0, 0); PG8_LDB(B1, 0, 1); PG8_SCHED; PG8_LDA(At, 0, 0); PG8_STAGE(PG8_SA(1, 1), a1 + hstepA, voffA);
            PG8_WAIT_V(8); PG8_WAIT_L(0); PG8_BAR; PG8_MMA(0, 0, At, B0); PG8_MMA(0, 1, At, B1); PG8_BAR; PG8_SCHED;
            PG8_LDA(At, 0, 1); PG8_STAGE(PG8_SB(0, 0), b2, voffB); PG8_STAGE(PG8_SB(0, 1), b2 + hstepB, voffB); PG8_STAGE(PG8_SA(0, 0), a2, voffA);
            PG8_WAIT_V(8); PG8_WAIT_L(0); PG8_BAR; PG8_MMA(1, 0, At, B0); PG8_MMA(1, 1, At, B1); PG8_BAR; PG8_SCHED;
            PG8_LDB(B0, 1, 0); PG8_LDB(B1, 1, 1); PG8_SCHED; PG8_LDA(At, 1, 0); PG8_STAGE(PG8_SA(0, 1), a2 + hstepA, voffA);
            PG8_WAIT_V(8); PG8_WAIT_L(0); PG8_BAR; PG8_MMA(0, 0, At, B0); PG8_MMA(0, 1, At, B1); PG8_BAR; PG8_SCHED;
            PG8_LDA(At, 1, 1); PG8_STAGE(PG8_SB(1, 0), b3, voffB); PG8_STAGE(PG8_SB(1, 1), b3 + hstepB, voffB); PG8_STAGE(PG8_SA(1, 0), a3, voffA);
            PG8_WAIT_V(8); PG8_WAIT_L(0); PG8_BAR; PG8_MMA(1, 0, At, B0); PG8_MMA(1, 1, At, B1); PG8_BAR; PG8_SCHED;
            } else {
            PG8_LDB(B0, 0, 0); PG8_SCHED; PG8_LDA(At, 0, 0); PG8_STAGE(PG8_SA(1, 1), a1 + hstepA, voffA);
            PG8_WAIT_L(8); PG8_BAR; PG8_WAIT_L(0); PG8_MMA(0, 0, At, B0); PG8_BAR; PG8_SCHED;
            PG8_LDB(B1, 0, 1); PG8_STAGE(PG8_SB(0, 0), b2, voffB);
            PG8_BAR; PG8_WAIT_L(0); PG8_MMA(0, 1, At, B1); PG8_BAR;
            PG8_LDA(At, 0, 1); PG8_STAGE(PG8_SA(0, 0), a2, voffA);
            PG8_BAR; PG8_WAIT_L(0); PG8_MMA(1, 0, At, B0); PG8_BAR; PG8_SCHED;
            PG8_STAGE(PG8_SB(0, 1), b2 + hstepB, voffB);
            PG8_WAIT_V(6); PG8_BAR; PG8_MMA(1, 1, At, B1); PG8_BAR;
            PG8_LDB(B0, 1, 0); PG8_SCHED; PG8_LDA(At, 1, 0); PG8_STAGE(PG8_SA(0, 1), a2 + hstepA, voffA);
            PG8_WAIT_L(8); PG8_BAR; PG8_WAIT_L(0); PG8_MMA(0, 0, At, B0); PG8_BAR; PG8_SCHED;
            PG8_LDB(B1, 1, 1); PG8_STAGE(PG8_SB(1, 0), b3, voffB);
            PG8_BAR; PG8_WAIT_L(0); PG8_MMA(0, 1, At, B1); PG8_BAR;
            PG8_LDA(At, 1, 1); PG8_STAGE(PG8_SA(1, 0), a3, voffA);
            PG8_BAR; PG8_WAIT_L(0); PG8_MMA(1, 0, At, B0); PG8_BAR; PG8_SCHED;
            PG8_STAGE(PG8_SB(1, 1), b3 + hstepB, voffB);
            PG8_WAIT_V(6); PG8_BAR; PG8_MMA(1, 1, At, B1); PG8_BAR;
            }
        }
        if constexpr (ALIGN_EPI) { if (wr == 0) PG8_BAR; }
        if constexpr (Epi::RESCALE) { E.fin(acc, cur, ui, wr, wc, fr, fq); } else if constexpr (!Epi::AFTER_DRAIN) { E(acc, cur, wr, wc, fr, fq); S.done(cur); }
        if (!has_next) break;
#pragma unroll
        for (int a = 0; a < 2; ++a)
#pragma unroll
            for (int b = 0; b < 2; ++b)
#pragma unroll
                for (int m = 0; m < 4; ++m)
#pragma unroll
                    for (int n = 0; n < 2; ++n) acc[a][b][m][n] = (f32x4){0.f, 0.f, 0.f, 0.f};
        cur = nxt; cA = nA; cB = nB; ++ui;
        if constexpr (ALIGN_EPI) { if (wr == 1) PG8_BAR; }
    }
    PG8_WAIT_V(0);
    if constexpr (!ALIGN_EPI) { if (wr == 0) PG8_BAR; }
    PG8_BAR;
    if constexpr (Epi::AFTER_DRAIN) { E.fused(acc, cur, wr, wc, fr, fq, lds, wid, lane); S.done(cur); }
#undef PG8_SA
#undef PG8_SB
#undef PG8_STAGE
#undef PG8_LDA
#undef PG8_LDB
#undef PG8_MMA
#undef PG8_WAIT_V
#undef PG8_WAIT_L
#undef PG8_BAR
#undef PG8_SCHED
}
}

#include <hip/hip_bf16.h>
#include <cmath>
namespace attn_body {
using bf16=__hip_bfloat16;
using bf16x8=__attribute__((ext_vector_type(8)))short;
using s16x4=__attribute__((ext_vector_type(4)))short;
using f32x16=__attribute__((ext_vector_type(16)))float;
using u32x4=__attribute__((ext_vector_type(4)))unsigned;
constexpr int D=64,DM=3584;
constexpr int NW=8,QBLK=32,QB=QBLK*NW,KVBLK=64;
constexpr int ATTN_PITCH=DM, ATTN_UNIT_ROWS=QB;
__device__ __forceinline__ int crow(int r,int hi){return (r&3)+8*(r>>2)+4*hi;}
#define SBAR() __builtin_amdgcn_sched_barrier(0)
constexpr int NSLOT=3, SLOTB=8192;
constexpr int LDS_K=0, LDS_V=NSLOT*SLOTB, LDS_WS=2*NSLOT*SLOTB, LDS_OST=LDS_WS+NW*64*4, LDS_BYTES=LDS_OST+NW*4096;
constexpr float C2=0.125f*1.4426950408889634f;
__device__ __forceinline__ void glds16(const void*gsrc,unsigned lds_dst){unsigned keep;
  asm volatile("s_mov_b32 %0, m0\n\ts_mov_b32 m0, %2\n\ts_nop 0\n\tglobal_load_lds_dwordx4 %1, off\n\ts_mov_b32 m0, %0":"=&s"(keep):"v"(gsrc),"s"(lds_dst):"memory");}
__device__ __forceinline__ float max3f(float a,float b,float c){float r;asm("v_max3_f32 %0, %1, %2, %3":"=v"(r):"v"(a),"v"(b),"v"(c));return r;}
__device__ __forceinline__ float max2f(float a,float b){float r;asm("v_max_f32_e32 %0, %1, %2":"=v"(r):"v"(a),"v"(b));return r;}
__device__ __forceinline__ float fadd_s(float a,float b){float r;asm("v_add_f32_e32 %0, %1, %2":"=v"(r):"v"(a),"v"(b));return r;}
__device__ __forceinline__ float fsub_s(float a,float b){float r;asm("v_sub_f32_e32 %0, %1, %2":"=v"(r):"v"(a),"v"(b));return r;}
typedef float f32x2_t __attribute__((ext_vector_type(2))); typedef __bf16 bf16x2_t __attribute__((ext_vector_type(2)));
__device__ __forceinline__ unsigned cvtpk_s(float lo,float hi){f32x2_t v={lo,hi};bf16x2_t b=__builtin_convertvector(v,bf16x2_t);return __builtin_bit_cast(unsigned,b);}
#define WAIT_BAR(N) asm volatile("s_waitcnt vmcnt(" #N ") lgkmcnt(0)\n\ts_barrier":::"memory")

__device__ __forceinline__ void qkt(f32x16&p0,f32x16&p1,const char*Kslot,const bf16x8*qr,const f32x16&negm,int r32,int hi){
  const char*kb=Kslot+hi*1024+r32*16;
  #pragma unroll
  for(int d0=0;d0<4;++d0){
    const bf16x8 b0=*reinterpret_cast<const bf16x8*>(kb+d0*2048);
    const bf16x8 b1=*reinterpret_cast<const bf16x8*>(kb+d0*2048+512);
    if(d0==0){p0=__builtin_amdgcn_mfma_f32_32x32x16_bf16(b0,qr[0],negm,0,0,0);p1=__builtin_amdgcn_mfma_f32_32x32x16_bf16(b1,qr[0],negm,0,0,0);}
    else{p0=__builtin_amdgcn_mfma_f32_32x32x16_bf16(b0,qr[d0],p0,0,0,0);p1=__builtin_amdgcn_mfma_f32_32x32x16_bf16(b1,qr[d0],p1,0,0,0);}}
}
typedef __attribute__((address_space(3))) const char* lds_cptr;
typedef short v4i16_t __attribute__((ext_vector_type(4)));
__device__ __forceinline__ void kload8(bf16x8*kf,lds_cptr kp){
  kf[0]=*(const __attribute__((address_space(3))) bf16x8*)(kp);      kf[1]=*(const __attribute__((address_space(3))) bf16x8*)(kp+512);
  kf[2]=*(const __attribute__((address_space(3))) bf16x8*)(kp+2048); kf[3]=*(const __attribute__((address_space(3))) bf16x8*)(kp+2560);
  kf[4]=*(const __attribute__((address_space(3))) bf16x8*)(kp+4096); kf[5]=*(const __attribute__((address_space(3))) bf16x8*)(kp+4608);
  kf[6]=*(const __attribute__((address_space(3))) bf16x8*)(kp+6144); kf[7]=*(const __attribute__((address_space(3))) bf16x8*)(kp+6656);
}
__device__ __forceinline__ void kload2(bf16x8*kf,lds_cptr kp,int j){ kf[2*j]=*(const __attribute__((address_space(3))) bf16x8*)(kp+j*2048); kf[2*j+1]=*(const __attribute__((address_space(3))) bf16x8*)(kp+j*2048+512); }
__device__ __forceinline__ s16x4 vtr(lds_cptr p){ return __builtin_bit_cast(s16x4,__builtin_amdgcn_ds_read_tr16_b64_v4i16((__attribute__((address_space(3))) v4i16_t*)p)); }
__device__ __forceinline__ float rowmax(const f32x16&p0,const f32x16&p1){
  float a=max3f(p0[0],p0[1],p1[0]),b=max3f(p0[2],p0[3],p1[1]);a=max3f(a,p1[2],p1[3]);
  #pragma unroll
  for(int r=4;r<16;r+=4){a=max3f(a,p0[r],p0[r+1]);b=max3f(b,p0[r+2],p0[r+3]);a=max3f(a,p1[r],p1[r+1]);b=max3f(b,p1[r+2],p1[r+3]);}
  const float m=max2f(a,b);
  auto rr=__builtin_amdgcn_permlane32_swap(__float_as_uint(m),__float_as_uint(m),false,false);
  return max2f(__uint_as_float(rr[0]),__uint_as_float(rr[1]));
}
__device__ __forceinline__ void pv(f32x16*o,int vb,bf16x8 pa0,bf16x8 pa1,bf16x8 pa2,bf16x8 pa3){
  #pragma unroll
  for(int d0=0;d0<2;++d0){s16x4 lo[4],hi[4];
    #pragma unroll
    for(int ks=0;ks<4;++ks){
      asm volatile("ds_read_b64_tr_b16 %0,%1 offset:%c2":"=&v"(lo[ks]):"v"(vb),"i"(d0*4096+ks*1024):"memory");
      asm volatile("ds_read_b64_tr_b16 %0,%1 offset:%c2":"=&v"(hi[ks]):"v"(vb),"i"(d0*4096+ks*1024+512):"memory");}
    asm volatile("s_waitcnt lgkmcnt(0)":::"memory");SBAR();
    #define PK(k) (bf16x8){lo[k][0],lo[k][1],lo[k][2],lo[k][3],hi[k][0],hi[k][1],hi[k][2],hi[k][3]}
    o[d0]=__builtin_amdgcn_mfma_f32_32x32x16_bf16(pa0,PK(0),o[d0],0,0,0);
    o[d0]=__builtin_amdgcn_mfma_f32_32x32x16_bf16(pa1,PK(1),o[d0],0,0,0);
    o[d0]=__builtin_amdgcn_mfma_f32_32x32x16_bf16(pa2,PK(2),o[d0],0,0,0);
    o[d0]=__builtin_amdgcn_mfma_f32_32x32x16_bf16(pa3,PK(3),o[d0],0,0,0);
    #undef PK
  }
}

#ifndef ATTN_STORE16
#define ATTN_STORE16(p,v) (*(u32x4*)(p)=(v))
#endif
template<int THRL,bool FAST> __device__ __forceinline__ void attn_unit(float bref,long rowbase,int seqlen,int h,int qb,const bf16*Q,const bf16*__restrict__ K,const bf16*__restrict__ V,bf16*O,float*SSQ,char*shm){
  int tid_l=threadIdx.x; asm volatile("":"+v"(tid_l)); const int tid=tid_l,lane=tid&63,r32=lane&31,hi=lane>>5; const int wid=__builtin_amdgcn_readfirstlane(tid>>6);
  const int q0=qb*QB; const int kvh=h>>2;
  const bf16*Qw=Q+(rowbase+q0+wid*QBLK)*DM+h*D;
  constexpr int KDM=64; constexpr long KVTOK=81920;
  const bf16*Kh=K+((long)kvh*KVTOK+rowbase)*KDM,*Vh=V+((long)kvh*KVTOK+rowbase)*KDM;
  const unsigned lds0=(unsigned)(uintptr_t)shm;
  float*wsf=(float*)(shm+LDS_WS)+wid*64;
  const bf16*ksrc=Kh+(long)lane*KDM+wid*8;
  const bf16*vsrc=Vh+(long)(16*(wid&3)+(lane>>2))*KDM+(wid>>2)*32+(lane&3)*8;
  const unsigned kdst=lds0+LDS_K+wid*1024, vdst=lds0+LDS_V+wid*1024;
  #define DMA_K(t,slot) glds16(ksrc+(long)(t)*KVBLK*KDM,(unsigned)__builtin_amdgcn_readfirstlane(kdst+(slot)))
  #define DMA_V(t,slot) glds16(vsrc+(long)(t)*KVBLK*KDM,(unsigned)__builtin_amdgcn_readfirstlane(vdst+(slot)))
  const int vb0=(int)(lds0+LDS_V)+((lane>>4)&1)*32+(lane&3)*8+(4*hi+((lane&15)>>2))*64;
  const char*Kbase=shm+LDS_K; bf16x8 kf[8];
  const lds_cptr shm3=(lds_cptr)shm; const lds_cptr kp0=shm3+LDS_K+hi*1024+r32*16; const lds_cptr vp0=shm3+LDS_V+((lane>>4)&1)*32+(lane&3)*8+(4*hi+((lane&15)>>2))*64;
  const int NT=seqlen/KVBLK;
  DMA_K(0,0);DMA_V(0,0);DMA_K(1,SLOTB);
  bf16x8 qr[4];
  #pragma unroll
  for(int d0=0;d0<4;++d0)qr[d0]=*reinterpret_cast<const bf16x8*>(&Qw[(long)r32*DM+d0*16+hi*8]);
  float mhat=FAST?bref:0.f,l_reg=0.f;f32x16 o[2];o[0]=f32x16{};o[1]=f32x16{};f32x16 negm=f32x16{};
  if constexpr(FAST){
    #pragma unroll
    for(int r=0;r<16;++r)negm[r]=-bref;}
  asm volatile("":"+v"(negm));
  #define CMASK(P0,P1,t) do{}while(0)
  bool resc=false;
  #define START(P0,P1) do{ resc=false; \
    if constexpr(!FAST){ const float rm=rowmax(P0,P1); const float dl=rm; mhat=fadd_s(mhat,dl); \
      _Pragma("unroll") for(int r=0;r<16;++r){P0[r]=fsub_s(P0[r],dl);P1[r]=fsub_s(P1[r],dl);} \
      _Pragma("unroll") for(int r=0;r<16;++r)negm[r]=-mhat; asm volatile("":"+v"(negm)); } \
    _Pragma("unroll") for(int r=0;r<16;++r)P0[r]=__builtin_amdgcn_exp2f(P0[r]); }while(0)
  #define RESC() do{ if(resc){ asm volatile("s_waitcnt lgkmcnt(0)":::"memory"); \
      _Pragma("unroll") for(int d_=0;d_<2;++d_) _Pragma("unroll") for(int r=0;r<16;++r)o[d_][r]*=wsf[crow(r,hi)]; } }while(0)
  f32x16 pA0,pA1,pB0,pB1;
  int sl_prev=0,sl_cur=0,sl_next=SLOTB;
  #define ROT() do{sl_prev=sl_cur;sl_cur=sl_next;sl_next=(sl_next==(NSLOT-1)*SLOTB)?0:sl_next+SLOTB;}while(0)
  DMA_K(2,2*SLOTB);
  WAIT_BAR(3);
  qkt(pA0,pA1,Kbase,qr,negm,r32,hi);asm volatile("s_nop 15\n\ts_nop 7":"+v"(pA0),"+v"(pA1));
  START(pA0,pA1);
  _Pragma("unroll") for(int r=0;r<16;++r)pA1[r]=__builtin_amdgcn_exp2f(pA1[r]);
  WAIT_BAR(0);
  DMA_K(3,0);DMA_V(1,SLOTB);
  ROT();
  kload8(kf,kp0+sl_cur);
  WAIT_BAR(2);
  s16x4 vlo[8],vhi[8]; u32x4 pw0,pw1,pw2,pw3;
  #define PKW(P,B) cvtpk_s(P[B],P[B+1])
  #define PAF(k) __builtin_bit_cast(bf16x8,pw##k)
  #define VFR(i) (bf16x8){vlo[i][0],vlo[i][1],vlo[i][2],vlo[i][3],vhi[i][0],vhi[i][1],vhi[i][2],vhi[i][3]}
  #define PIN(x) asm volatile("":"+v"(x))
  #define MX3(a,b,c) __builtin_fmaxf(__builtin_fmaxf((a),(b)),(c))
  #define GAPA(MF,A0,A1,A2,A3,W0,W1,PW) do{ MF; sacc+=A0; sacc+=A1; sacc+=A2; sacc+=A3; PIN(sacc); W0; W1; PIN(PW); SBAR(); }while(0)
  #define EX(v) __builtin_amdgcn_exp2f(v)
  #define GAPB(MF,X,B) do{ MF; X[B]=EX(X[B]); X[B+1]=EX(X[B+1]); X[B+2]=EX(X[B+2]); X[B+3]=EX(X[B+3]); PIN(X); SBAR(); }while(0)
  #define VRD(i) do{ vlo[i]=vtr(vp_+(((i)>>2)*4096+((i)&3)*1024)); vhi[i]=vtr(vp_+(((i)>>2)*4096+((i)&3)*1024+512)); }while(0)
  #define KRD(G,j) do{ if(G){ kload2(kf,kp0+sl_next,j); SBAR(); } }while(0)
  #define STEP(C0,C1,P0,P1,t,GK,GV,GL) do{ SBAR(); \
    const lds_cptr vp_=vp0+sl_prev; \
    VRD(0); SBAR(); float sacc=(P0[0]+P0[1]); \
    GAPA(C0=__builtin_amdgcn_mfma_f32_32x32x16_bf16(kf[0],qr[0],negm,0,0,0), P0[2],P0[3],P0[4],P0[5],     pw0[0]=PKW(P0,0), pw0[1]=PKW(P0,2), pw0); \
    VRD(4); SBAR(); GAPA(C1=__builtin_amdgcn_mfma_f32_32x32x16_bf16(kf[1],qr[0],negm,0,0,0), P0[6],P0[7],P0[8],P0[9],     pw0[2]=PKW(P0,4), pw0[3]=PKW(P0,6), pw0); \
    VRD(1); SBAR(); GAPA(C0=__builtin_amdgcn_mfma_f32_32x32x16_bf16(kf[2],qr[1],C0,0,0,0),   P0[10],P0[11],P0[12],P0[13], pw1[0]=PKW(P0,8), pw1[1]=PKW(P0,10), pw1); \
    VRD(5); SBAR(); GAPA(C1=__builtin_amdgcn_mfma_f32_32x32x16_bf16(kf[3],qr[1],C1,0,0,0),   P0[14],P0[15],P1[0],P1[1],   pw1[2]=PKW(P0,12),pw1[3]=PKW(P0,14), pw1); \
    VRD(2); SBAR(); GAPA(C0=__builtin_amdgcn_mfma_f32_32x32x16_bf16(kf[4],qr[2],C0,0,0,0),   P1[2],P1[3],P1[4],P1[5],     pw2[0]=PKW(P1,0), pw2[1]=PKW(P1,2), pw2); \
    VRD(6); SBAR(); GAPA(C1=__builtin_amdgcn_mfma_f32_32x32x16_bf16(kf[5],qr[2],C1,0,0,0),   P1[6],P1[7],P1[8],P1[9],     pw2[2]=PKW(P1,4), pw2[3]=PKW(P1,6), pw2); \
    VRD(3); SBAR(); GAPA(C0=__builtin_amdgcn_mfma_f32_32x32x16_bf16(kf[6],qr[3],C0,0,0,0),   P1[10],P1[11],P1[12],P1[13], pw3[0]=PKW(P1,8), pw3[1]=PKW(P1,10), pw3); \
    VRD(7); SBAR(); GAPA(C1=__builtin_amdgcn_mfma_f32_32x32x16_bf16(kf[7],qr[3],C1,0,0,0),   P1[14],P1[15],0.f,0.f,       pw3[2]=PKW(P1,12),pw3[3]=PKW(P1,14), pw3); \
    l_reg+=sacc; \
    if(GK){DMA_K((t)+3,sl_cur);} if(GV){DMA_V((t)+1,sl_next);} \
    CMASK(C0,C1,t); \
    if constexpr(!FAST){ float a=MX3(C0[0],C0[1],C1[0]),b=MX3(C0[2],C0[3],C1[1]); a=MX3(a,C1[2],C1[3]); \
      _Pragma("unroll") for(int r=4;r<16;r+=4){a=MX3(a,C0[r],C0[r+1]);b=MX3(b,C0[r+2],C0[r+3]);a=MX3(a,C1[r],C1[r+1]);b=MX3(b,C1[r+2],C1[r+3]);} \
      float rm=__builtin_fmaxf(a,b); { auto rr=__builtin_amdgcn_permlane32_swap(__float_as_uint(rm),__float_as_uint(rm),false,false); rm=__builtin_fmaxf(__uint_as_float(rr[0]),__uint_as_float(rr[1])); } \
      resc=false; \
      if(__builtin_expect(__any(rm>(float)THRL),0)){ const float dl=__builtin_fmaxf(rm,0.f); mhat+=dl; \
        _Pragma("unroll") for(int r=0;r<16;++r){C0[r]-=dl;C1[r]-=dl;} \
        _Pragma("unroll") for(int r=0;r<16;++r)negm[r]=-mhat; asm volatile("":"+v"(negm)); \
        const float f=__builtin_amdgcn_exp2f(-dl); l_reg*=f; if(hi==0)wsf[r32]=f; resc=true; } } \
    SBAR(); \
    GAPB(o[0]=__builtin_amdgcn_mfma_f32_32x32x16_bf16(PAF(0),VFR(0),o[0],0,0,0), C0,0); \
    GAPB(o[1]=__builtin_amdgcn_mfma_f32_32x32x16_bf16(PAF(0),VFR(4),o[1],0,0,0), C0,4); \
    KRD(GL,0); GAPB(o[0]=__builtin_amdgcn_mfma_f32_32x32x16_bf16(PAF(1),VFR(1),o[0],0,0,0), C0,8); \
    KRD(GL,1); GAPB(o[1]=__builtin_amdgcn_mfma_f32_32x32x16_bf16(PAF(1),VFR(5),o[1],0,0,0), C0,12); \
    KRD(GL,2); GAPB(o[0]=__builtin_amdgcn_mfma_f32_32x32x16_bf16(PAF(2),VFR(2),o[0],0,0,0), C1,0); \
    KRD(GL,3); GAPB(o[1]=__builtin_amdgcn_mfma_f32_32x32x16_bf16(PAF(2),VFR(6),o[1],0,0,0), C1,4); \
    GAPB(o[0]=__builtin_amdgcn_mfma_f32_32x32x16_bf16(PAF(3),VFR(3),o[0],0,0,0), C1,8); \
    GAPB(o[1]=__builtin_amdgcn_mfma_f32_32x32x16_bf16(PAF(3),VFR(7),o[1],0,0,0), C1,12); \
    }while(0)
  int t=1;
  for(;t+5<NT;t+=2){
    STEP(pB0,pB1,pA0,pA1,t,true,true,true);     WAIT_BAR(2); RESC(); ROT();
    STEP(pA0,pA1,pB0,pB1,t+1,true,true,true);   WAIT_BAR(2); RESC(); ROT();
  }
  #define ENDW(tt) do{ if((tt)+3<NT){WAIT_BAR(2);} else if((tt)+2<NT){WAIT_BAR(1);} else {WAIT_BAR(0);} }while(0)
  for(;t+1<NT;t+=2){
    STEP(pB0,pB1,pA0,pA1,t,(t+3<NT),(t+1<NT),(t+1<NT));       ENDW(t);   RESC(); ROT();
    STEP(pA0,pA1,pB0,pB1,t+1,(t+4<NT),(t+2<NT),(t+2<NT));     ENDW(t+1); RESC(); ROT();
  }
  STEP(pB0,pB1,pA0,pA1,NT-1,false,false,false); RESC();
  { float sacc=pB0[0]+pB0[1]; _Pragma("unroll") for(int r=2;r<16;++r)sacc+=pB0[r]; _Pragma("unroll") for(int r=0;r<16;++r)sacc+=pB1[r]; l_reg+=sacc;
    pw0=(u32x4){PKW(pB0,0),PKW(pB0,2),PKW(pB0,4),PKW(pB0,6)};pw1=(u32x4){PKW(pB0,8),PKW(pB0,10),PKW(pB0,12),PKW(pB0,14)};pw2=(u32x4){PKW(pB1,0),PKW(pB1,2),PKW(pB1,4),PKW(pB1,6)};pw3=(u32x4){PKW(pB1,8),PKW(pB1,10),PKW(pB1,12),PKW(pB1,14)};
    SBAR(); pv(o,vb0+sl_cur,PAF(0),PAF(1),PAF(2),PAF(3)); }
  #undef PKW
  #undef PAF
  #undef VFR
  #undef PIN
  #undef MX3
  #undef GAPA
  #undef GAPB
  #undef EX
  #undef VRD
  #undef KRD
  #undef STEP
  #undef ENDW
  {auto rr=__builtin_amdgcn_permlane32_swap(__float_as_uint(l_reg),__float_as_uint(l_reg),false,false);l_reg=__uint_as_float(rr[0])+__uint_as_float(rr[1]);}
  if(hi==0)wsf[32+r32]=l_reg;asm volatile("s_waitcnt lgkmcnt(0)":::"memory");
  float rli[16];
  #pragma unroll
  for(int r=0;r<16;++r)rli[r]=__builtin_amdgcn_rcpf(wsf[32+crow(r,hi)]);
  bf16*Ow=O+(rowbase+q0+wid*QBLK)*DM+h*D;
  { bf16*stg=(bf16*)(shm+LDS_OST)+wid*2048;
    #pragma unroll
    for(int r=0;r<16;++r){const int orow=crow(r,hi);
      #pragma unroll
      for(int d0=0;d0<2;++d0)stg[orow*64+d0*32+r32]=__float2bfloat16(o[d0][r]*rli[r]);}
    asm volatile("s_waitcnt lgkmcnt(0)":::"memory");
    #pragma unroll
    for(int i=0;i<4;++i){const int row=i*8+(lane>>3),ch=lane&7; const u32x4 v=*(const u32x4*)(stg+row*64+ch*8); ATTN_STORE16(Ow+(long)row*DM+ch*8,v);
      float q=0.f;
      #pragma unroll
      for(int e=0;e<4;++e){const float a=__uint_as_float(v[e]<<16),b=__uint_as_float(v[e]&0xffff0000u);q+=a*a+b*b;}
      q+=__shfl_xor(q,1);q+=__shfl_xor(q,2);q+=__shfl_xor(q,4);
      if(ch==0)SSQ[(rowbase+q0+wid*QBLK+row)*8+h]=q;} }
  asm volatile("s_waitcnt lgkmcnt(0)\n\ts_barrier":::"memory");
  #undef DMA_K
  #undef DMA_V
  #undef CMASK
  #undef START
  #undef RESC
  #undef ROT
}
constexpr int ATTN_LDS_BYTES=LDS_BYTES;
struct AttnTensors { const bf16* Q; const bf16* K; const bf16* V; bf16* O; float* SSQ; };
template<int THRL,bool FAST> __device__ __forceinline__ void attn_phase(float bref,char*lds,const AttnTensors&T,int vcu,int G){
  for(int u=vcu;u<2560;u+=G){
    long rowbase;int seqlen,h,qb;
    if(u<512){rowbase=0;seqlen=16384;h=u>>6;qb=u&63;}
    else{const int u2=u-512;const int s=u2>>8;rowbase=16384+(long)s*8192;seqlen=8192;h=(u2>>5)&7;qb=u2&31;}
    attn_unit<THRL,FAST>(bref,rowbase,seqlen,h,qb,T.Q,T.K,T.V,T.O,T.SSQ,lds);
  }
}
#undef SBAR
#undef WAIT_BAR
}

namespace cg = cooperative_groups;
#ifndef PHMASK
#define PHMASK 0xffff
#endif

#define LAS __attribute__((address_space(3)))
typedef unsigned short bf16;
typedef unsigned v4u __attribute__((ext_vector_type(4)));
typedef unsigned v2u __attribute__((ext_vector_type(2)));
typedef float f32x4 __attribute__((ext_vector_type(4)));
typedef short bf16x8 __attribute__((ext_vector_type(8)));

constexpr int NTOK = 81920, PP = 3584;
constexpr int QC = 1024, XC = 1536, KC = 3072, VC = 3200, DTC = 3328;
constexpr int NCHUNK = 640;
constexpr float LOG2E = 1.4426950408889634f, EPSN = 1e-6f;
constexpr size_t MiB = 1u << 20;
constexpr size_t WS_TAB = 0, WS_WIN = 1 * MiB, WS_WOUT = 8 * MiB, WS_WXQ = 11 * MiB, WS_WXKV = 12 * MiB, WS_WXO = 14 * MiB, WS_WGU = 15 * MiB, WS_WD = 26 * MiB,
                 WS_MEMN = 32 * MiB, WS_MKV = 37 * MiB, WS_XN = 42 * MiB, WS_DT = 42 * MiB, WS_CS = 52 * MiB, WS_DEC = 62 * MiB, WS_SSQS = 64 * MiB, WS_SSQA = 66 * MiB, WS_KC = 122 * MiB, WS_VC = 1002 * MiB,
                 WS_PROJ = 202 * MiB, WS_Q2 = 202 * MiB, WS_CA = 282 * MiB, WS_HID = 202 * MiB, WS_XBC = 762 * MiB, WS_RAW = 762 * MiB, WS_X2B0 = 642 * MiB, WS_X2B1 = 922 * MiB, WS_END = 1022 * MiB, WS_BAR = 512 * 1024;
constexpr int LDS_BYTES = 152 * 1024;

__device__ __forceinline__ unsigned f2bf(float f) { unsigned u = __builtin_bit_cast(unsigned, f); return (u + 0x7fffu + ((u >> 16) & 1u)) >> 16; }
typedef float f32x2_t __attribute__((ext_vector_type(2))); typedef __bf16 bf16x2_t __attribute__((ext_vector_type(2)));
__device__ __forceinline__ unsigned pk2(float lo, float hi) { f32x2_t v = {lo, hi}; bf16x2_t b = __builtin_convertvector(v, bf16x2_t); return __builtin_bit_cast(unsigned, b); }
__device__ __forceinline__ float bflo(unsigned w) { return __builtin_bit_cast(float, w << 16); }
__device__ __forceinline__ float bfhi(unsigned w) { return __builtin_bit_cast(float, w & 0xffff0000u); }
__device__ __forceinline__ float bf1(bf16 h) { return __builtin_bit_cast(float, ((unsigned)h) << 16); }
__device__ __forceinline__ float wave_sum(float v) {
#pragma unroll
    for (int o = 1; o < 64; o <<= 1) v += __shfl_xor(v, o);
    return v;
}
__device__ __forceinline__ float ex2(float x) { return __builtin_amdgcn_exp2f(x); }
__device__ __forceinline__ f32x4 mfma16(bf16x8 a, bf16x8 b, f32x4 c) { return __builtin_amdgcn_mfma_f32_16x16x32_bf16(a, b, c, 0, 0, 0); }
__device__ __forceinline__ const float* xrow(const float* xp, const float* xs, int t) { return t < 16384 ? xp + (size_t)t * 1024 : xs + (size_t)(t - 16384) * 1024; }
#define LDS_WAIT() asm volatile("s_waitcnt lgkmcnt(0)" ::: "memory")
#define LBAR() asm volatile("s_waitcnt lgkmcnt(0)\n\ts_barrier" ::: "memory")

struct EpiStore {
    static constexpr bool PERM = true, AFTER_DRAIN = false, RESCALE = false;
    bf16* O; int ldc; float scale; const float* rs;
    __device__ __forceinline__ void operator()(const f32x4 (&acc)[2][2][4][2], const pg8::Unit& u, int wr, int wc, int fr, int fq) const {
        const int row0 = u.pm * 256 + wr * 64 + fr, col0 = u.pn * 256 + wc * 32 + 8 * fq;
#pragma unroll
        for (int ai = 0; ai < 2; ++ai)
#pragma unroll
            for (int m = 0; m < 4; ++m) { bf16* rowp = O + (size_t)(row0 + ai * 128 + m * 16) * ldc + col0; const float sc = rs ? scale * rs[row0 + ai * 128 + m * 16] : scale;
#pragma unroll
                for (int bj = 0; bj < 2; ++bj) { const f32x4 v0 = acc[ai][bj][m][0] * sc, v1 = acc[ai][bj][m][1] * sc;
                    v4u w; w.x = pk2(v0[0], v0[1]); w.y = pk2(v0[2], v0[3]); w.z = pk2(v1[0], v1[1]); w.w = pk2(v1[2], v1[3]);
                    *(v4u*)(rowp + bj * 128) = w; } }
    }
};
struct EpiProj {
    static constexpr bool PERM = true, AFTER_DRAIN = false, RESCALE = false;
    bf16* O; bf16* VCp;
    __device__ __forceinline__ void operator()(const f32x4 (&acc)[2][2][4][2], const pg8::Unit& u, int wr, int wc, int fr, int fq) const {
        const int row0 = u.pm * 256 + wr * 64 + fr, col0 = u.pn * 256 + wc * 32 + 8 * fq;
        if (u.pn == 13 && wc != 0) return;
#pragma unroll
        for (int ai = 0; ai < 2; ++ai)
#pragma unroll
            for (int m = 0; m < 4; ++m) { const int row = row0 + ai * 128 + m * 16; bf16* rowp = O + (size_t)row * PP + col0;
#pragma unroll
                for (int bj = 0; bj < 2; ++bj) { if (u.pn == 13 && bj == 1) continue;
                    const f32x4 v0 = acc[ai][bj][m][0], v1 = acc[ai][bj][m][1];
                    v4u w; w.x = pk2(v0[0], v0[1]); w.y = pk2(v0[2], v0[3]); w.z = pk2(v1[0], v1[1]); w.w = pk2(v1[2], v1[3]);
                    if (u.pn == 12 && bj == 1) { const int cv = wc * 32 + 8 * fq; *(v4u*)(VCp + ((size_t)(cv >> 6) * NTOK + row) * 64 + (cv & 63)) = w; }
                    else *(v4u*)(rowp + bj * 128) = w; } }
    }
};
struct EpiRowScale {
    static constexpr bool PERM = true, AFTER_DRAIN = false, RESCALE = true;
    bf16* O; int ldc; const LAS float* Rl;
    __device__ __forceinline__ void rescale(f32x4 (&acc)[2][2][4][2], int ui, int t, int wr, int fr) const {
        const LAS float* rp = Rl + (size_t)ui * 1024 + (wr * 64 + fr) * 4 + (t == 8 ? 0 : 1);
#pragma unroll
        for (int ai = 0; ai < 2; ++ai)
#pragma unroll
            for (int m = 0; m < 4; ++m) { const float f = rp[(ai * 128 + m * 16) * 4];
#pragma unroll
                for (int bj = 0; bj < 2; ++bj)
#pragma unroll
                    for (int n = 0; n < 2; ++n) acc[ai][bj][m][n] = acc[ai][bj][m][n] * f; }
    }
    __device__ __forceinline__ void fin(const f32x4 (&acc)[2][2][4][2], const pg8::Unit& u, int ui, int wr, int wc, int fr, int fq) const {
        const int row0 = u.pm * 256 + wr * 64 + fr, col0 = u.pn * 256 + wc * 32 + 8 * fq; const LAS float* rp = Rl + (size_t)ui * 1024 + (wr * 64 + fr) * 4 + 2;
#pragma unroll
        for (int ai = 0; ai < 2; ++ai)
#pragma unroll
            for (int m = 0; m < 4; ++m) { bf16* rowp = O + (size_t)(row0 + ai * 128 + m * 16) * ldc + col0; const float scale = rp[(ai * 128 + m * 16) * 4];
#pragma unroll
                for (int bj = 0; bj < 2; ++bj) { const f32x4 v0 = acc[ai][bj][m][0] * scale, v1 = acc[ai][bj][m][1] * scale;
                    v4u w; w.x = pk2(v0[0], v0[1]); w.y = pk2(v0[2], v0[3]); w.z = pk2(v1[0], v1[1]); w.w = pk2(v1[2], v1[3]);
                    *(v4u*)(rowp + bj * 128) = w; } }
    }
    __device__ __forceinline__ void operator()(const f32x4 (&acc)[2][2][4][2], const pg8::Unit& u, int wr, int wc, int fr, int fq) const {}
};
struct EpiSwiglu {
    static constexpr bool PERM = true, AFTER_DRAIN = false, RESCALE = false;
    bf16* O; int ldc; const float* rs;
    __device__ __forceinline__ void operator()(const f32x4 (&acc)[2][2][4][2], const pg8::Unit& u, int wr, int wc, int fr, int fq) const {
        const int row0 = u.pm * 256 + wr * 64 + fr, col0 = u.pn * 128 + wc * 32 + 8 * fq;
#pragma unroll
        for (int ai = 0; ai < 2; ++ai)
#pragma unroll
            for (int m = 0; m < 4; ++m) { bf16* rowp = O + (size_t)(row0 + ai * 128 + m * 16) * ldc + col0; float h[8]; const float sc = rs[row0 + ai * 128 + m * 16];
#pragma unroll
                for (int n = 0; n < 2; ++n)
#pragma unroll
                    for (int i = 0; i < 4; ++i) { const float g = acc[ai][0][m][n][i] * sc, up = acc[ai][1][m][n][i] * sc; h[4 * n + i] = g * __builtin_amdgcn_rcpf(1.f + ex2(-g * LOG2E)) * up; }
                v4u w; w.x = pk2(h[0], h[1]); w.y = pk2(h[2], h[3]); w.z = pk2(h[4], h[5]); w.w = pk2(h[6], h[7]);
                *(v4u*)rowp = w; }
    }
};

__device__ __forceinline__ void tr_item(const float* W, int pitch, int k0, int ncol0, bf16* WT, int dstK, int drow0, LAS float* scr, int lane, const float* gk = nullptr) {
    float tv[32];
#pragma unroll
    for (int i = 0; i < 32; ++i) { const int kk = 2 * i + (lane >> 5); tv[i] = W[(size_t)(k0 + kk) * pitch + ncol0 + (lane & 31)]; if (gk) tv[i] *= gk[kk]; }
#pragma unroll
    for (int i = 0; i < 32; ++i) { const int kk = 2 * i + (lane >> 5); scr[kk * 33 + (lane & 31)] = tv[i]; }
    LDS_WAIT(); asm volatile("" ::: "memory");
    const int c = lane & 7;
#pragma unroll
    for (int j = 0; j < 4; ++j) { const int n = (lane >> 3) + 8 * j; const LAS float* s = scr + (8 * c) * 33 + n;
        v4u o; o.x = pk2(s[0 * 33], s[1 * 33]); o.y = pk2(s[2 * 33], s[3 * 33]); o.z = pk2(s[4 * 33], s[5 * 33]); o.w = pk2(s[6 * 33], s[7 * 33]);
        *(v4u*)(WT + (size_t)(drow0 + n) * dstK + k0 + 8 * c) = o; }
    LDS_WAIT(); asm volatile("" ::: "memory");
}

constexpr int XSPLIT = 61440;
template <int RB> __device__ __forceinline__ void norm_rows(const float* xp, const float* xs, const bf16* xb_in0, const bf16* xb_in1, const bf16* RAW, const float* gpost, float* out, bf16* xb_out0, bf16* xb_out1,
                                                            const float* gpre, bf16* XN, float* rs_out, int gw, int NGW, int lane) {
    for (int tb = gw; tb < NTOK; tb += NGW * RB) {
        f32x4 v[RB][4]; v2u rw[RB][4];
#pragma unroll
        for (int k = 0; k < RB; ++k) { const int t = tb + k * NGW; if (t < NTOK) {
            if (xp) { const float* base = xrow(xp, xs, t);
#pragma unroll
                for (int j = 0; j < 4; ++j) v[k][j] = ((const f32x4*)base)[lane + 64 * j]; }
            else { const bf16* base = t < XSPLIT ? xb_in0 + (size_t)t * 1024 : xb_in1 + (size_t)(t - XSPLIT) * 1024;
#pragma unroll
                for (int j = 0; j < 4; ++j) { const v2u w = *(const v2u*)(base + 4 * (lane + 64 * j)); v[k][j] = (f32x4){bflo(w.x), bfhi(w.x), bflo(w.y), bfhi(w.y)}; } }
            if (RAW) {
#pragma unroll
                for (int j = 0; j < 4; ++j) rw[k][j] = *(const v2u*)(RAW + (size_t)t * 1024 + 4 * (lane + 64 * j)); } } }
#pragma unroll
        for (int k = 0; k < RB; ++k) { const int t = tb + k * NGW; if (t < NTOK) {
            if (RAW) {
                f32x4 r[4]; float ss = 0.f;
#pragma unroll
                for (int j = 0; j < 4; ++j) { const v2u w = rw[k][j]; r[j] = (f32x4){bflo(w.x), bfhi(w.x), bflo(w.y), bfhi(w.y)};
                    ss += (r[j].x * r[j].x + r[j].y * r[j].y) + (r[j].z * r[j].z + r[j].w * r[j].w); }
                const float rstd = 1.0f / sqrtf(wave_sum(ss) * (1.f / 1024.f) + EPSN);
#pragma unroll
                for (int j = 0; j < 4; ++j) { const f32x4 g = ((const f32x4*)gpost)[lane + 64 * j]; v[k][j] = v[k][j] + r[j] * rstd * g; }
            }
            if (out) {
#pragma unroll
                for (int j = 0; j < 4; ++j) ((f32x4*)(out + (size_t)t * 1024))[lane + 64 * j] = v[k][j]; }
            if (xb_out0) { bf16* ob = t < XSPLIT ? xb_out0 + (size_t)t * 1024 : xb_out1 + (size_t)(t - XSPLIT) * 1024;
#pragma unroll
                for (int j = 0; j < 4; ++j) { v2u w; w.x = pk2(v[k][j].x, v[k][j].y); w.y = pk2(v[k][j].z, v[k][j].w); *(v2u*)(ob + 4 * (lane + 64 * j)) = w; } }
            if (XN || rs_out) {
                float s2 = 0.f;
#pragma unroll
                for (int j = 0; j < 4; ++j) s2 += (v[k][j].x * v[k][j].x + v[k][j].y * v[k][j].y) + (v[k][j].z * v[k][j].z + v[k][j].w * v[k][j].w);
                const float rstd2 = 1.0f / sqrtf(wave_sum(s2) * (1.f / 1024.f) + EPSN);
                if (rs_out && lane == 0) rs_out[t] = rstd2;
                if (XN) {
#pragma unroll
                for (int j = 0; j < 4; ++j) { const f32x4 g = ((const f32x4*)gpre)[lane + 64 * j]; const f32x4 o = v[k][j] * rstd2 * g;
                    v2u w; w.x = pk2(o.x, o.y); w.y = pk2(o.z, o.w); *(v2u*)(XN + (size_t)t * 1024 + 4 * (lane + 64 * j)) = w; } }
            } } }
    }
}

template <int NCH  > __device__ __forceinline__ void lds_transpose128(const bf16* src, int pitch, LAS unsigned char* dst, int tid) {
#pragma unroll
    for (int rep = 0; rep < NCH / 8; ++rep) { const int it = tid + 512 * rep, i = it & 63, ch = it >> 6;
        const bf16* p = src + (size_t)(2 * i) * pitch + ch * 8; const v4u r0 = *(const v4u*)p, r1 = *(const v4u*)(p + pitch);
#pragma unroll
        for (int j = 0; j < 8; ++j) { const unsigned a = r0[j >> 1], b = r1[j >> 1]; const unsigned lo = (j & 1) ? (a >> 16) : (a & 0xffffu), hi = (j & 1) ? (b & 0xffff0000u) : (b << 16);
            *(LAS unsigned*)(dst + (ch * 8 + j) * 272 + 4 * i) = lo | hi; } }
}
__device__ __forceinline__ void lds_copy128(const bf16* src, int pitch, LAS unsigned char* dst, int tid) {
#pragma unroll
    for (int rep = 0; rep < 4; ++rep) { const int it = tid + 512 * rep, r = it >> 4, ch = it & 15; *(LAS v4u*)(dst + r * 272 + ch * 16) = *(const v4u*)(src + (size_t)r * pitch + ch * 8); }
}
__device__ __forceinline__ bf16x8 scale8(v4u x, f32x4 w0, f32x4 w1) {
    v4u o; o.x = pk2(bflo(x.x) * w0.x, bfhi(x.x) * w0.y); o.y = pk2(bflo(x.y) * w0.z, bfhi(x.y) * w0.w); o.z = pk2(bflo(x.z) * w1.x, bfhi(x.z) * w1.y); o.w = pk2(bflo(x.w) * w1.z, bfhi(x.w) * w1.w);
    return __builtin_bit_cast(bf16x8, o);
}
__device__ __forceinline__ bf16x8 scale8s(v4u x, float w) {
    v4u o; o.x = pk2(bflo(x.x) * w, bfhi(x.x) * w); o.y = pk2(bflo(x.y) * w, bfhi(x.y) * w); o.z = pk2(bflo(x.z) * w, bfhi(x.z) * w); o.w = pk2(bflo(x.w) * w, bfhi(x.w) * w);
    return __builtin_bit_cast(bf16x8, o);
}

__device__ __forceinline__ void ssdA_load(const bf16* XBC, const float* DT, const float* CS, int u, int tid, v4u (&pb)[2][2], v4u (&px)[4][2], float (&pw)[2][3]) {
    const int c = u >> 2, g = (u >> 1) & 1, hh = u & 1, h0 = 8 * g + 4 * hh; const size_t tok0 = (size_t)c * 128;
#pragma unroll
    for (int rep = 0; rep < 2; ++rep) { const int it = tid + 512 * rep, i = it & 63, ch = it >> 6; const bf16* p = XBC + (tok0 + 2 * i) * 1536 + 1024 + g * 128 + ch * 8; pb[rep][0] = *(const v4u*)p; pb[rep][1] = *(const v4u*)(p + 1536); }
#pragma unroll
    for (int rep = 0; rep < 4; ++rep) { const int it = tid + 512 * rep, i = it & 63, ch = it >> 6; const bf16* p = XBC + (tok0 + 2 * i) * 1536 + h0 * 64 + ch * 8; px[rep][0] = *(const v4u*)p; px[rep][1] = *(const v4u*)(p + 1536); }
#pragma unroll
    for (int rep = 0; rep < 2; ++rep) { const int idx = tid + 512 * rep, hd = idx >> 8, dir = (idx >> 7) & 1, s = idx & 127, j = dir * 16 + h0 + hd;
        pw[rep][0] = CS[(tok0 + s) * 32 + j]; pw[rep][1] = CS[(tok0 + (dir ? 0 : 127)) * 32 + j]; pw[rep][2] = DT[(tok0 + s) * 32 + j]; }
}
__device__ __forceinline__ void tr_write(LAS unsigned char* dst, int ch, int i, v4u r0, v4u r1) {
#pragma unroll
    for (int j = 0; j < 8; ++j) { const unsigned a = r0[j >> 1], b = r1[j >> 1]; const unsigned lo = (j & 1) ? (a >> 16) : (a & 0xffffu), hi = (j & 1) ? (b & 0xffff0000u) : (b << 16);
        *(LAS unsigned*)(dst + (ch * 8 + j) * 272 + 4 * i) = lo | hi; }
}
__device__ __forceinline__ void ssd_states(LAS unsigned char* lds, const bf16* XBC, const float* DT, const float* CS, bf16* ST, int vcu, int G, int tid0) {
    const int wave = __builtin_amdgcn_readfirstlane(tid0 >> 6);
    LAS unsigned char* BT = lds; LAS unsigned char* XT = lds + 34816; LAS float* Wv = (LAS float*)(lds + 34816 + 69632);
    v4u pb[2][2], px[4][2]; float pw[2][3];
    if (vcu < 4 * NCHUNK) ssdA_load(XBC, DT, CS, vcu, tid0, pb, px, pw);
    for (int u = vcu; u < 4 * NCHUNK; u += G) {
        int tid = tid0; asm volatile("" : "+v"(tid));
        const int lane = tid & 63, fr = lane & 15, fq = lane >> 4;
        const int c = u >> 2, g = (u >> 1) & 1, hh = u & 1, h0 = 8 * g + 4 * hh;
#pragma unroll
        for (int rep = 0; rep < 2; ++rep) { const int it = tid + 512 * rep; tr_write(BT, it >> 6, it & 63, pb[rep][0], pb[rep][1]); }
#pragma unroll
        for (int rep = 0; rep < 4; ++rep) { const int it = tid + 512 * rep; tr_write(XT, it >> 6, it & 63, px[rep][0], px[rep][1]); }
#pragma unroll
        for (int rep = 0; rep < 2; ++rep) Wv[tid + 512 * rep] = ex2(pw[rep][1] - pw[rep][0]) * pw[rep][2];
        LBAR();
        if (u + G < 4 * NCHUNK) ssdA_load(XBC, DT, CS, u + G, tid, pb, px, pw);
        const int hd = wave >> 1, dir = wave & 1;
        f32x4 acc[8][4];
#pragma unroll
        for (int a = 0; a < 8; ++a)
#pragma unroll
            for (int b = 0; b < 4; ++b) acc[a][b] = (f32x4){0.f, 0.f, 0.f, 0.f};
#pragma unroll 1
        for (int ks = 0; ks < 4; ++ks) {
            const LAS float* wp = Wv + (hd * 2 + dir) * 128 + ks * 32 + fq * 8; const f32x4 w0 = *(const LAS f32x4*)wp, w1 = *(const LAS f32x4*)(wp + 4);
            bf16x8 bfr[4];
#pragma unroll
            for (int pt = 0; pt < 4; ++pt) bfr[pt] = scale8(*(const LAS v4u*)(XT + (hd * 64 + pt * 16 + fr) * 272 + (ks * 32 + fq * 8) * 2), w0, w1);
#pragma unroll
            for (int nt = 0; nt < 8; ++nt) { const bf16x8 a = *(const LAS bf16x8*)(BT + (nt * 16 + fr) * 272 + (ks * 32 + fq * 8) * 2);
#pragma unroll
                for (int pt = 0; pt < 4; ++pt) acc[nt][pt] = mfma16(a, bfr[pt], acc[nt][pt]); }
        }
        bf16* dst = ST + ((size_t)(c * 2 + dir) * 16 + (h0 + hd)) * 8192;
#pragma unroll
        for (int nt = 0; nt < 8; ++nt)
#pragma unroll
            for (int pt = 0; pt < 4; ++pt) { v2u w; w.x = pk2(acc[nt][pt][0], acc[nt][pt][1]); w.y = pk2(acc[nt][pt][2], acc[nt][pt][3]); *(v2u*)(dst + (pt * 16 + fr) * 128 + nt * 16 + fq * 4) = w; }
        LBAR();
    }
}

__device__ __forceinline__ void ssd_pass(bf16* ST, const float* DEC, int gtid, int NT_) {
    for (int it = gtid; it < 18 * 16384; it += NT_) {
        const int itx = it + 262144 < 18 * 16384 ? it + 262144 : it + 262144 - 18 * 16384;
        const int sd = itx >> 14, v = itx & 16383, s = sd >> 1, dir = sd & 1, head = v >> 10;
        const int c0 = s == 0 ? 0 : 128 + (s - 1) * 64, nc = s == 0 ? 128 : 64;
        float h[8];
#pragma unroll
        for (int k = 0; k < 8; ++k) h[k] = 0.f;
        for (int i = 0; i < nc; i += 8) {
            v4u sv[8]; float d[8]; bf16* pp[8];
#pragma unroll
            for (int q = 0; q < 8; ++q) { const int c = dir ? (c0 + nc - 1 - (i + q)) : (c0 + i + q); pp[q] = ST + ((size_t)(c * 2 + dir) * 16) * 8192 + (size_t)v * 8; sv[q] = *(const v4u*)pp[q]; d[q] = DEC[c * 32 + dir * 16 + head]; }
#pragma unroll
            for (int q = 0; q < 8; ++q) { v4u o; o.x = pk2(h[0], h[1]); o.y = pk2(h[2], h[3]); o.z = pk2(h[4], h[5]); o.w = pk2(h[6], h[7]); *(v4u*)pp[q] = o;
                h[0] = d[q] * h[0] + bflo(sv[q].x); h[1] = d[q] * h[1] + bfhi(sv[q].x); h[2] = d[q] * h[2] + bflo(sv[q].y); h[3] = d[q] * h[3] + bfhi(sv[q].y);
                h[4] = d[q] * h[4] + bflo(sv[q].z); h[5] = d[q] * h[5] + bfhi(sv[q].z); h[6] = d[q] * h[6] + bflo(sv[q].w); h[7] = d[q] * h[7] + bfhi(sv[q].w); }
        }
    }
}

__device__ __forceinline__ void ssd_out(LAS unsigned char* lds, const bf16* XBC, const float* DT, const float* CS, const bf16* ST, bf16* PROJ, const float* dskip, float* SSQS, int vcu, int G, int tid0) {
    const int wave = __builtin_amdgcn_readfirstlane(tid0 >> 6);
    LAS unsigned char* Cm = lds; LAS unsigned char* CBm = lds + 34816; LAS unsigned char* XT = lds + 69632; LAS float* Vv = (LAS float*)(lds + 69632 + 69632);
    for (int u = vcu; u < 4 * NCHUNK; u += G) {
        int tid = tid0; asm volatile("" : "+v"(tid));
        const int c = u >> 2, g = (u >> 1) & 1, hh = u & 1, h0 = 8 * g + 4 * hh; const size_t tok0 = (size_t)c * 128;
        v4u pc[4], pbn[4]; float pv[4];
#pragma unroll
        for (int rep = 0; rep < 4; ++rep) { const int it = tid + 512 * rep, r = it >> 4, ch = it & 15; const bf16* p = XBC + (tok0 + r) * 1536 + 1024 + g * 128 + ch * 8; pbn[rep] = *(const v4u*)p; pc[rep] = *(const v4u*)(p + 256); }
#pragma unroll
        for (int rep = 0; rep < 4; ++rep) { const int idx = tid + 512 * rep, hd = idx >> 9, kind = (idx >> 7) & 3, s = idx & 127, j = (kind & 1) * 16 + h0 + hd; pv[rep] = (kind < 2 ? CS : DT)[(tok0 + s) * 32 + j]; }
#pragma unroll
        for (int rep = 0; rep < 4; ++rep) { const int it = tid + 512 * rep, r = it >> 4, ch = it & 15; *(LAS v4u*)(Cm + r * 272 + ch * 16) = pc[rep]; *(LAS v4u*)(XT + r * 272 + ch * 16) = pbn[rep]; Vv[it] = pv[rep]; }
        LBAR();
        asm volatile("" : "+v"(tid));
        int lane = tid & 63, fr = lane & 15, fq = lane >> 4;
        {
            f32x4 cb[8];
#pragma unroll
            for (int st = 0; st < 8; ++st) cb[st] = (f32x4){0.f, 0.f, 0.f, 0.f};
#pragma unroll
            for (int ks = 0; ks < 4; ++ks) { const bf16x8 cf = *(const LAS bf16x8*)(Cm + (wave * 16 + fr) * 272 + (ks * 32 + fq * 8) * 2);
#pragma unroll
                for (int st = 0; st < 8; ++st) { const bf16x8 bfg = *(const LAS bf16x8*)(XT + (st * 16 + fr) * 272 + (ks * 32 + fq * 8) * 2); cb[st] = mfma16(bfg, cf, cb[st]); } }
#pragma unroll
            for (int st = 0; st < 8; ++st) { v2u w; w.x = pk2(cb[st][0], cb[st][1]); w.y = pk2(cb[st][2], cb[st][3]); *(LAS v2u*)(CBm + (wave * 16 + fr) * 272 + (st * 16 + fq * 4) * 2) = w; }
        }
        LBAR();
        asm volatile("" : "+v"(tid));
#pragma unroll
        for (int rep = 0; rep < 4; ++rep) { const int it = tid + 512 * rep, i = it & 63, ch = it >> 6; const bf16* p = XBC + (tok0 + 2 * i) * 1536 + h0 * 64 + ch * 8; tr_write(XT, ch, i, *(const v4u*)p, *(const v4u*)(p + 1536)); }
        LBAR();
        asm volatile("" : "+v"(tid)); lane = tid & 63; fr = lane & 15; fq = lane >> 4;
        const int hd = wave >> 1, lh = wave & 1, h = h0 + hd;
        const LAS float* csf = Vv + hd * 512, *csb = csf + 128, *dtf = csf + 256, *dtb = csf + 384;
        bf16x8 hf[4][4], hbk[4][4];
        f32x4 acc[4][4];
#pragma unroll
        for (int a = 0; a < 4; ++a)
#pragma unroll
            for (int b = 0; b < 4; ++b) acc[a][b] = (f32x4){0.f, 0.f, 0.f, 0.f};
        float csf_l[4], csb_l[4];
#pragma unroll
        for (int lt = 0; lt < 4; ++lt) { const int l = 16 * (4 * lh + lt) + fr; csf_l[lt] = csf[l]; csb_l[lt] = csb[l]; }
#pragma unroll 1
        for (int ks = 0; ks < 4; ++ks) {
            bf16x8 xb[4];
#pragma unroll
            for (int pt = 0; pt < 4; ++pt) xb[pt] = *(const LAS bf16x8*)(XT + (hd * 64 + pt * 16 + fr) * 272 + (ks * 32 + fq * 8) * 2);
            const int s0 = ks * 32 + fq * 8;
            const f32x4 sf0 = *(const LAS f32x4*)(csf + s0), sf1 = *(const LAS f32x4*)(csf + s0 + 4), sb0 = *(const LAS f32x4*)(csb + s0), sb1 = *(const LAS f32x4*)(csb + s0 + 4);
            const f32x4 df0 = *(const LAS f32x4*)(dtf + s0), df1 = *(const LAS f32x4*)(dtf + s0 + 4), db0 = *(const LAS f32x4*)(dtb + s0), db1 = *(const LAS f32x4*)(dtb + s0 + 4);
#pragma unroll
            for (int lt = 0; lt < 4; ++lt) { const int l = 16 * (4 * lh + lt) + fr;
                const v4u cbw = *(const LAS v4u*)(CBm + l * 272 + s0 * 2); float m[8];
                const int Lt = 4 * lh + lt; const bool allf = (32 * ks + 31 < 16 * Lt), allb = (32 * ks > 16 * Lt + 15);
                if (allf) {
#pragma unroll
                    for (int j = 0; j < 8; ++j) { const float sfj = j < 4 ? sf0[j & 3] : sf1[j & 3], dfj = j < 4 ? df0[j & 3] : df1[j & 3]; const unsigned cw = cbw[j >> 1]; m[j] = ((j & 1) ? bfhi(cw) : bflo(cw)) * (ex2(csf_l[lt] - sfj) * dfj); }
                } else if (allb) {
#pragma unroll
                    for (int j = 0; j < 8; ++j) { const float sbj = j < 4 ? sb0[j & 3] : sb1[j & 3], dbj = j < 4 ? db0[j & 3] : db1[j & 3]; const unsigned cw = cbw[j >> 1]; m[j] = ((j & 1) ? bfhi(cw) : bflo(cw)) * (ex2(csb_l[lt] - sbj) * dbj); }
                } else {
#pragma unroll
                    for (int j = 0; j < 8; ++j) { const int s = s0 + j; const float sfj = j < 4 ? sf0[j & 3] : sf1[j & 3], sbj = j < 4 ? sb0[j & 3] : sb1[j & 3], dfj = j < 4 ? df0[j & 3] : df1[j & 3], dbj = j < 4 ? db0[j & 3] : db1[j & 3];
                        const float mf = (s <= l) ? ex2(csf_l[lt] - sfj) * dfj : 0.f, mb = (s >= l) ? ex2(csb_l[lt] - sbj) * dbj : 0.f;
                        const unsigned cw = cbw[j >> 1]; m[j] = ((j & 1) ? bfhi(cw) : bflo(cw)) * (mf + mb); }
                }
                v4u mw; mw.x = pk2(m[0], m[1]); mw.y = pk2(m[2], m[3]); mw.z = pk2(m[4], m[5]); mw.w = pk2(m[6], m[7]); const bf16x8 a = __builtin_bit_cast(bf16x8, mw);
#pragma unroll
                for (int pt = 0; pt < 4; ++pt) acc[lt][pt] = mfma16(a, xb[pt], acc[lt][pt]); }
        }
        { const bf16* Hp = ST + ((size_t)(c * 2 + 0) * 16 + h) * 8192 + fr * 128 + fq * 8;
#pragma unroll
          for (int ks = 0; ks < 4; ++ks)
#pragma unroll
            for (int pt = 0; pt < 4; ++pt) hf[ks][pt] = *(const bf16x8*)(Hp + pt * 2048 + ks * 32); }
        { float e_l[4];
#pragma unroll
          for (int lt = 0; lt < 4; ++lt) e_l[lt] = ex2(csf_l[lt]);
#pragma unroll
          for (int ks = 0; ks < 4; ++ks) {
#pragma unroll
            for (int lt = 0; lt < 4; ++lt) { const int l = 16 * (4 * lh + lt) + fr; const bf16x8 a = scale8s(*(const LAS v4u*)(Cm + l * 272 + (ks * 32 + fq * 8) * 2), e_l[lt]);
#pragma unroll
                for (int pt = 0; pt < 4; ++pt) acc[lt][pt] = mfma16(a, hf[ks][pt], acc[lt][pt]); }
            __builtin_amdgcn_sched_barrier(0);
            if (ks >= 1 && ks <= 2) {
                const bf16* Hp = ST + ((size_t)(c * 2 + 1) * 16 + h) * 8192 + fr * 128 + fq * 8;
#pragma unroll
                for (int k2 = 2 * (ks - 1); k2 < 2 * (ks - 1) + 2; ++k2)
#pragma unroll
                    for (int pt = 0; pt < 4; ++pt) hbk[k2][pt] = *(const bf16x8*)(Hp + pt * 2048 + k2 * 32);
                __builtin_amdgcn_sched_barrier(0); } } }
        { float e_l[4];
#pragma unroll
          for (int lt = 0; lt < 4; ++lt) e_l[lt] = ex2(csb_l[lt]);
#pragma unroll
          for (int ks = 0; ks < 4; ++ks) {
#pragma unroll
            for (int lt = 0; lt < 4; ++lt) { const int l = 16 * (4 * lh + lt) + fr; const bf16x8 a = scale8s(*(const LAS v4u*)(Cm + l * 272 + (ks * 32 + fq * 8) * 2), e_l[lt]);
#pragma unroll
                for (int pt = 0; pt < 4; ++pt) acc[lt][pt] = mfma16(a, hbk[ks][pt], acc[lt][pt]); }
            __builtin_amdgcn_sched_barrier(0);
 } }
        LBAR();
        LAS unsigned char* ZT = lds;
#pragma unroll
        for (int rep = 0; rep < 8; ++rep) { const int it = tid + 512 * rep, r = it >> 5, ch = it & 31; *(LAS v4u*)(ZT + r * 528 + ch * 16) = *(const v4u*)(PROJ + (tok0 + r) * PP + h0 * 64 + ch * 8); }
        LBAR();
        asm volatile("" : "+v"(tid)); lane = tid & 63; fr = lane & 15; fq = lane >> 4;
        const float dsk = dskip[h];
#pragma unroll
        for (int lt = 0; lt < 4; ++lt) {
#pragma unroll
            for (int pt = 0; pt < 4; ++pt) { const int lb = 16 * (4 * lh + lt) + 4 * fq, p = pt * 16 + fr;
                const v2u xw = *(const LAS v2u*)(XT + (hd * 64 + p) * 272 + lb * 2); const float xv[4] = {bflo(xw.x), bfhi(xw.x), bflo(xw.y), bfhi(xw.y)};
#pragma unroll
                for (int r = 0; r < 4; ++r) { LAS bf16* zp = (LAS bf16*)(ZT + (lb + r) * 528 + (hd * 64 + p) * 2); const float z = bf1(*zp); const float y = (acc[lt][pt][r] + xv[r] * dsk) * z * __builtin_amdgcn_rcpf(1.f + ex2(-z * LOG2E)); *zp = (bf16)f2bf(y); } }
            __builtin_amdgcn_sched_barrier(0); }
        LBAR();
#pragma unroll
        for (int rep = 0; rep < 8; ++rep) { const int it = tid + 512 * rep, r = it >> 5, ch = it & 31; const v4u yv = *(const LAS v4u*)(ZT + r * 528 + ch * 16); *(v4u*)(PROJ + (tok0 + r) * PP + h0 * 64 + ch * 8) = yv;
            float q = (bflo(yv.x) * bflo(yv.x) + bfhi(yv.x) * bfhi(yv.x)) + (bflo(yv.y) * bflo(yv.y) + bfhi(yv.y) * bfhi(yv.y)) + (bflo(yv.z) * bflo(yv.z) + bfhi(yv.z) * bfhi(yv.z)) + (bflo(yv.w) * bflo(yv.w) + bfhi(yv.w) * bfhi(yv.w));
            q += __shfl_xor(q, 1); q += __shfl_xor(q, 2); q += __shfl_xor(q, 4); q += __shfl_xor(q, 8); q += __shfl_xor(q, 16);
            if (ch == 0) SSQS[(tok0 + r) * 4 + g * 2 + hh] = q; }
        LBAR();
    }
}

__device__ __forceinline__ void xa_scores(const LAS unsigned char* Kl, const bf16* qrow, int fr, int fq, v4u (&pa)[8], float& sum) {
    bf16x8 qf[4];
#pragma unroll
    for (int ks = 0; ks < 4; ++ks) qf[ks] = *(const bf16x8*)(qrow + 32 * ks);
    f32x4 s[16];
#pragma unroll
    for (int mt = 0; mt < 16; ++mt) { s[mt] = (f32x4){0.f, 0.f, 0.f, 0.f};
#pragma unroll
        for (int ks = 0; ks < 4; ++ks) s[mt] = mfma16(*(const LAS bf16x8*)(Kl + (mt * 16 + fr) * 272 + (ks * 32 + fq * 8) * 2), qf[ks], s[mt]);
        if (mt & 1) __builtin_amdgcn_sched_barrier(0); }
    float mx = -3.0e38f;
#pragma unroll
    for (int mt = 0; mt < 16; ++mt) mx = fmaxf(fmaxf(mx, fmaxf(s[mt][0], s[mt][1])), fmaxf(s[mt][2], s[mt][3]));
    mx = fmaxf(mx, __shfl_xor(mx, 16)); mx = fmaxf(mx, __shfl_xor(mx, 32));
    float sm = 0.f;
#pragma unroll
    for (int mt = 0; mt < 16; ++mt)
#pragma unroll
        for (int r = 0; r < 4; ++r) { const float e = ex2(s[mt][r] - mx); s[mt][r] = e; sm += e; }
    sm += __shfl_xor(sm, 16); sm += __shfl_xor(sm, 32); sum = sm;
#pragma unroll
    for (int kk = 0; kk < 8; ++kk) { v4u pw; pw.x = pk2(s[2 * kk][0], s[2 * kk][1]); pw.y = pk2(s[2 * kk][2], s[2 * kk][3]); pw.z = pk2(s[2 * kk + 1][0], s[2 * kk + 1][1]); pw.w = pk2(s[2 * kk + 1][2], s[2 * kk + 1][3]); pa[kk] = pw; }
    __builtin_amdgcn_sched_barrier(0);
}
__device__ __forceinline__ void xattn(LAS unsigned char* lds, const bf16* Q2, const bf16* MKV, bf16* CA, int vcu, int G, int tid0) {
    const int wave = __builtin_amdgcn_readfirstlane(tid0 >> 6);
    LAS unsigned char* Kl = lds; LAS unsigned char* VT = lds + 69632;
    const int per = (1280 + G - 1) / G; int loaded = -1;
    const int u1 = (vcu + 1) * per < 1280 ? (vcu + 1) * per : 1280;
    for (int u = vcu * per; u < u1; ++u) {
        int tid = tid0; asm volatile("" : "+v"(tid));
        const int lane = tid & 63, fr = lane & 15, fq = lane >> 4;
        int seq, head, tile;
        if (u < 256) { seq = 0; head = u >> 6; tile = u & 63; } else { const int u2 = u - 256, pr = u2 >> 5; seq = 1 + (pr >> 2); head = pr & 3; tile = u2 & 31; }
        const int key = seq * 4 + head;
        if (key != loaded) {
            __syncthreads();
            const bf16* Kg = MKV + (size_t)(seq * 256) * 1024 + head * 128; const bf16* Vg = Kg + 512;
#pragma unroll
            for (int rep = 0; rep < 8; ++rep) { const int it = tid + 512 * rep, m = it >> 4, ch = it & 15; *(LAS v4u*)(Kl + m * 272 + ch * 16) = *(const v4u*)(Kg + (size_t)m * 1024 + ch * 8); }
#pragma unroll
            for (int rep = 0; rep < 4; ++rep) { const int it = tid + 512 * rep, i = it & 127, ch = it >> 7;
                const bf16* p = Vg + (size_t)(2 * i) * 1024 + ch * 8; const v4u r0 = *(const v4u*)p, r1 = *(const v4u*)(p + 1024);
#pragma unroll
                for (int j = 0; j < 8; ++j) { const unsigned a = r0[j >> 1], b = r1[j >> 1]; const unsigned lo = (j & 1) ? (a >> 16) : (a & 0xffffu), hi = (j & 1) ? (b & 0xffff0000u) : (b << 16);
                    *(LAS unsigned*)(VT + (ch * 8 + j) * 528 + 4 * i) = lo | hi; } }
            __syncthreads(); loaded = key;
        }
        const int tokb = (seq == 0 ? 0 : 16384 + (seq - 1) * 8192) + tile * 256 + wave * 32;
        v4u pa[2][8]; float sum[2];
#pragma unroll
        for (int itr = 0; itr < 2; ++itr) xa_scores(Kl, Q2 + (size_t)(tokb + 16 * itr + fr) * 512 + head * 128 + fq * 8, fr, fq, pa[itr], sum[itr]);
        f32x4 o[2][8];
#pragma unroll
        for (int itr = 0; itr < 2; ++itr)
#pragma unroll
            for (int dt = 0; dt < 8; ++dt) o[itr][dt] = (f32x4){0.f, 0.f, 0.f, 0.f};
#pragma unroll
        for (int kk = 0; kk < 8; ++kk) {
#pragma unroll
            for (int dt = 0; dt < 8; ++dt) { const LAS unsigned char* vp = VT + (dt * 16 + fr) * 528 + (kk * 32 + fq * 4) * 2; const v2u lo = *(const LAS v2u*)vp, hi = *(const LAS v2u*)(vp + 32);
                v4u vw; vw.x = lo.x; vw.y = lo.y; vw.z = hi.x; vw.w = hi.y; const bf16x8 vb = __builtin_bit_cast(bf16x8, vw);
                o[0][dt] = mfma16(vb, __builtin_bit_cast(bf16x8, pa[0][kk]), o[0][dt]); o[1][dt] = mfma16(vb, __builtin_bit_cast(bf16x8, pa[1][kk]), o[1][dt]); }
            __builtin_amdgcn_sched_barrier(0);
        }
#pragma unroll
        for (int itr = 0; itr < 2; ++itr) { const int l0 = tokb + 16 * itr; const float inv = 1.0f / sum[itr]; bf16* cp = CA + (size_t)(l0 + fr) * 512 + head * 128 + fq * 4;
#pragma unroll
            for (int dt = 0; dt < 8; ++dt) { v2u w; w.x = pk2(o[itr][dt][0] * inv, o[itr][dt][1] * inv); w.y = pk2(o[itr][dt][2] * inv, o[itr][dt][3] * inv); *(v2u*)(cp + dt * 16) = w; } }
    }
}

typedef __attribute__((address_space(1))) unsigned gu32;
#define RLX_AGENT __ATOMIC_RELAXED, __HIP_MEMORY_SCOPE_AGENT
#define XB_TMO      128
#define XB_XCNT(j)  (256  + 64 * (j))
#define XB_XSUB(j)  (1280 + 64 * (j))
#define XB_XGEN(j)  (2304 + 64 * (j))
#define XB_TOP      3328
#define XB_TOPGEN   3392
#define XCD_BAR_WORDS 3456
#define XB_SPIN_CAP (1u << 18)

__device__ __forceinline__ unsigned xb_ld(unsigned* p)              { return __hip_atomic_load(p, __ATOMIC_RELAXED, __HIP_MEMORY_SCOPE_AGENT); }
__device__ __forceinline__ unsigned xb_add(unsigned* p, unsigned v) { return __hip_atomic_fetch_add(p, v, __ATOMIC_RELAXED, __HIP_MEMORY_SCOPE_AGENT); }
__device__ __forceinline__ unsigned xb_xcc_id() { return (unsigned)__builtin_amdgcn_s_getreg((3 << 11) | 20) & 0xFu; }
#define XB_SPIN(cond, bar) do { unsigned _sp = 0; while (cond) { __builtin_amdgcn_s_sleep(1); \
    if ((++_sp & 255u) == 0u) { if (xb_ld(&(bar)[XB_TMO])) break; if (_sp > XB_SPIN_CAP) { atomicAdd(&(bar)[XB_TMO], 1u); break; } } } } while (0)

struct XcdBarrier {
    unsigned* bar; unsigned x;
    volatile LAS unsigned* st;
};

__device__ __forceinline__ XcdBarrier xcd_barrier_post(unsigned* bar, volatile LAS unsigned* st) {
    XcdBarrier b; b.bar = bar; b.x = xb_xcc_id(); b.st = st;
    if (threadIdx.x == 0) (void)xb_add(&bar[XB_XCNT(b.x)], 1u);
    return b;
}
__device__ __forceinline__ void xcd_barrier_complete(unsigned* bar, unsigned x, unsigned& nloc, unsigned& nx) {
    const unsigned G = gridDim.x * gridDim.y * gridDim.z;
    unsigned sum, cnt, mine, sp = 0u;
    for (;;) {
        sum = 0u; cnt = 0u; mine = 0u;
#pragma unroll
        for (unsigned j = 0; j < 16; ++j) { const unsigned c = xb_ld(&bar[XB_XCNT(j)]); sum += c; cnt += (c > 0u) ? 1u : 0u; mine = (j == x) ? c : mine; }
        if (sum == G) break;
        __builtin_amdgcn_s_sleep(1);
        if ((++sp & 255u) == 0u) { if (xb_ld(&bar[XB_TMO])) break; if (sp > XB_SPIN_CAP) { atomicAdd(&bar[XB_TMO], 1u); break; } }
    }
    nloc = mine > 0u ? mine : 1u; nx = cnt > 0u ? cnt : 1u;
}

__device__ __forceinline__ void xcd_barrier(const XcdBarrier& b) {
    asm volatile("s_waitcnt vmcnt(0)" ::: "memory");
    __syncthreads();
    if (threadIdx.x == 0) {
        unsigned* bar = b.bar;
        __builtin_amdgcn_s_waitcnt(0);
        unsigned nloc = b.st[0], nx = b.st[1];
        if (nloc == 0u) { xcd_barrier_complete(bar, b.x, nloc, nx); b.st[0] = nloc; b.st[1] = nx; }
        const unsigned old = xb_add(&bar[XB_XSUB(b.x)], 1u);
        const unsigned gen = old / nloc;
        if (old + 1u == (gen + 1u) * nloc) {
            __builtin_amdgcn_fence(__ATOMIC_RELEASE, "agent");
            asm volatile("s_waitcnt vmcnt(0)" ::: "memory");
            const unsigned og = xb_add(&bar[XB_TOP], 1u);
            const unsigned tg = og / nx;
            if (og + 1u == (tg + 1u) * nx) xb_add(&bar[XB_TOPGEN], 1u);
            else XB_SPIN(xb_ld(&bar[XB_TOPGEN]) == tg, bar);
            __builtin_amdgcn_fence(__ATOMIC_ACQUIRE, "agent");
            xb_add(&bar[XB_XGEN(b.x)], 1u);
            asm volatile("s_waitcnt vmcnt(0)" ::: "memory");
        } else {
            XB_SPIN(xb_ld(&bar[XB_XGEN(b.x)]) == gen, bar);
            __builtin_amdgcn_fence(__ATOMIC_ACQUIRE, "agent");
            asm volatile("s_waitcnt vmcnt(0)" ::: "memory");
        }
    }
    __syncthreads();
}


struct Args { const float* in[29]; float* out; unsigned char* ws; };
__global__ void __launch_bounds__(512, 2) hymba_fwd(Args args) {
    extern __shared__ __attribute__((aligned(16))) unsigned char lds_raw[];
    cg::grid_group grid = cg::this_grid();
    LAS unsigned char* lds = (LAS unsigned char*)lds_raw;
    const int wave = __builtin_amdgcn_readfirstlane((int)threadIdx.x >> 6);
    const int G = gridDim.x; const int bx = blockIdx.x; const int vcu = (G % 8 == 0) ? (bx % 8) * (G / 8) + bx / 8 : bx;
    const int gw = vcu * 8 + wave, NGW = G * 8, NTH = G * 512;
#define PH_VARS int tid = threadIdx.x; asm volatile("" : "+v"(tid)); const int lane = tid & 63; const int gtid = vcu * 512 + tid; (void)lane; (void)gtid;
    unsigned char* ws = args.ws;
    const float* xp = args.in[0]; const float* xs = args.in[1];
    bf16* WIN = (bf16*)(ws + WS_WIN); bf16* WOUT = (bf16*)(ws + WS_WOUT); bf16* WXQ = (bf16*)(ws + WS_WXQ); bf16* WXKV = (bf16*)(ws + WS_WXKV); bf16* WXO = (bf16*)(ws + WS_WXO);
    bf16* WGU = (bf16*)(ws + WS_WGU); bf16* WD = (bf16*)(ws + WS_WD); bf16* MEMN = (bf16*)(ws + WS_MEMN); bf16* MKV = (bf16*)(ws + WS_MKV); bf16* XN = (bf16*)(ws + WS_XN);
    float* DT = (float*)(ws + WS_DT); float* CS = (float*)(ws + WS_CS); float* DEC = (float*)(ws + WS_DEC); float* TAB = (float*)(ws + WS_TAB); bf16* KC_ = (bf16*)(ws + WS_KC); bf16* VC_ = (bf16*)(ws + WS_VC); float* SSQS = (float*)(ws + WS_SSQS); float* RS1 = (float*)(ws + 64 * 1024); float* RS2 = (float*)(ws + 528 * 1024);   float* SSQA = (float*)(ws + WS_SSQA);
    bf16* PROJ = (bf16*)(ws + WS_PROJ); bf16* Q2 = (bf16*)(ws + WS_Q2); bf16* CA = (bf16*)(ws + WS_CA); bf16* HID = (bf16*)(ws + WS_HID); bf16* XBC = (bf16*)(ws + WS_XBC); bf16* RAW = (bf16*)(ws + WS_RAW);
    bf16* X1B = (bf16*)args.out; bf16* X2B0 = (bf16*)(ws + WS_X2B0); bf16* X2B1 = (bf16*)(ws + WS_X2B1);
    bf16* ST = (bf16*)args.out;
    volatile LAS unsigned* bst = (volatile LAS unsigned*)(lds + LDS_BYTES - 16);
    if (threadIdx.x < 4) bst[threadIdx.x] = 0u;
    __syncthreads();
    if (blockIdx.x == 0) for (int i = threadIdx.x; i < XCD_BAR_WORDS; i += 512) ((unsigned*)(ws + WS_BAR))[i] = 0u;
    XcdBarrier xbar; xbar.bar = (unsigned*)(ws + WS_BAR); xbar.x = 0; xbar.st = bst;
#define GRID_BAR() xcd_barrier(xbar)

#if (PHMASK >> 0) & 1
    { PH_VARS
    {
        LAS float* scr = (LAS float*)(lds + wave * 16384);
        for (int it = gw; it < 7696; it += NGW) {
            int r = it;
#define TRY(W_, pitch_, Krows_, col0_, ncols_, WT_, drow0_, mode_) { const int nb_ = (ncols_) / 32, cnt_ = ((Krows_) / 64) * nb_; if (r < cnt_) { const int kb = r / nb_, n0 = (r % nb_) * 32; \
                const int dr = (mode_) ? (drow0_) + 256 * (n0 / 128) + (n0 % 128) : (drow0_) + n0; tr_item(W_, pitch_, kb * 64, (col0_) + n0, WT_, Krows_, dr, scr, lane); continue; } r -= cnt_; }
            TRY(args.in[5], 3360, 1024, 0, 1024, WIN, 0, 0)
            TRY(args.in[5], 3360, 1024, 1024, 1536, WIN, XC, 0)
            TRY(args.in[5], 3360, 1024, 2560, 32, WIN, DTC, 0)
            TRY(args.in[5], 3360, 1024, 2592, 512, WIN, QC, 0)
            TRY(args.in[5], 3360, 1024, 3104, 128, WIN, KC, 0)
            TRY(args.in[5], 3360, 1024, 3232, 128, WIN, VC, 0)
            { const int nb_ = 32, cnt_ = 24 * nb_; if (r < cnt_) { const int kb = r / nb_, n0 = (r % nb_) * 32; const float* gk = kb < 16 ? args.in[11] + kb * 64 : args.in[14] + (kb - 16) * 64;
                tr_item(args.in[15], 1024, kb * 64, n0, WOUT, 1536, n0, scr, lane, gk); continue; } r -= cnt_; }
            { const int nb_ = 16, cnt_ = 16 * nb_; if (r < cnt_) { const int kb = r / nb_, n0 = (r % nb_) * 32; tr_item(args.in[19], 512, kb * 64, n0, WXQ, 1024, n0, scr, lane, args.in[17] + kb * 64); continue; } r -= cnt_; }
            TRY(args.in[20], 512, 1024, 0, 512, WXKV, 0, 0)
            TRY(args.in[21], 512, 1024, 0, 512, WXKV, 512, 0)
            TRY(args.in[22], 1024, 512, 0, 1024, WXO, 0, 0)
            { const int nb_ = 88, cnt_ = 16 * nb_; if (r < cnt_) { const int kb = r / nb_, n0 = (r % nb_) * 32; tr_item(args.in[25], 2816, kb * 64, n0, WGU, 1024, 256 * (n0 / 128) + (n0 % 128), scr, lane, args.in[24] + kb * 64); continue; } r -= cnt_; }
            { const int nb_ = 88, cnt_ = 16 * nb_; if (r < cnt_) { const int kb = r / nb_, n0 = (r % nb_) * 32; tr_item(args.in[26], 2816, kb * 64, n0, WGU, 1024, 128 + 256 * (n0 / 128) + (n0 % 128), scr, lane, args.in[24] + kb * 64); continue; } r -= cnt_; }
            TRY(args.in[27], 1024, 2816, 0, 1024, WD, 0, 0)
#undef TRY
        }
        for (int i = gtid; i < 224 * 1024 / 8; i += NTH) ((v4u*)(WIN + (size_t)3360 * 1024))[i] = (v4u){0u, 0u, 0u, 0u};
        for (int i = gtid; i < 320 * 16; i += NTH) { const int pos = i >> 4, f = i & 15; const double m4 = (f & 3) == 0 ? 1.0 : (f & 3) == 1 ? 0.56234132519034908 : (f & 3) == 2 ? 0.31622776601683794 : 0.17782794100389228;
            const double e4 = (f >> 2) == 0 ? 1.0 : (f >> 2) == 1 ? 0.1 : (f >> 2) == 2 ? 0.01 : 0.001; const double pv = (double)(pos < 256 ? pos : pos - 256);
            double rev = pv * (m4 * e4) * 0.15915494309189535; rev -= floor(rev); const float rf = (float)rev;
            TAB[2 * i] = __builtin_amdgcn_cosf(rf); TAB[2 * i + 1] = __builtin_amdgcn_sinf(rf); }
        norm_rows<4>(xp, xs, nullptr, nullptr, nullptr, nullptr, nullptr, nullptr, nullptr, args.in[4], XN, nullptr, gw, NGW, lane);
        for (int t = gw; t < 2304; t += NGW) {
            const float* base = t < 256 ? args.in[2] + (size_t)t * 1024 : args.in[3] + (size_t)(t - 256) * 1024; f32x4 v[4]; float s2 = 0.f;
#pragma unroll
            for (int j = 0; j < 4; ++j) { v[j] = ((const f32x4*)base)[lane + 64 * j]; s2 += (v[j].x * v[j].x + v[j].y * v[j].y) + (v[j].z * v[j].z + v[j].w * v[j].w); }
            const float rstd = 1.0f / sqrtf(wave_sum(s2) * (1.f / 1024.f) + EPSN);
#pragma unroll
            for (int j = 0; j < 4; ++j) { const f32x4 g = ((const f32x4*)args.in[18])[lane + 64 * j]; const f32x4 o = v[j] * rstd * g; v2u w; w.x = pk2(o.x, o.y); w.y = pk2(o.z, o.w); *(v2u*)(MEMN + (size_t)t * 1024 + 4 * (lane + 64 * j)) = w; }
        }
    }
    }
#endif
    grid.sync();
    xbar = xcd_barrier_post((unsigned*)(ws + WS_BAR), bst);
#if (PHMASK >> 1) & 1
    { PH_VARS
    {
        pg8::Gemm g{XN, WIN, NTOK, PP, 1024, 1024, 0, 1 << 30}; pg8::StaticOrder S; S.init(NTOK, PP, G, bx); EpiProj E{PROJ, VC_};
        pg8::gemm_phase<EpiProj, pg8::StaticOrder, true, true>(lds, g, S, E);
        pg8::Gemm g2{MEMN, WXKV, 2304, 1024, 1024, 1024, 0, 1 << 30}; pg8::StaticOrder S2; S2.init(2304, 1024, G, (bx + 128) % G); EpiStore E2{MKV, 1024, 1.0f, nullptr};
        pg8::gemm_phase<EpiStore, pg8::StaticOrder, true, true>(lds, g2, S2, E2);
    }
    }
#endif
    GRID_BAR();
#if (PHMASK >> 2) & 1
    { PH_VARS
    {
        const float* conv_w = args.in[6]; const float* conv_b = args.in[7];
        const bool rebal = (NGW == 2048);
        for (int k_ = 0; k_ < 16; ++k_) {
            int item;
            if (k_ < 15) { item = gw + k_ * NGW; if (rebal && gw < 640 && k_ >= 13) continue; }
            else { if (!rebal || gw < 640 || gw >= 1920) continue; const int e_ = gw - 640; item = (e_ % 640) + (13 + e_ / 640) * NGW; }
            if (item >= 30720) continue;
            const int run = item / 3, j = item - run * 3, t0 = run * 8, c0 = (lane + 64 * j) * 8;
            const int s0 = t0 < 16384 ? 0 : 16384 + ((t0 - 16384) >> 13) * 8192, len = t0 < 16384 ? 16384 : 8192, pos0 = t0 - s0;
            v4u rows[12];
#pragma unroll
            for (int i = 0; i < 12; ++i) { const int tt = pos0 + i - 2; rows[i] = (v4u){0u, 0u, 0u, 0u}; if (tt >= 0 && tt < len) rows[i] = *(const v4u*)(PROJ + (size_t)(t0 + i - 2) * PP + XC + c0); }
            f32x4 w[5][2];
#pragma unroll
            for (int dk = 0; dk < 5; ++dk) { w[dk][0] = *(const f32x4*)(conv_w + dk * 1536 + c0); w[dk][1] = *(const f32x4*)(conv_w + dk * 1536 + c0 + 4); }
            const f32x4 b0 = *(const f32x4*)(conv_b + c0), b1 = *(const f32x4*)(conv_b + c0 + 4);
#pragma unroll
            for (int o_ = 0; o_ < 8; ++o_) { float a[8] = {b0.x, b0.y, b0.z, b0.w, b1.x, b1.y, b1.z, b1.w};
#pragma unroll
                for (int dk = 0; dk < 5; ++dk) { const v4u r = rows[o_ + dk]; const f32x4 w0 = w[dk][0], w1 = w[dk][1];
                    a[0] += w0.x * bflo(r.x); a[1] += w0.y * bfhi(r.x); a[2] += w0.z * bflo(r.y); a[3] += w0.w * bfhi(r.y); a[4] += w1.x * bflo(r.z); a[5] += w1.y * bfhi(r.z); a[6] += w1.z * bflo(r.w); a[7] += w1.w * bfhi(r.w); }
#pragma unroll
                for (int k = 0; k < 8; ++k) a[k] = a[k] * __builtin_amdgcn_rcpf(1.f + ex2(-a[k] * LOG2E));
                v4u o; o.x = pk2(a[0], a[1]); o.y = pk2(a[2], a[3]); o.z = pk2(a[4], a[5]); o.w = pk2(a[6], a[7]); *(v4u*)(XBC + (size_t)(t0 + o_) * 1536 + c0) = o; }
        }
        for (int tb = gw * 4; tb < NTOK; tb += NGW * 4) {
            const int s0 = tb < 16384 ? 0 : 16384 + ((tb - 16384) >> 13) * 8192;
            v4u rin[5]; bf16* ptrs[5];
#pragma unroll
            for (int part = 0; part < 5; ++part) { const int t = part < 4 ? tb + part : tb + (lane >> 4); ptrs[part] = PROJ + (size_t)t * PP + (part < 4 ? QC + lane * 8 : KC + (lane & 15) * 8); rin[part] = *(const v4u*)ptrs[part]; }
#pragma unroll
            for (int part = 0; part < 5; ++part) {
                const int t = part < 4 ? tb + part : tb + (lane >> 4), pos = t - s0, prow = pos >> 6, pcol = pos & 63, i = lane & 7;
                const v4u r = rin[part]; float x[8] = {bflo(r.x), bfhi(r.x), bflo(r.y), bfhi(r.y), bflo(r.z), bfhi(r.z), bflo(r.w), bfhi(r.w)};
                float ss = 0.f;
#pragma unroll
                for (int k = 0; k < 8; ++k) ss += x[k] * x[k];
                ss += __shfl_xor(ss, 1); ss += __shfl_xor(ss, 2); ss += __shfl_xor(ss, 4);
                const float rstd = 1.0f / sqrtf(ss * (1.f / 64.f) + EPSN); const float* gn = args.in[part < 4 ? 12 : 13] + i * 8;
                const f32x4 g0 = *(const f32x4*)gn, g1 = *(const f32x4*)(gn + 4); const float gg[8] = {g0.x, g0.y, g0.z, g0.w, g1.x, g1.y, g1.z, g1.w};
                const float* tbp = TAB + ((size_t)((i < 4) ? prow : 256 + pcol) * 16 + 8 * (i & 1)) * 2; const f32x4 t0 = *(const f32x4*)tbp, t1 = *(const f32x4*)(tbp + 4), t2 = *(const f32x4*)(tbp + 8), t3 = *(const f32x4*)(tbp + 12);
                const float cs_[8] = {t0.x, t0.z, t1.x, t1.z, t2.x, t2.z, t3.x, t3.z}, sn_[8] = {t0.y, t0.w, t1.y, t1.w, t2.y, t2.w, t3.y, t3.w};
                const float sc = part < 4 ? 0.125f * LOG2E : 1.0f; float y[8];
#pragma unroll
                for (int k = 0; k < 8; ++k) { const float xv = x[k] * rstd * gg[k]; const float ov = __shfl_xor(xv, 2); y[k] = ((i & 2) ? (xv * cs_[k] + ov * sn_[k]) : (xv * cs_[k] - ov * sn_[k])) * sc; }
                v4u o; o.x = pk2(y[0], y[1]); o.y = pk2(y[2], y[3]); o.z = pk2(y[4], y[5]); o.w = pk2(y[6], y[7]);
                if (part < 4) *(v4u*)ptrs[part] = o;
                else *(v4u*)(KC_ + ((size_t)((lane >> 3) & 1) * NTOK + t) * 64 + i * 8) = o;
            }
        }
        for (int c = gw; c < NCHUNK; c += NGW) {
            const int j = lane & 31, hf = lane >> 5, dir = j >> 4; const float bias = args.in[8][j], al2 = -__expf(args.in[9][j]) * LOG2E; const size_t tok0 = (size_t)c * 128;
            float tot = 0.f;
#pragma unroll 1
            for (int i0 = 0; i0 < 64; i0 += 16) { float dtv[16];
#pragma unroll
                for (int i = 0; i < 16; ++i) { const int o = hf * 64 + i0 + i, tk = dir ? 127 - o : o; dtv[i] = bf1(PROJ[(tok0 + tk) * PP + DTC + j]); }
#pragma unroll
                for (int i = 0; i < 16; ++i) { const float xr = dtv[i] + bias; const float dt = xr > 15.f ? xr : log1pf(__expf(xr)); tot += dt * al2; } }
            const float other = __shfl_xor(tot, 32); float run = hf ? other : 0.f;
#pragma unroll 1
            for (int i0 = 0; i0 < 64; i0 += 16) { float dtv[16];
#pragma unroll
                for (int i = 0; i < 16; ++i) { const int o = hf * 64 + i0 + i, tk = dir ? 127 - o : o; dtv[i] = bf1(PROJ[(tok0 + tk) * PP + DTC + j]); }
#pragma unroll
                for (int i = 0; i < 16; ++i) { const int o = hf * 64 + i0 + i, tk = dir ? 127 - o : o; const float xr = dtv[i] + bias; const float dt = xr > 15.f ? xr : log1pf(__expf(xr)); run += dt * al2;
                    DT[(tok0 + tk) * 32 + j] = dt; CS[(tok0 + tk) * 32 + j] = run; } }
            if (hf == 0) DEC[c * 32 + j] = ex2(tot + other);
        }
    }
    }
#endif
    GRID_BAR();
#if (PHMASK >> 3) & 1
    { PH_VARS
    ssd_states(lds, XBC, DT, CS, ST, vcu, G, tid);
    }
#endif
    GRID_BAR();
#if (PHMASK >> 4) & 1
    { PH_VARS
    ssd_pass(ST, DEC, gtid, NTH);
    {
        const attn_body::AttnTensors AT{(const attn_body::bf16*)(PROJ + QC), (const attn_body::bf16*)KC_, (const attn_body::bf16*)VC_, (attn_body::bf16*)(PROJ + QC), SSQA};
        float mq = fabsf(args.in[12][lane]), mk = fabsf(args.in[13][lane]);
#pragma unroll
        for (int o_ = 1; o_ < 64; o_ <<= 1) { mq = fmaxf(mq, __shfl_xor(mq, o_)); mk = fmaxf(mk, __shfl_xor(mk, o_)); }
        const float bref = 0.125f * LOG2E * 64.f * mq * mk * 1.02f + 0.1f;
        if (bref <= 40.f) attn_body::attn_phase<8, true>(bref, (char*)lds_raw, AT, vcu, G);
        else attn_body::attn_phase<8, false>(0.f, (char*)lds_raw, AT, vcu, G);
    }
    }
#endif
    GRID_BAR();
#if (PHMASK >> 5) & 1
    { PH_VARS
    ssd_out(lds, XBC, DT, CS, ST, PROJ, args.in[10], SSQS, vcu, G, tid);
    }
#endif
    GRID_BAR();
#if (PHMASK >> 7) & 1
    { PH_VARS
    { pg8::Gemm g{PROJ, WOUT, NTOK, 1024, 1536, PP, 0, 1 << 30}; pg8::StaticOrder S; S.init(NTOK, 1024, G, bx);
      LAS float* Rl = (LAS float*)(lds + 131072);
      { pg8::Unit uu; for (int i = 0; i < 5 && S.next(i, uu); ++i) if (tid < 256) { const size_t row = (size_t)uu.pm * 256 + tid;
            const f32x4 sv = *(const f32x4*)(SSQS + row * 4), a0 = *(const f32x4*)(SSQA + row * 8), a1 = *(const f32x4*)(SSQA + row * 8 + 4);
            const float d0 = (sv.x + sv.y) * (1.f / 512.f) + EPSN, d1 = (sv.z + sv.w) * (1.f / 512.f) + EPSN, d2 = (((a0.x + a0.y) + (a0.z + a0.w)) + ((a1.x + a1.y) + (a1.z + a1.w))) * (1.f / 512.f) + EPSN;
            *(LAS f32x4*)(Rl + (size_t)i * 1024 + tid * 4) = (f32x4){sqrtf(d1 / d0), sqrtf(d2 / d1), 1.0f / sqrtf(d2), 0.f}; }
        __syncthreads(); }
      EpiRowScale E{RAW, 1024, Rl}; pg8::gemm_phase<EpiRowScale, pg8::StaticOrder, true, true>(lds, g, S, E); }
    }
#endif
    GRID_BAR();
#if (PHMASK >> 8) & 1
    { PH_VARS
    norm_rows<4>(xp, xs, nullptr, nullptr, RAW, args.in[16], nullptr, X1B, X1B + (size_t)XSPLIT * 1024, nullptr, nullptr, RS1, gw, NGW, lane);
    }
#endif
    GRID_BAR();
#if (PHMASK >> 9) & 1
    { PH_VARS
    { pg8::Gemm g{X1B, WXQ, NTOK, 512, 1024, 1024, 0, 1 << 30}; pg8::StaticOrder S; S.init(NTOK, 512, G, bx); EpiStore E{Q2, 512, 0.08838834764831845f * LOG2E, RS1}; pg8::gemm_phase<EpiStore, pg8::StaticOrder, true, true>(lds, g, S, E); }
    }
#endif
    GRID_BAR();
#if (PHMASK >> 10) & 1
    { PH_VARS
    xattn(lds, Q2, MKV, CA, vcu, G, tid);
    }
#endif
    GRID_BAR();
#if (PHMASK >> 11) & 1
    { PH_VARS
    { pg8::Gemm g{CA, WXO, NTOK, 1024, 512, 512, 0, 1 << 30}; pg8::StaticOrder S; S.init(NTOK, 1024, G, bx); EpiStore E{RAW, 1024, 1.0f, nullptr}; pg8::gemm_phase<EpiStore, pg8::StaticOrder, true, true>(lds, g, S, E); }
    }
#endif
    GRID_BAR();
#if (PHMASK >> 12) & 1
    { PH_VARS
    norm_rows<4>(nullptr, nullptr, X1B, X1B + (size_t)XSPLIT * 1024, RAW, args.in[23], nullptr, X2B0, X2B1, nullptr, nullptr, RS2, gw, NGW, lane);
    }
#endif
    GRID_BAR();
#if (PHMASK >> 13) & 1
    { PH_VARS
    { pg8::Gemm g{X2B0, WGU, NTOK, 5632, 1024, 1024, (long)((const char*)X2B1 - (const char*)X2B0), XSPLIT / 256}; pg8::StaticOrder S; S.init(NTOK, 5632, G, bx); EpiSwiglu E{HID, 2816, RS2}; pg8::gemm_phase<EpiSwiglu, pg8::StaticOrder, true, true>(lds, g, S, E); }
    }
#endif
    GRID_BAR();
#if (PHMASK >> 14) & 1
    { PH_VARS
    { pg8::Gemm g{HID, WD, NTOK, 1024, 2816, 2816, 0, 1 << 30}; pg8::StaticOrder S; S.init(NTOK, 1024, G, bx); EpiStore E{RAW, 1024, 1.0f, nullptr}; pg8::gemm_phase<EpiStore, pg8::StaticOrder, true, true>(lds, g, S, E); }
    }
#endif
    GRID_BAR();
#if (PHMASK >> 15) & 1
    { PH_VARS
    norm_rows<4>(nullptr, nullptr, X2B0, X2B1, RAW, args.in[28], args.out, nullptr, nullptr, nullptr, nullptr, nullptr, gw, NGW, lane);
    }
#endif
}

extern "C" void kernel_launch(void* const* d_in, const int* in_sizes, int n_in, void* d_out, int out_size, void* d_ws, size_t ws_size, hipStream_t stream) {
    static int grid = 0;
    if (grid == 0) {
        if (n_in != 29 || out_size != NTOK * 1024 || ws_size < WS_END) { fprintf(stderr, "kernel_launch: unexpected shapes (n_in %d, out %d, ws %zu)\n", n_in, out_size, ws_size); grid = -1; return; }
        int dev = 0, cus = 0, per_cu = 0;
        if (hipGetDevice(&dev) != hipSuccess || hipDeviceGetAttribute(&cus, hipDeviceAttributeMultiprocessorCount, dev) != hipSuccess) { grid = -1; return; }
        if (hipFuncSetAttribute((const void*)hymba_fwd, hipFuncAttributeMaxDynamicSharedMemorySize, LDS_BYTES) != hipSuccess) { fprintf(stderr, "kernel_launch: hipFuncSetAttribute failed\n"); grid = -1; return; }
        if (hipOccupancyMaxActiveBlocksPerMultiprocessor(&per_cu, (const void*)hymba_fwd, 512, LDS_BYTES) != hipSuccess || per_cu < 1) { fprintf(stderr, "kernel_launch: occupancy query says %d\n", per_cu); per_cu = 1; }
        (void)hipGetLastError();
        grid = cus * (per_cu > 1 ? 1 : per_cu);
    }
    if (grid < 0) return;
    Args a{};
    for (int i = 0; i < 29; ++i) a.in[i] = (const float*)d_in[i];
    a.out = (float*)d_out; a.ws = (unsigned char*)d_ws;
    void* kargs[] = {&a};
    const hipError_t e = hipLaunchCooperativeKernel((const void*)hymba_fwd, dim3(grid), dim3(512), kargs, LDS_BYTES, stream);
    if (e != hipSuccess) fprintf(stderr, "kernel_launch: cooperative launch failed: %s (grid %d)\n", hipGetErrorString(e), grid);
}
```
